# Optimizing an MI355X kernel written in HIP

```python
import math
import jax, jax.numpy as jnp
from jax import lax
import numpy as np

D_MODEL = 1024
BATCH = 16
SEQ = 2048
DEPTH = 2

MEM_LEN = 256
ATTN_HEADS = 8
ATTN_HEAD_DIM = 64
D_ATTN = ATTN_HEADS * ATTN_HEAD_DIM
D_SSM = D_MODEL // 4
SSM_GROUP = 16
SSM_GROUPS = D_SSM // SSM_GROUP
SSM_STATE = 64
D_LRU = D_MODEL // 4
LRU_HEADS = 4
LRU_HEAD_DIM = D_LRU // LRU_HEADS
CONV_WIDTH = 4
LRU_C = 8.0
D_MIX = D_ATTN + D_SSM + D_LRU
D_IN = 3 * D_ATTN + D_SSM + 2 * D_LRU
SPLITS = (D_ATTN, 2 * D_ATTN, 3 * D_ATTN, 3 * D_ATTN + D_SSM, 3 * D_ATTN + D_SSM + D_LRU)
MOBA_BLOCK = 256
MOBA_TOPK = 3
MOBA_Q_CHUNK = 16
MEM_HEADS = 4
MEM_HEAD_DIM = D_MODEL // MEM_HEADS
N_GROUPS = 4
EXPERTS_PER_GROUP = 4
N_EXPERTS = N_GROUPS * EXPERTS_PER_GROUP
EXPERT_TOPK = 2
D_EXPERT = 256
ALPHA = (2.0 * DEPTH) ** 0.25
BETA = (8.0 * DEPTH) ** -0.25
LN_EPS = 1e-5
RMS_EPS = 1e-6
NEG_INF = -1e30

kernel_name = "hymba_moba_s5_rglru_hmoe_deepnorm"


def layer_norm(x, g, b):
    xf = x.astype(jnp.float32)
    mu = jnp.mean(xf, axis=-1, keepdims=True)
    var = jnp.mean(jnp.square(xf - mu), axis=-1, keepdims=True)
    y = (xf - mu) * lax.rsqrt(var + LN_EPS) * g.astype(jnp.float32) + b.astype(jnp.float32)
    return y.astype(x.dtype)


def rms_normalize(x):
    xf = x.astype(jnp.float32)
    return (xf * lax.rsqrt(jnp.mean(xf * xf, axis=-1, keepdims=True) + RMS_EPS)).astype(x.dtype)


def alibi_slopes(n_heads):
    return jnp.asarray([2.0 ** (-8.0 * (h + 1) / n_heads) for h in range(n_heads)], jnp.float32)


def moba_attention(q, k, v):
    bsz, s, nh, dh = q.shape
    f32 = jnp.float32
    nb = -(-s // MOBA_BLOCK)
    sp = nb * MOBA_BLOCK
    kk = min(MOBA_TOPK, nb)
    nc = sp // MOBA_Q_CHUNK
    pad = ((0, 0), (0, sp - s), (0, 0), (0, 0))
    q, k, v = [jnp.pad(t, pad).transpose(0, 2, 1, 3) for t in (q, k, v)]
    kb = k.reshape(bsz, nh, nb, MOBA_BLOCK, dh)
    vb = v.reshape(bsz, nh, nb, MOBA_BLOCK, dh)
    kmean = jnp.mean(kb.astype(f32), axis=3)
    gate = jnp.einsum('bhtd,bhnd->bhtn', q.astype(f32), kmean)
    qblk = jnp.arange(sp) // MOBA_BLOCK
    fully_past = jnp.arange(nb)[None, :] < qblk[:, None]
    gate = jnp.where(fully_past, gate, NEG_INF)
    _, sel = lax.top_k(gate, kk)
    slopes = alibi_slopes(nh)
    scale = dh ** -0.5
    q_chunks = q.reshape(bsz, nh, nc, MOBA_Q_CHUNK, dh).transpose(2, 0, 1, 3, 4)
    sel_chunks = sel.reshape(bsz, nh, nc, MOBA_Q_CHUNK, kk).transpose(2, 0, 1, 3, 4)
    gather_blocks = jax.vmap(jax.vmap(lambda blocks, idx: blocks[idx]))
    offs = jnp.arange(MOBA_BLOCK)

    def attend_chunk(args):
        c, q_c, sel_c = args
        t = c * MOBA_Q_CHUNK + jnp.arange(MOBA_Q_CHUNK)
        own = (c * MOBA_Q_CHUNK) // MOBA_BLOCK
        k_sel = gather_blocks(kb, sel_c)
        v_sel = gather_blocks(vb, sel_c)
        s_sel = jnp.einsum('bhqd,bhqjsd->bhqjs', q_c, k_sel).astype(f32) * scale
        dist_sel = (t[:, None, None] - (sel_c[..., None] * MOBA_BLOCK + offs)).astype(f32)
        s_sel = s_sel - slopes[None, :, None, None, None] * dist_sel
        sel_ok = jnp.arange(kk) < own
        s_sel = jnp.where(sel_ok[:, None], s_sel, NEG_INF)
        k_own = lax.dynamic_index_in_dim(kb, own, axis=2, keepdims=False)
        v_own = lax.dynamic_index_in_dim(vb, own, axis=2, keepdims=False)
        s_own = jnp.einsum('bhqd,bhsd->bhqs', q_c, k_own).astype(f32) * scale
        dist_own = (t[:, None] - (own * MOBA_BLOCK + offs)[None, :]).astype(f32)
        s_own = jnp.where(dist_own >= 0, s_own - slopes[:, None, None] * dist_own, NEG_INF)
        scores = jnp.concatenate([s_sel.reshape(bsz, nh, MOBA_Q_CHUNK, kk * MOBA_BLOCK), s_own], axis=-1)
        p = jax.nn.softmax(scores, axis=-1).astype(v_sel.dtype)
        p_sel = p[..., :kk * MOBA_BLOCK].reshape(bsz, nh, MOBA_Q_CHUNK, kk, MOBA_BLOCK)
        p_own = p[..., kk * MOBA_BLOCK:]
        return (jnp.einsum('bhqjs,bhqjsd->bhqd', p_sel, v_sel)
                + jnp.einsum('bhqs,bhsd->bhqd', p_own, v_own))

    out = lax.map(attend_chunk, (jnp.arange(nc), q_chunks, sel_chunks))
    out = out.transpose(1, 0, 3, 2, 4).reshape(bsz, sp, nh * dh)
    return out[:, :s]


def s5_mixer(u, a_re, a_im, b_re, b_im, c_re, c_im, d_skip, log_dt, w_glu, b_glu):
    f32 = jnp.float32
    bsz, s, _ = u.shape
    uf = u.astype(f32).reshape(bsz, s, SSM_GROUPS, SSM_GROUP)
    dt = jnp.exp(log_dt.astype(f32))[:, None]
    are, aim = a_re.astype(f32), a_im.astype(f32)
    mag = jnp.exp(dt * are)
    ab_re, ab_im = mag * jnp.cos(dt * aim), mag * jnp.sin(dt * aim)
    den = are * are + aim * aim
    nr, ni = ab_re - 1.0, ab_im
    f_re = (nr * are + ni * aim) / den
    f_im = (ni * are - nr * aim) / den
    br, bi = b_re.astype(f32), b_im.astype(f32)
    bb_re = f_re[..., None] * br - f_im[..., None] * bi
    bb_im = f_re[..., None] * bi + f_im[..., None] * br
    bu_re = jnp.einsum('gph,bsgh->bsgp', bb_re, uf)
    bu_im = jnp.einsum('gph,bsgh->bsgp', bb_im, uf)
    at_re = jnp.broadcast_to(ab_re, bu_re.shape)
    at_im = jnp.broadcast_to(ab_im, bu_im.shape)

    def combine(e1, e2):
        a1r, a1i, b1r, b1i = e1
        a2r, a2i, b2r, b2i = e2
        return (a2r * a1r - a2i * a1i, a2r * a1i + a2i * a1r,
                a2r * b1r - a2i * b1i + b2r, a2r * b1i + a2i * b1r + b2i)

    _, _, xr, xi = lax.associative_scan(combine, (at_re, at_im, bu_re, bu_im), axis=1)
    y = (jnp.einsum('ghp,bsgp->bsgh', c_re.astype(f32), xr)
         - jnp.einsum('ghp,bsgp->bsgh', c_im.astype(f32), xi)).reshape(bsz, s, D_SSM)
    y = jax.nn.gelu(y + d_skip.astype(f32) * u.astype(f32))
    y = y * jax.nn.sigmoid(y @ w_glu.astype(f32) + b_glu.astype(f32))
    return y.astype(u.dtype)


def rglru_mixer(xl, gl, conv_w, conv_b, w_a, b_a, w_x, b_x, lam):
    f32 = jnp.float32
    bsz, s, _ = xl.shape
    xc = lax.conv_general_dilated(xl.astype(f32), conv_w.astype(f32)[:, None, :], window_strides=(1,),
                                  padding=[(CONV_WIDTH - 1, 0)], dimension_numbers=('NWC', 'WIO', 'NWC'),
                                  feature_group_count=D_LRU) + conv_b.astype(f32)
    xh = xc.reshape(bsz, s, LRU_HEADS, LRU_HEAD_DIM)
    r = jax.nn.sigmoid(jnp.einsum('bshi,hij->bshj', xh, w_a.astype(f32)).reshape(bsz, s, D_LRU) + b_a.astype(f32))
    i = jax.nn.sigmoid(jnp.einsum('bshi,hij->bshj', xh, w_x.astype(f32)).reshape(bsz, s, D_LRU) + b_x.astype(f32))
    log_a = -LRU_C * r * jax.nn.softplus(-lam.astype(f32))
    a = jnp.exp(log_a)
    bterm = jnp.sqrt(-jnp.expm1(2.0 * log_a)) * (i * xc)
    _, hseq = lax.associative_scan(lambda e1, e2: (e1[0] * e2[0], e2[0] * e1[1] + e2[1]), (a, bterm), axis=1)
    return (hseq * jax.nn.gelu(gl.astype(f32))).astype(xl.dtype)


def hybrid_mixer(h, w_in, mix_g, w_out, a_re, a_im, b_re, b_im, c_re, c_im, d_skip, log_dt, w_glu, b_glu,
                 conv_w, conv_b, w_a, b_a, w_x, b_x, lam):
    bsz, s, _ = h.shape
    z = h @ w_in
    q, k, v, u, xl, gl = jnp.split(z, SPLITS, axis=-1)
    hd = (bsz, s, ATTN_HEADS, ATTN_HEAD_DIM)
    y_attn = moba_attention(q.reshape(hd), k.reshape(hd), v.reshape(hd))
    y_ssm = s5_mixer(u, a_re, a_im, b_re, b_im, c_re, c_im, d_skip, log_dt, w_glu, b_glu)
    y_lru = rglru_mixer(xl, gl, conv_w, conv_b, w_a, b_a, w_x, b_x, lam)
    y = jnp.concatenate([rms_normalize(y_attn), rms_normalize(y_ssm), rms_normalize(y_lru)], axis=-1)
    return (y * mix_g) @ w_out


def memory_cross_attention(h, mem, wq, wk, wv, wo):
    bsz, s, _ = h.shape
    m = mem.shape[1]
    q = (h @ wq).reshape(bsz, s, MEM_HEADS, MEM_HEAD_DIM)
    k = (mem @ wk).reshape(bsz, m, MEM_HEADS, MEM_HEAD_DIM)
    v = (mem @ wv).reshape(bsz, m, MEM_HEADS, MEM_HEAD_DIM)
    sc = jnp.einsum('bqhd,bkhd->bhqk', q, k).astype(jnp.float32) * (MEM_HEAD_DIM ** -0.5)
    p = jax.nn.softmax(sc, axis=-1).astype(v.dtype)
    o = jnp.einsum('bhqk,bkhd->bqhd', p, v).reshape(bsz, s, D_MODEL)
    return o @ wo


def hier_moe(h, wr_g, br_g, wr_e, br_e, w_gate, w_up, w_down):
    f32 = jnp.float32
    bsz, s, d = h.shape
    t = h.reshape(bsz * s, d)
    g_logits = (t @ wr_g).astype(f32) + br_g.astype(f32)
    g_prob = jax.nn.softmax(g_logits, axis=-1)
    g_onehot = jax.nn.one_hot(jnp.argmax(g_logits, axis=-1), N_GROUPS, dtype=f32)
    g_w = jnp.sum(g_prob * g_onehot, axis=-1, keepdims=True)
    e_logits = ((t @ wr_e).astype(f32) + br_e.astype(f32)).reshape(-1, N_GROUPS, EXPERTS_PER_GROUP)
    e_in_group = jnp.einsum('ng,nge->ne', g_onehot, e_logits)
    e_prob = jax.nn.softmax(e_in_group, axis=-1)
    top_p, top_i = lax.top_k(e_prob, EXPERT_TOPK)
    top_p = top_p / jnp.sum(top_p, axis=-1, keepdims=True)
    local = jnp.sum(jax.nn.one_hot(top_i, EXPERTS_PER_GROUP, dtype=f32) * top_p[..., None], axis=1)
    combine = (g_onehot[:, :, None] * local[:, None, :] * g_w[:, :, None]).reshape(-1, N_EXPERTS).astype(t.dtype)
    out = jnp.zeros_like(t)
    for e in range(N_EXPERTS):
        he = jax.nn.silu(t @ w_gate[e]) * (t @ w_up[e])
        out = out + combine[:, e:e + 1] * (he @ w_down[e])
    return out.reshape(bsz, s, d)


def setup_inputs(seed: int = 0) -> dict:
    key = jax.random.key(seed)
    keys = jax.random.split(key, 64)
    counter = [0]

    def nk():
        kk_ = keys[counter[0]]
        counter[0] += 1
        return kk_

    def nrm(shape, scale):
        return scale * jax.random.normal(nk(), shape, jnp.float32)

    def gain(shape):
        return 1.0 + nrm(shape, 0.02)

    L, d = DEPTH, D_MODEL
    G, P, H = SSM_GROUPS, SSM_STATE, SSM_GROUP
    inp = {}
    inp['x'] = nrm((BATCH, SEQ, d), 1.0)
    inp['mem'] = nrm((BATCH, MEM_LEN, d), 1.0)
    inp['ln0_g'] = gain((d,))
    inp['ln0_b'] = nrm((d,), 0.02)
    inp['w_in'] = nrm((L, d, D_IN), d ** -0.5)
    inp['mix_g'] = gain((L, D_MIX))
    inp['w_out'] = nrm((L, D_MIX, d), BETA * D_MIX ** -0.5)
    inp['ssm_a_re'] = -0.5 + nrm((L, G, P), 0.01)
    inp['ssm_a_im'] = math.pi * jnp.arange(P, dtype=jnp.float32) + nrm((L, G, P), 0.01)
    inp['ssm_b_re'] = nrm((L, G, P, H), (2.0 * H) ** -0.5)
    inp['ssm_b_im'] = nrm((L, G, P, H), (2.0 * H) ** -0.5)
    inp['ssm_c_re'] = nrm((L, G, H, P), P ** -0.5)
    inp['ssm_c_im'] = nrm((L, G, H, P), P ** -0.5)
    inp['ssm_d'] = nrm((L, D_SSM), 1.0)
    inp['ssm_log_dt'] = jax.random.uniform(nk(), (L, G), jnp.float32, math.log(1e-3), math.log(1e-1))
    inp['ssm_w_glu'] = nrm((L, D_SSM, D_SSM), D_SSM ** -0.5)
    inp['ssm_b_glu'] = nrm((L, D_SSM), 0.01)
    inp['lru_conv_w'] = nrm((L, CONV_WIDTH, D_LRU), CONV_WIDTH ** -0.5)
    inp['lru_conv_b'] = nrm((L, D_LRU), 0.01)
    inp['lru_w_a'] = nrm((L, LRU_HEADS, LRU_HEAD_DIM, LRU_HEAD_DIM), LRU_HEAD_DIM ** -0.5)
    inp['lru_b_a'] = nrm((L, D_LRU), 0.01)
    inp['lru_w_x'] = nrm((L, LRU_HEADS, LRU_HEAD_DIM, LRU_HEAD_DIM), LRU_HEAD_DIM ** -0.5)
    inp['lru_b_x'] = nrm((L, D_LRU), 0.01)
    a_pow_c = jax.random.uniform(nk(), (L, D_LRU), jnp.float32, 0.9, 0.999)
    a_base = a_pow_c ** (1.0 / LRU_C)
    inp['lru_lam'] = jnp.log(a_base) - jnp.log1p(-a_base)
    inp['ln1_g'] = gain((L, d))
    inp['ln1_b'] = nrm((L, d), 0.02)
    inp['mem_wq'] = nrm((L, d, d), d ** -0.5)
    inp['mem_wk'] = nrm((L, d, d), d ** -0.5)
    inp['mem_wv'] = nrm((L, d, d), d ** -0.5)
    inp['mem_wo'] = nrm((L, d, d), BETA * d ** -0.5)
    inp['ln2_g'] = gain((L, d))
    inp['ln2_b'] = nrm((L, d), 0.02)
    inp['moe_wr_g'] = nrm((L, d, N_GROUPS), d ** -0.5)
    inp['moe_br_g'] = nrm((L, N_GROUPS), 0.01)
    inp['moe_wr_e'] = nrm((L, d, N_EXPERTS), d ** -0.5)
    inp['moe_br_e'] = nrm((L, N_EXPERTS), 0.01)
    inp['moe_w_gate'] = nrm((L, N_EXPERTS, d, D_EXPERT), d ** -0.5)
    inp['moe_w_up'] = nrm((L, N_EXPERTS, d, D_EXPERT), d ** -0.5)
    inp['moe_w_down'] = nrm((L, N_EXPERTS, D_EXPERT, d), BETA * D_EXPERT ** -0.5)
    inp['ln3_g'] = gain((L, d))
    inp['ln3_b'] = nrm((L, d), 0.02)
    return inp


def reference(x, mem, ln0_g, ln0_b, w_in, mix_g, w_out,
              ssm_a_re, ssm_a_im, ssm_b_re, ssm_b_im, ssm_c_re, ssm_c_im, ssm_d, ssm_log_dt, ssm_w_glu, ssm_b_glu,
              lru_conv_w, lru_conv_b, lru_w_a, lru_b_a, lru_w_x, lru_b_x, lru_lam,
              ln1_g, ln1_b, mem_wq, mem_wk, mem_wv, mem_wo, ln2_g, ln2_b,
              moe_wr_g, moe_br_g, moe_wr_e, moe_br_e, moe_w_gate, moe_w_up, moe_w_down, ln3_g, ln3_b):
    h = layer_norm(x, ln0_g, ln0_b)
    for l in range(DEPTH):
        mix = hybrid_mixer(h, w_in[l], mix_g[l], w_out[l],
                           ssm_a_re[l], ssm_a_im[l], ssm_b_re[l], ssm_b_im[l], ssm_c_re[l], ssm_c_im[l],
                           ssm_d[l], ssm_log_dt[l], ssm_w_glu[l], ssm_b_glu[l],
                           lru_conv_w[l], lru_conv_b[l], lru_w_a[l], lru_b_a[l], lru_w_x[l], lru_b_x[l], lru_lam[l])
        h = layer_norm(ALPHA * h + mix, ln1_g[l], ln1_b[l])
        cross = memory_cross_attention(h, mem, mem_wq[l], mem_wk[l], mem_wv[l], mem_wo[l])
        h = layer_norm(ALPHA * h + cross, ln2_g[l], ln2_b[l])
        ffn = hier_moe(h, moe_wr_g[l], moe_br_g[l], moe_wr_e[l], moe_br_e[l],
                       moe_w_gate[l], moe_w_up[l], moe_w_down[l])
        h = layer_norm(ALPHA * h + ffn, ln3_g[l], ln3_b[l])
    return h
```

```cpp
#include <hip/hip_runtime.h>
#include <cstdio>
#include <cstdint>

#ifndef MK_ONE_LAUNCH
#define MK_ONE_LAUNCH 1
#endif
#ifndef PROBE_REP
#define PROBE_REP -1
#endif
#ifndef PROBE_N
#define PROBE_N 2
#endif
#define REPS(k) (((k) == PROBE_REP) ? (PROBE_N + 1) : 1)

typedef _Float16 f16;
typedef _Float16 f16x8 __attribute__((ext_vector_type(8)));
typedef _Float16 f16x4 __attribute__((ext_vector_type(4)));
typedef float f32x4 __attribute__((ext_vector_type(4)));
#define LAS __attribute__((address_space(3)))
#define GAS __attribute__((address_space(1)))
typedef GAS unsigned gu32;

constexpr int BATCH = 16, SEQ = 2048, NTOK = BATCH * SEQ, D = 1024, DIN = 2304, DEPTH = 2;
constexpr int MEMLEN = 256, NMEM = BATCH * MEMLEN;
constexpr int ZQ = 0, ZK = 512, ZV = 1024, ZU = 1536, ZXL = 1792, ZGL = 2048;
constexpr int NEXP = 16, DEXP = 256;
constexpr float ALPHA = 1.4142135623730951f;
constexpr float LOG2E = 1.4426950408889634f;
constexpr float QSCALE = 0.125f * LOG2E;
constexpr float XQSCALE = 0.0625f * LOG2E;
constexpr int MOE_MAXROWS = 2 * NTOK + NEXP * 256;

constexpr size_t MiB = 1u << 20;
constexpr size_t WS_CTL = 0, CTL_ZERO_BYTES = 64 * 1024;
constexpr size_t WS_KMEAN = 1 * MiB;
constexpr size_t WS_TOKE = 2 * MiB;
constexpr size_t WS_TOKW = 3 * MiB;
constexpr size_t WS_HIST = 4 * MiB;
constexpr size_t WS_ROWTOK = 5 * MiB;
constexpr size_t WS_ROWW = 6 * MiB;
constexpr size_t WS_TILEEXP = 7 * MiB;
constexpr size_t WS_ROWSRC = 9 * MiB;
constexpr size_t WS_S1Q = 10 * MiB, WS_S2Q = 10 * MiB + 64 * 1024;
constexpr size_t WS_STATS1 = 11 * MiB;
constexpr size_t WS_LRUENDS = 8 * MiB;
constexpr size_t WS_MEM16 = 16 * MiB;
constexpr size_t WS_KM = 24 * MiB;
constexpr size_t WS_VM = 40 * MiB;
constexpr size_t WS_H = 56 * MiB;
constexpr size_t WS_WREG = 120 * MiB;
constexpr size_t WS_S5AP = 120 * MiB, WS_S5BB = 121 * MiB, WS_S5KK = 122 * MiB, WS_S5WEND = 124 * MiB, WS_S5T = 128 * MiB, WS_UG = 152 * MiB;
constexpr size_t WS_XC = 120 * MiB;
constexpr size_t WS_LA = 152 * MiB;
constexpr size_t WS_LB = 184 * MiB;
constexpr size_t WS_ARENA = 280 * MiB;
constexpr size_t WS_Z = WS_ARENA;
constexpr size_t WS_Y = WS_ARENA + 144 * MiB;
constexpr size_t WS_YACT = WS_ARENA + 208 * MiB;
constexpr size_t WS_QX = WS_ARENA;
constexpr size_t WS_P = WS_ARENA + 64 * MiB;
constexpr size_t WS_OC = WS_ARENA + 128 * MiB;
constexpr size_t WS_YS = WS_ARENA;
constexpr size_t WS_XG = WS_ARENA;
constexpr size_t WS_HE = WS_ARENA + 136 * MiB;
constexpr size_t WS_END = 512 * MiB;
static_assert(WS_HE + (size_t)MOE_MAXROWS * 256 * 2 <= WS_END && WS_YACT + (size_t)NTOK * 256 * 2 <= WS_END, "ws map");

constexpr size_t WS_W = 216 * MiB;
constexpr size_t WS_WIN_T = WS_W, WS_WOUT_T = WS_W + 9 * MiB, WS_WQ_T = WS_W + 13 * MiB, WS_WKV_T = WS_W + 17 * MiB, WS_WO_T = WS_W + 25 * MiB, WS_WGLU_T = WS_W + 29 * MiB, WS_WLA_T = WS_W + 29 * MiB + 512 * 1024, WS_WLX_T = WS_W + 29 * MiB + 768 * 1024, WS_WGU_T = WS_W + 30 * MiB, WS_WD_T = WS_W + 46 * MiB;
static_assert(WS_WD_T + (size_t)NEXP * D * DEXP * 2 <= WS_ARENA, "weights region");
constexpr int CW_BAR = 4096;

constexpr int LDS_BYTES = 147456;
constexpr int MISC_OFF = 131072 + 320;

#define XB_TMO      128
#define XB_XCNT(j)  (256  + 64 * (j))
#define XB_XSUB(j)  (1280 + 64 * (j))
#define XB_XGEN(j)  (2304 + 64 * (j))
#define XB_TOP      3328
#define XB_TOPGEN   3392
#define XCD_BAR_WORDS 3456
#define XB_SPIN_CAP (1u << 18)

__device__ __forceinline__ unsigned xb_ld(unsigned* p)              { return __hip_atomic_load(p, __ATOMIC_RELAXED, __HIP_MEMORY_SCOPE_AGENT); }
__device__ __forceinline__ unsigned xb_add(unsigned* p, unsigned v) { return __hip_atomic_fetch_add(p, v, __ATOMIC_RELAXED, __HIP_MEMORY_SCOPE_AGENT); }
__device__ __forceinline__ unsigned xb_xcc_id() { return (unsigned)__builtin_amdgcn_s_getreg((3 << 11) | 20) & 0xFu; }
#define XB_SPIN(cond, bar) do { unsigned _sp = 0; while (cond) { __builtin_amdgcn_s_sleep(1); \
    if ((++_sp & 255u) == 0u) { if (xb_ld(&(bar)[XB_TMO])) break; if (_sp > XB_SPIN_CAP) { atomicAdd(&(bar)[XB_TMO], 1u); break; } } } } while (0)

struct XcdBarrier { unsigned* bar; unsigned x; volatile LAS unsigned* st; };

__device__ __forceinline__ XcdBarrier xcd_barrier_post(unsigned* bar, volatile LAS unsigned* st) {
    XcdBarrier b; b.bar = bar; b.x = xb_xcc_id(); b.st = st;
    if (threadIdx.x == 0) (void)xb_add(&bar[XB_XCNT(b.x)], 1u);
    return b;
}
__device__ __forceinline__ void xcd_barrier_complete(unsigned* bar, unsigned x, unsigned& nloc, unsigned& nx) {
    const unsigned G = gridDim.x * gridDim.y * gridDim.z;
    unsigned sum, cnt, mine, sp = 0u;
    for (;;) {
        sum = 0u; cnt = 0u; mine = 0u;
#pragma unroll
        for (unsigned j = 0; j < 16; ++j) { const unsigned c = xb_ld(&bar[XB_XCNT(j)]); sum += c; cnt += (c > 0u) ? 1u : 0u; mine = (j == x) ? c : mine; }
        if (sum == G) break;
        __builtin_amdgcn_s_sleep(1);
        if ((++sp & 255u) == 0u) { if (xb_ld(&bar[XB_TMO])) break; if (sp > XB_SPIN_CAP) { atomicAdd(&bar[XB_TMO], 1u); break; } }
    }
    nloc = mine > 0u ? mine : 1u; nx = cnt > 0u ? cnt : 1u;
}
__device__ __forceinline__ void xcd_barrier(const XcdBarrier& b) {
    asm volatile("s_waitcnt vmcnt(0)" ::: "memory");
    __syncthreads();
    if (threadIdx.x == 0) {
        unsigned* bar = b.bar;
        __builtin_amdgcn_s_waitcnt(0);
        unsigned nloc = b.st[0], nx = b.st[1];
        if (nloc == 0u) { xcd_barrier_complete(bar, b.x, nloc, nx); b.st[0] = nloc; b.st[1] = nx; }
        const unsigned old = xb_add(&bar[XB_XSUB(b.x)], 1u);
        const unsigned gen = old / nloc;
        if (old + 1u == (gen + 1u) * nloc) {
            __builtin_amdgcn_fence(__ATOMIC_RELEASE, "agent");
            asm volatile("s_waitcnt vmcnt(0)" ::: "memory");
            const unsigned og = xb_add(&bar[XB_TOP], 1u);
            const unsigned tg = og / nx;
            if (og + 1u == (tg + 1u) * nx) xb_add(&bar[XB_TOPGEN], 1u);
            else XB_SPIN(xb_ld(&bar[XB_TOPGEN]) == tg, bar);
            __builtin_amdgcn_fence(__ATOMIC_ACQUIRE, "agent");
            xb_add(&bar[XB_XGEN(b.x)], 1u);
            asm volatile("s_waitcnt vmcnt(0)" ::: "memory");
        } else {
            XB_SPIN(xb_ld(&bar[XB_XGEN(b.x)]) == gen, bar);
            __builtin_amdgcn_fence(__ATOMIC_ACQUIRE, "agent");
            asm volatile("s_waitcnt vmcnt(0)" ::: "memory");
        }
    }
    __syncthreads();
}

__device__ __forceinline__ float wave_sum(float v) {
#pragma unroll
    for (int o = 1; o < 64; o <<= 1) v += __shfl_xor(v, o);
    return v;
}
__device__ __forceinline__ float wave_max(float v) {
#pragma unroll
    for (int o = 1; o < 64; o <<= 1) v = fmaxf(v, __shfl_xor(v, o));
    return v;
}
__device__ __forceinline__ float gelu_tanh(float x) {
    const float u = 0.7978845608028654f * (x + 0.044715f * x * x * x);
    return 0.5f * x * (1.0f + tanhf(u));
}
__device__ __forceinline__ float sigmoidf_(float x) { return 1.0f / (1.0f + expf(-x)); }

struct Ctx {
    const float* const* in;
    float* out;
    unsigned char* ws;
    LAS unsigned char* lds;
    int tid, lane, wid, G, bid;
};
template <class T> __device__ __forceinline__ T* wsp(const Ctx& c, size_t off) { return (T*)(c.ws + off); }
__device__ __forceinline__ Ctx fresh(const Ctx& c0) { Ctx c = c0; asm volatile("" : "+v"(c.tid)); c.lane = c.tid & 63; unsigned long long w = (unsigned long long)c.ws; asm volatile("" : "+s"(w)); c.ws = (unsigned char*)w;
    asm volatile("" : "+s"(c.bid), "+s"(c.G), "+s"(c.wid)); return c; }

__device__ __forceinline__ void row_load16(const f16* row, int lane, float (&v)[16]) {
    const f16x8 a = *(const f16x8*)(row + 8 * lane), b = *(const f16x8*)(row + 512 + 8 * lane);
#pragma unroll
    for (int i = 0; i < 8; ++i) { v[i] = (float)a[i]; v[8 + i] = (float)b[i]; }
}
__device__ __forceinline__ void row_store16(f16* row, int lane, const float (&v)[16]) {
    f16x8 a, b;
#pragma unroll
    for (int i = 0; i < 8; ++i) { a[i] = (f16)v[i]; b[i] = (f16)v[8 + i]; }
    *(f16x8*)(row + 8 * lane) = a; *(f16x8*)(row + 512 + 8 * lane) = b;
}
__device__ __forceinline__ void vec_load16(const float* p, int lane, float (&v)[16]) {
    const f32x4 a0 = *(const f32x4*)(p + 8 * lane), a1 = *(const f32x4*)(p + 8 * lane + 4), b0 = *(const f32x4*)(p + 512 + 8 * lane), b1 = *(const f32x4*)(p + 512 + 8 * lane + 4);
#pragma unroll
    for (int i = 0; i < 4; ++i) { v[i] = a0[i]; v[4 + i] = a1[i]; v[8 + i] = b0[i]; v[12 + i] = b1[i]; }
}
__device__ __forceinline__ void row_load16_nt(const f16* row, int lane, float (&v)[16]) {
    const f16x8 a = __builtin_nontemporal_load((const f16x8*)(row + 8 * lane)), b = __builtin_nontemporal_load((const f16x8*)(row + 512 + 8 * lane));
#pragma unroll
    for (int i = 0; i < 8; ++i) { v[i] = (float)a[i]; v[8 + i] = (float)b[i]; }
}
__device__ __forceinline__ void vec_load16_nt(const float* p, int lane, float (&v)[16]) {
    const f32x4 a0 = __builtin_nontemporal_load((const f32x4*)(p + 8 * lane)), a1 = __builtin_nontemporal_load((const f32x4*)(p + 8 * lane + 4)), b0 = __builtin_nontemporal_load((const f32x4*)(p + 512 + 8 * lane)), b1 = __builtin_nontemporal_load((const f32x4*)(p + 512 + 8 * lane + 4));
#pragma unroll
    for (int i = 0; i < 4; ++i) { v[i] = a0[i]; v[4 + i] = a1[i]; v[8 + i] = b0[i]; v[12 + i] = b1[i]; }
}
__device__ __forceinline__ void ln_row(float (&v)[16], const float* g, const float* b, int lane) {
    float s = 0.f;
#pragma unroll
    for (int i = 0; i < 16; ++i) s += v[i];
    const float mu = wave_sum(s) * (1.0f / 1024.0f);
    float q = 0.f;
#pragma unroll
    for (int i = 0; i < 16; ++i) { v[i] -= mu; q += v[i] * v[i]; }
    const float rstd = 1.0f / sqrtf(wave_sum(q) * (1.0f / 1024.0f) + 1e-5f);
    float gg[16], bb[16]; vec_load16(g, lane, gg); vec_load16(b, lane, bb);
#pragma unroll
    for (int i = 0; i < 16; ++i) v[i] = v[i] * rstd * gg[i] + bb[i];
}

namespace pg8 {
#define PG8_LAS __attribute__((address_space(3)))
typedef _Float16 bf16_t;
typedef _Float16 bf16x8 __attribute__((ext_vector_type(8)));
typedef float f32x4 __attribute__((ext_vector_type(4)));
typedef unsigned u32x4 __attribute__((ext_vector_type(4)));
constexpr int BM = 256, BK = 64, HALF = 128, HTB = HALF * BK * 2  , STAGE_BYTES = 8 * HTB, NXCD = 8, WGM = 8;

__host__ __device__ __forceinline__ int lds_byte(int r, int c) { const int st = (r >> 4) * 2 + (c >> 5), rr = r & 15, cc = c & 31, ob = rr * 64 + cc * 2; return st * 1024 + (ob ^ (((ob >> 9) & 1) << 5)); }
__host__ __device__ __forceinline__ void stage_rc(int b, int& R, int& C) { const int st = b / 1024, sb = b % 1024, swz = sb ^ (((sb >> 9) & 1) << 5); R = (st >> 1) * 16 + swz / 64; C = (st & 1) * 32 + (swz % 64) / 2; }
__host__ __device__ __forceinline__ int perm32(int rho) { const int n = rho >> 4, i = rho & 15; return 8 * (i >> 2) + 4 * n + (i & 3); }

struct Unit { int pm, pn; unsigned aoff, boff; int tag; int nt; };
struct Gemm { const bf16_t* A; const bf16_t* Bt; int K, lda, ldb; const int* arow = nullptr; };

struct StaticOrder {
    int nM, nN, nwg, G, c;
    __host__ __device__ void init(int M, int N, int G_, int c_) { nM = M / BM; nN = N / BM; nwg = nM * nN; G = G_; c = c_; }
    __host__ __device__ bool next(int i, Unit& u) const {
        const long L = (long)i * G + c; if (L >= nwg) return false;
        int wgid = (int)L; { const int q = nwg / NXCD, r = nwg % NXCD, xcd = wgid % NXCD, off = wgid / NXCD; wgid = (xcd < r ? xcd * (q + 1) : r * (q + 1) + (xcd - r) * q) + off; }
        const int nig = WGM * nN, gid = wgid / nig, fm = gid * WGM, gsz = (nM - fm) < WGM ? (nM - fm) : WGM;
        u.pm = fm + ((wgid % nig) % gsz); u.pn = (wgid % nig) / gsz; u.aoff = 0; u.boff = 0; u.tag = 0; u.nt = 0; return true;
    }
    __device__ __forceinline__ void a_ready(const Unit&) const {}
    __device__ __forceinline__ void done(const Unit&) const {}
};
template <class Epi, class Sched, bool ALIGN_EPI = false, bool SP2 = false, bool GATHER = false>
__device__ __forceinline__ void gemm_phase(PG8_LAS unsigned char* lds, const Gemm g, const Sched& S, const Epi& E, const int tid) {
    const int wid = __builtin_amdgcn_readfirstlane(tid >> 6), lane = tid & 63, wr = wid >> 2, wc = wid & 3, fr = lane & 15, fq = lane >> 4;
    const int ntg = g.K / BK; int nt = ntg;
    unsigned voffA[2], voffB[2];
#pragma unroll
    for (int i = 0; i < 2; ++i) { int R, C; stage_rc(tid * 16 + i * 8192, R, C); const int Rb = Epi::PERM ? ((R & ~31) + perm32(R & 31)) : R;
        voffA[i] = (unsigned)(R * g.lda + C) * 2u; voffB[i] = (unsigned)(Rb * g.ldb + C) * 2u; }
    const unsigned kstep = (unsigned)(BK * 2);
    const unsigned hstepA = (unsigned)HALF * g.lda * 2u, hstepB = (unsigned)HALF * g.ldb * 2u;
    static_assert(!GATHER || SP2, "GATHER is written for the SP2 loop only");
    const unsigned tstepA = GATHER ? 0u : 2u * hstepA, tstepB = 2u * hstepB;
    const unsigned ldsw = (unsigned)wid * 1024u;
    const int aoff = lds_byte(wr * 64 + fr, fq * 8), boff = lds_byte(wc * 32 + fr, fq * 8);
#define PG8_SA(b, h) (((b) * 2 + (h)) * HTB)
#define PG8_SB(b, h) ((4 + (b) * 2 + (h)) * HTB)
#define PG8_STAGE(bufoff, gbase, voff) do { _Pragma("unroll") for (int _i = 0; _i < 2; ++_i) \
        __builtin_amdgcn_global_load_lds((const unsigned*)((const char*)(gbase) + (voff)[_i]), (PG8_LAS unsigned*)(lds + (bufoff) + ldsw + _i * 8192), 16, 0, 0); } while (0)
#define PG8_STAGE_A(b, h, gbase, usenext) do { if constexpr (GATHER) { if (usenext) PG8_STAGE(PG8_SA(b, h), gbase, (h) ? nv1 : nv0); else PG8_STAGE(PG8_SA(b, h), gbase, (h) ? vo1 : vo0); } \
        else PG8_STAGE(PG8_SA(b, h), (gbase) + ((h) ? hstepA : 0u), voffA); } while (0)
#define PG8_LOADVO(u, o0, o1) do { _Pragma("unroll") for (int _i = 0; _i < 2; ++_i) { int R_, C_; stage_rc(tid * 16 + _i * 8192, R_, C_); \
        o0[_i] = (unsigned)g.arow[(u).pm * BM + R_] * (unsigned)(g.lda * 2) + (unsigned)C_ * 2u; o1[_i] = (unsigned)g.arow[(u).pm * BM + HALF + R_] * (unsigned)(g.lda * 2) + (unsigned)C_ * 2u; } } while (0)
    unsigned vo0[2] = {0u, 0u}, vo1[2] = {0u, 0u}, nv0[2] = {0u, 0u}, nv1[2] = {0u, 0u};
#define PG8_LDA(dst, b, h) do { _Pragma("unroll") for (int m = 0; m < 4; ++m) _Pragma("unroll") for (int k = 0; k < 2; ++k) dst[m][k] = *(const PG8_LAS bf16x8*)(lds + PG8_SA(b, h) + aoff + m * 2048 + k * 1024); } while (0)
#define PG8_LDB(dst, b, h) do { _Pragma("unroll") for (int n = 0; n < 2; ++n) _Pragma("unroll") for (int k = 0; k < 2; ++k) dst[n][k] = *(const PG8_LAS bf16x8*)(lds + PG8_SB(b, h) + boff + n * 2048 + k * 1024); } while (0)
#define PG8_MMA(ai, bj, At, Bt) do { __builtin_amdgcn_s_setprio(1); _Pragma("unroll") for (int m = 0; m < 4; ++m) _Pragma("unroll") for (int n = 0; n < 2; ++n) _Pragma("unroll") for (int k = 0; k < 2; ++k) \
        acc[ai][bj][m][n] = __builtin_amdgcn_mfma_f32_16x16x32_f16(Bt[n][k], At[m][k], acc[ai][bj][m][n], 0, 0, 0); __builtin_amdgcn_s_setprio(0); } while (0)
#define PG8_WAIT_V(n) asm volatile("s_waitcnt vmcnt(" #n ")" ::: "memory")
#define PG8_WAIT_L(n) asm volatile("s_waitcnt lgkmcnt(" #n ")" ::: "memory")
#define PG8_BAR __builtin_amdgcn_s_barrier()
#define PG8_SCHED __builtin_amdgcn_sched_barrier(0)
    Unit cur, nxt; int ui = 0;
    if (!S.next(0, cur)) return;
    nt = cur.nt ? cur.nt : ntg;
    f32x4 acc[2][2][4][2];
#pragma unroll
    for (int a = 0; a < 2; ++a)
#pragma unroll
        for (int b = 0; b < 2; ++b)
#pragma unroll
            for (int m = 0; m < 4; ++m)
#pragma unroll
                for (int n = 0; n < 2; ++n) acc[a][b][m][n] = (f32x4){0.f, 0.f, 0.f, 0.f};
    bf16x8 At[4][2], B0[2][2], B1[2][2];
    const char* cA = (const char*)g.A + (size_t)cur.pm * tstepA + cur.aoff; const char* cB = (const char*)g.Bt + (size_t)cur.pn * tstepB + cur.boff;
    S.a_ready(cur);
    if constexpr (SP2) {
        if constexpr (GATHER) PG8_LOADVO(cur, vo0, vo1);
        PG8_STAGE(PG8_SB(0, 0), cB, voffB); PG8_STAGE(PG8_SB(0, 1), cB + hstepB, voffB); PG8_STAGE_A(0, 0, cA, false); PG8_STAGE_A(0, 1, cA, false);
        if (wr == 1) PG8_BAR;
        PG8_WAIT_V(2); PG8_BAR;
        PG8_STAGE(PG8_SB(1, 0), cB + kstep, voffB); PG8_STAGE_A(1, 0, cA + kstep, false); PG8_STAGE(PG8_SB(1, 1), cB + hstepB + kstep, voffB);
        PG8_WAIT_V(6); PG8_BAR;
    } else {
        PG8_STAGE(PG8_SB(0, 0), cB, voffB); PG8_STAGE(PG8_SA(0, 0), cA, voffA); PG8_STAGE(PG8_SB(0, 1), cB + hstepB, voffB); PG8_STAGE(PG8_SA(0, 1), cA + hstepA, voffA);
        if (wr == 1) PG8_BAR;
        PG8_WAIT_V(4); PG8_BAR;
        PG8_STAGE(PG8_SB(1, 0), cB + kstep, voffB); PG8_STAGE(PG8_SA(1, 0), cA + kstep, voffA); PG8_STAGE(PG8_SB(1, 1), cB + hstepB + kstep, voffB);
        PG8_WAIT_V(6); PG8_BAR;
    }
    for (;;) {
        const bool has_next = S.next(ui + 1, nxt);
        if constexpr (GATHER) { if (has_next) PG8_LOADVO(nxt, nv0, nv1); else { nv0[0] = vo0[0]; nv0[1] = vo0[1]; nv1[0] = vo1[0]; nv1[1] = vo1[1]; } }
        const char* nA = has_next ? (const char*)g.A + (size_t)nxt.pm * tstepA + nxt.aoff : cA; const char* nB = has_next ? (const char*)g.Bt + (size_t)nxt.pn * tstepB + nxt.boff : cB;
#pragma nounroll
        for (int t = 0; t < nt; t += 2) {
            const bool last = (t == nt - 2);
            const char* a1 = cA + (size_t)(t + 1) * kstep;
            const char* a2 = last ? nA : cA + (size_t)(t + 2) * kstep; const char* b2 = last ? nB : cB + (size_t)(t + 2) * kstep;
            const char* a3 = a2 + kstep; const char* b3 = b2 + kstep;
            if (last && has_next) S.a_ready(nxt);
            if constexpr (SP2) {
            PG8_LDB(B0, 0, 0); PG8_LDB(B1, 0, 1); PG8_SCHED; PG8_LDA(At, 0, 0); PG8_STAGE_A(1, 1, a1, false);
            PG8_WAIT_V(8); PG8_WAIT_L(0); PG8_BAR; PG8_MMA(0, 0, At, B0); PG8_MMA(0, 1, At, B1); PG8_BAR; PG8_SCHED;
            PG8_LDA(At, 0, 1); PG8_STAGE(PG8_SB(0, 0), b2, voffB); PG8_STAGE(PG8_SB(0, 1), b2 + hstepB, voffB); PG8_STAGE_A(0, 0, a2, last);
            PG8_WAIT_V(8); PG8_WAIT_L(0); PG8_BAR; PG8_MMA(1, 0, At, B0); PG8_MMA(1, 1, At, B1); PG8_BAR; PG8_SCHED;
            PG8_LDB(B0, 1, 0); PG8_LDB(B1, 1, 1); PG8_SCHED; PG8_LDA(At, 1, 0); PG8_STAGE_A(0, 1, a2, last);
            PG8_WAIT_V(8); PG8_WAIT_L(0); PG8_BAR; PG8_MMA(0, 0, At, B0); PG8_MMA(0, 1, At, B1); PG8_BAR; PG8_SCHED;
            PG8_LDA(At, 1, 1); PG8_STAGE(PG8_SB(1, 0), b3, voffB); PG8_STAGE(PG8_SB(1, 1), b3 + hstepB, voffB); PG8_STAGE_A(1, 0, a3, last);
            PG8_WAIT_V(8); PG8_WAIT_L(0); PG8_BAR; PG8_MMA(1, 0, At, B0); PG8_MMA(1, 1, At, B1); PG8_BAR; PG8_SCHED;
            } else {
            PG8_LDB(B0, 0, 0); PG8_SCHED; PG8_LDA(At, 0, 0); PG8_STAGE(PG8_SA(1, 1), a1 + hstepA, voffA);
            PG8_WAIT_L(8); PG8_BAR; PG8_WAIT_L(0); PG8_MMA(0, 0, At, B0); PG8_BAR; PG8_SCHED;
            PG8_LDB(B1, 0, 1); PG8_STAGE(PG8_SB(0, 0), b2, voffB);
            PG8_BAR; PG8_WAIT_L(0); PG8_MMA(0, 1, At, B1); PG8_BAR;
            PG8_LDA(At, 0, 1); PG8_STAGE(PG8_SA(0, 0), a2, voffA);
            PG8_BAR; PG8_WAIT_L(0); PG8_MMA(1, 0, At, B0); PG8_BAR; PG8_SCHED;
            PG8_STAGE(PG8_SB(0, 1), b2 + hstepB, voffB);
            PG8_WAIT_V(6); PG8_BAR; PG8_MMA(1, 1, At, B1); PG8_BAR;
            PG8_LDB(B0, 1, 0); PG8_SCHED; PG8_LDA(At, 1, 0); PG8_STAGE(PG8_SA(0, 1), a2 + hstepA, voffA);
            PG8_WAIT_L(8); PG8_BAR; PG8_WAIT_L(0); PG8_MMA(0, 0, At, B0); PG8_BAR; PG8_SCHED;
            PG8_LDB(B1, 1, 1); PG8_STAGE(PG8_SB(1, 0), b3, voffB);
            PG8_BAR; PG8_WAIT_L(0); PG8_MMA(0, 1, At, B1); PG8_BAR;
            PG8_LDA(At, 1, 1); PG8_STAGE(PG8_SA(1, 0), a3, voffA);
            PG8_BAR; PG8_WAIT_L(0); PG8_MMA(1, 0, At, B0); PG8_BAR; PG8_SCHED;
            PG8_STAGE(PG8_SB(1, 1), b3 + hstepB, voffB);
            PG8_WAIT_V(6); PG8_BAR; PG8_MMA(1, 1, At, B1); PG8_BAR;
            }
        }
        if constexpr (ALIGN_EPI) { if (wr == 0) PG8_BAR; }
        if constexpr (!Epi::AFTER_DRAIN) { E(acc, cur, wr, wc, fr, fq); S.done(cur); }
        if (!has_next) break;
#pragma unroll
        for (int a = 0; a < 2; ++a)
#pragma unroll
            for (int b = 0; b < 2; ++b)
#pragma unroll
                for (int m = 0; m < 4; ++m)
#pragma unroll
                    for (int n = 0; n < 2; ++n) acc[a][b][m][n] = (f32x4){0.f, 0.f, 0.f, 0.f};
        cur = nxt; cA = nA; cB = nB; ++ui; nt = cur.nt ? cur.nt : ntg;
        if constexpr (GATHER) { vo0[0] = nv0[0]; vo0[1] = nv0[1]; vo1[0] = nv1[0]; vo1[1] = nv1[1]; }
        if constexpr (ALIGN_EPI) { if (wr == 1) PG8_BAR; }
    }
    PG8_WAIT_V(0);
    if constexpr (!ALIGN_EPI) { if (wr == 0) PG8_BAR; }
    PG8_BAR;
    if constexpr (Epi::AFTER_DRAIN) { E.fused(acc, cur, wr, wc, fr, fq, lds, wid, lane); S.done(cur); }
#undef PG8_SA
#undef PG8_SB
#undef PG8_STAGE
#undef PG8_STAGE_A
#undef PG8_LOADVO
#undef PG8_LDA
#undef PG8_LDB
#undef PG8_MMA
#undef PG8_WAIT_V
#undef PG8_WAIT_L
#undef PG8_BAR
#undef PG8_SCHED
}
}
namespace pg8 {
#define PG8_EPI_ROWS(...) \
    _Pragma("unroll") for (int ai = 0; ai < 2; ++ai) _Pragma("unroll") for (int m = 0; m < 4; ++m) { const int rt = ai * HALF + wr * 64 + m * 16 + fr; __VA_ARGS__ }
__device__ __forceinline__ bf16x8 pack8(const f32x4 a, const f32x4 b) { bf16x8 o; o[0] = (bf16_t)a[0]; o[1] = (bf16_t)a[1]; o[2] = (bf16_t)a[2]; o[3] = (bf16_t)a[3]; o[4] = (bf16_t)b[0]; o[5] = (bf16_t)b[1]; o[6] = (bf16_t)b[2]; o[7] = (bf16_t)b[3]; return o; }
struct EStore { static constexpr bool PERM = true, AFTER_DRAIN = false; bf16_t* C; int ldc;
    __device__ __forceinline__ void operator()(const f32x4 (&acc)[2][2][4][2], const Unit& u, int wr, int wc, int fr, int fq) const {
        PG8_EPI_ROWS( bf16_t* rp = C + (size_t)(u.pm * BM + rt) * ldc + u.pn * BM + wc * 32 + 8 * fq;
            _Pragma("unroll") for (int bj = 0; bj < 2; ++bj) *(bf16x8*)(rp + bj * HALF) = pack8(acc[ai][bj][m][0], acc[ai][bj][m][1]); ) } };
struct EStoreKV { static constexpr bool PERM = true, AFTER_DRAIN = false; bf16_t* KM; bf16_t* VM;
    __device__ __forceinline__ void operator()(const f32x4 (&acc)[2][2][4][2], const Unit& u, int wr, int wc, int fr, int fq) const {
        const int mat = u.pn >> 2, j = u.pn & 3; bf16_t* C = KM + (size_t)(mat & 1) * ((WS_VM - WS_KM) / 2) + (size_t)(mat >> 1) * NMEM * D;
        PG8_EPI_ROWS( bf16_t* rp = C + (size_t)(u.pm * BM + rt) * D + j * BM + wc * 32 + 8 * fq;
            _Pragma("unroll") for (int bj = 0; bj < 2; ++bj) *(bf16x8*)(rp + bj * HALF) = pack8(acc[ai][bj][m][0], acc[ai][bj][m][1]); ) } };
struct EResid { static constexpr bool PERM = true, AFTER_DRAIN = false; bf16_t* H;
    __device__ __forceinline__ void operator()(const f32x4 (&acc)[2][2][4][2], const Unit& u, int wr, int wc, int fr, int fq) const {
        PG8_EPI_ROWS( bf16_t* rp = H + (size_t)(u.pm * BM + rt) * D + u.pn * BM + wc * 32 + 8 * fq;
            _Pragma("unroll") for (int bj = 0; bj < 2; ++bj) { const bf16x8 h = *(const bf16x8*)(rp + bj * HALF); f32x4 a = acc[ai][bj][m][0], b = acc[ai][bj][m][1];
                _Pragma("unroll") for (int e = 0; e < 4; ++e) { a[e] += ALPHA * (float)h[e]; b[e] += ALPHA * (float)h[4 + e]; }
                *(bf16x8*)(rp + bj * HALF) = pack8(a, b); } ) } };
struct EResidStats { static constexpr bool PERM = true, AFTER_DRAIN = false; bf16_t* H; float* ST; PG8_LAS float* X;
    __device__ __forceinline__ void operator()(f32x4 (&acc)[2][2][4][2], const Unit& u, int wr, int wc, int fr_, int fq) const {
        int fr = fr_; asm volatile("" : "+v"(fr));
        PG8_EPI_ROWS( bf16_t* rp = H + (size_t)(u.pm * BM + rt) * D + u.pn * BM + wc * 32 + 8 * fq; float sm = 0.f, sq = 0.f;
            _Pragma("unroll") for (int bj = 0; bj < 2; ++bj) { const bf16x8 h = *(const bf16x8*)(rp + bj * HALF); f32x4 a = acc[ai][bj][m][0], b = acc[ai][bj][m][1];
                _Pragma("unroll") for (int e = 0; e < 4; ++e) { a[e] += ALPHA * (float)h[e]; b[e] += ALPHA * (float)h[4 + e]; sm += a[e] + b[e]; sq += a[e] * a[e] + b[e] * b[e]; }
                *(bf16x8*)(rp + bj * HALF) = pack8(a, b); }
            sm += __shfl_xor(sm, 16); sm += __shfl_xor(sm, 32); sq += __shfl_xor(sq, 16); sq += __shfl_xor(sq, 32);
            if (fq == 0) { X[(rt * 4 + wc) * 2] = sm; X[(rt * 4 + wc) * 2 + 1] = sq; } )
        asm volatile("s_waitcnt lgkmcnt(0)\n\ts_barrier" ::: "memory");
        { const int t = wr * 0 + (int)(threadIdx.x);
          if (t < 256) { const f32x4 p0 = *(const PG8_LAS f32x4*)(X + t * 8), p1 = *(const PG8_LAS f32x4*)(X + t * 8 + 4);
              float* o = ST + ((size_t)(u.pm * BM + t) * 4 + u.pn) * 2; o[0] = (p0[0] + p0[2]) + (p1[0] + p1[2]); o[1] = (p0[1] + p0[3]) + (p1[1] + p1[3]); } }
    } };
__device__ __forceinline__ void ln_stats4(const float* ST, size_t row, float& mu, float& rstd) {
    const f32x4 p0 = *(const f32x4*)(ST + row * 8), p1 = *(const f32x4*)(ST + row * 8 + 4);
    const float S = (p0[0] + p0[2]) + (p1[0] + p1[2]), Q = (p0[1] + p0[3]) + (p1[1] + p1[3]); mu = S * (1.0f / 1024.0f);
    const float var = fmaxf(Q * (1.0f / 1024.0f) - mu * mu, 0.f); rstd = 1.0f / sqrtf(var + 1e-5f); }
struct EStoreLN { static constexpr bool PERM = true, AFTER_DRAIN = false; bf16_t* C; int ldc; const float* ST; const float* s1; const float* s2;
    __device__ __forceinline__ void operator()(const f32x4 (&acc)[2][2][4][2], const Unit& u, int wr, int wc, int fr, int fq) const {
        const int c0 = u.pn * BM + wc * 32 + 8 * fq;
        PG8_EPI_ROWS( const size_t row = (size_t)(u.pm * BM + rt); float mu, rs; ln_stats4(ST, row, mu, rs); const float mr = -mu * rs;
            _Pragma("unroll") for (int bj = 0; bj < 2; ++bj) { const int col = c0 + bj * HALF; const f32x4 a1 = *(const f32x4*)(s1 + col), b1 = *(const f32x4*)(s1 + col + 4), a2 = *(const f32x4*)(s2 + col), b2 = *(const f32x4*)(s2 + col + 4);
                f32x4 a = acc[ai][bj][m][0], b = acc[ai][bj][m][1];
                _Pragma("unroll") for (int e = 0; e < 4; ++e) { a[e] = rs * a[e] + (mr * a1[e] + a2[e]); b[e] = rs * b[e] + (mr * b1[e] + b2[e]); }
                *(bf16x8*)(C + row * ldc + col) = pack8(a, b); } ) } };
struct EResidLN { static constexpr bool PERM = true, AFTER_DRAIN = false; bf16_t* H; const float* ST; const float* g; const float* b;
    __device__ __forceinline__ void operator()(const f32x4 (&acc)[2][2][4][2], const Unit& u, int wr, int wc, int fr, int fq) const {
        const int c0 = u.pn * BM + wc * 32 + 8 * fq;
        PG8_EPI_ROWS( const size_t row = (size_t)(u.pm * BM + rt); float mu, rs; ln_stats4(ST, row, mu, rs); rs *= ALPHA;
            _Pragma("unroll") for (int bj = 0; bj < 2; ++bj) { const int col = c0 + bj * HALF; bf16_t* rp = H + row * D + col; const bf16x8 h = *(const bf16x8*)rp;
                const f32x4 g0 = *(const f32x4*)(g + col), g1 = *(const f32x4*)(g + col + 4), b0 = *(const f32x4*)(b + col), b1 = *(const f32x4*)(b + col + 4);
                f32x4 a = acc[ai][bj][m][0], bq = acc[ai][bj][m][1];
                _Pragma("unroll") for (int e = 0; e < 4; ++e) { a[e] += ((float)h[e] - mu) * rs * g0[e] + ALPHA * b0[e]; bq[e] += ((float)h[4 + e] - mu) * rs * g1[e] + ALPHA * b1[e]; }
                *(bf16x8*)rp = pack8(a, bq); } ) } };
struct EGlu { static constexpr bool PERM = true, AFTER_DRAIN = false; const bf16_t* yact; const float* bg; bf16_t* Y; PG8_LAS float* X;
    __device__ __forceinline__ void operator()(f32x4 (&acc)[2][2][4][2], const Unit& u, int wr, int wc, int fr_, int fq) const {
        int fr = fr_; asm volatile("" : "+v"(fr));
        PG8_EPI_ROWS( const size_t row = (size_t)(u.pm * BM + rt); float ss = 0.f;
            _Pragma("unroll") for (int bj = 0; bj < 2; ++bj) { const int col = bj * HALF + wc * 32 + 8 * fq; const bf16x8 y = *(const bf16x8*)(yact + row * 256 + col);
                const f32x4 b0 = *(const f32x4*)(bg + col), b1 = *(const f32x4*)(bg + col + 4); f32x4 a = acc[ai][bj][m][0] + b0, b = acc[ai][bj][m][1] + b1;
                _Pragma("unroll") for (int e = 0; e < 4; ++e) { a[e] = (float)y[e] * __builtin_amdgcn_rcpf(1.0f + __expf(-a[e])); b[e] = (float)y[4 + e] * __builtin_amdgcn_rcpf(1.0f + __expf(-b[e])); ss += a[e] * a[e] + b[e] * b[e]; }
                acc[ai][bj][m][0] = a; acc[ai][bj][m][1] = b; }
            ss += __shfl_xor(ss, 16); ss += __shfl_xor(ss, 32); if (fq == 0) X[rt * 4 + wc] = ss; )
        asm volatile("s_waitcnt lgkmcnt(0)\n\ts_barrier" ::: "memory");
        PG8_EPI_ROWS( const size_t row = (size_t)(u.pm * BM + rt); const f32x4 sv = *(const PG8_LAS f32x4*)(X + rt * 4);
            const float rs = 1.0f / sqrtf(((sv[0] + sv[1]) + (sv[2] + sv[3])) * (1.0f / 256.0f) + 1e-6f);
            _Pragma("unroll") for (int bj = 0; bj < 2; ++bj) *(bf16x8*)(Y + row * D + 512 + bj * HALF + wc * 32 + 8 * fq) = pack8(acc[ai][bj][m][0] * rs, acc[ai][bj][m][1] * rs); ) } };
struct ESiluMul { static constexpr bool PERM = true, AFTER_DRAIN = false; bf16_t* HE;
    __device__ __forceinline__ void operator()(const f32x4 (&acc)[2][2][4][2], const Unit& u, int wr, int wc, int fr, int fq) const {
        const int jb = u.pn & 1;
        PG8_EPI_ROWS( f32x4 a = acc[ai][0][m][0], b = acc[ai][0][m][1]; const f32x4 ua = acc[ai][1][m][0], ub = acc[ai][1][m][1];
            _Pragma("unroll") for (int e = 0; e < 4; ++e) { a[e] = a[e] * __builtin_amdgcn_rcpf(1.0f + __expf(-a[e])) * ua[e]; b[e] = b[e] * __builtin_amdgcn_rcpf(1.0f + __expf(-b[e])) * ub[e]; }
            *(bf16x8*)(HE + (size_t)(u.pm * BM + rt) * DEXP + jb * HALF + wc * 32 + 8 * fq) = pack8(a, b); ) } };
struct EScatter { static constexpr bool PERM = true, AFTER_DRAIN = false; const int* rowtok; const float* roww; bf16_t* YS;
    __device__ __forceinline__ void operator()(const f32x4 (&acc)[2][2][4][2], const Unit& u, int wr, int wc, int fr, int fq) const {
        const int j = u.pn & 3;
        PG8_EPI_ROWS( const int lr = u.pm * BM + rt; const int r = rowtok[lr]; const float w = roww[lr];
            if (r >= 0) { bf16_t* rp = YS + (size_t)r * D + j * BM + wc * 32 + 8 * fq;
                _Pragma("unroll") for (int bj = 0; bj < 2; ++bj) *(bf16x8*)(rp + bj * HALF) = pack8(acc[ai][bj][m][0] * w, acc[ai][bj][m][1] * w); } ) } };
struct MoeOrder { const int* tx; int NJ, G, c, nwg;
    __device__ __forceinline__ void init(const int* tx_, int NJ_, int G_, int c_) { tx = tx_; NJ = NJ_; G = G_; c = c_; nwg = __builtin_amdgcn_readfirstlane(tx_[0]) * NJ_; }
    __device__ __forceinline__ bool next(int i, Unit& u) const {
        const long L = (long)i * G + c; if (L >= nwg) return false;
        int wgid = (int)L; { const int q = nwg / NXCD, r = nwg % NXCD, xcd = wgid % NXCD, off = wgid / NXCD; wgid = (xcd < r ? xcd * (q + 1) : r * (q + 1) + (xcd - r) * q) + off; }
        u.pm = wgid / NJ; u.pn = __builtin_amdgcn_readfirstlane(tx[1 + u.pm]) * NJ + (wgid % NJ); u.aoff = 0; u.boff = 0; u.tag = 0; u.nt = 0; return true; }
    __device__ __forceinline__ void a_ready(const Unit&) const {}
    __device__ __forceinline__ void done(const Unit&) const {}
};
struct EStoreWin { static constexpr bool PERM = true, AFTER_DRAIN = false; bf16_t* Z; bf16_t* UG;
    __device__ __forceinline__ void operator()(const f32x4 (&acc)[2][2][4][2], const Unit& u, int wr, int wc, int fr, int fq) const {
        if (u.pn != 6) {
            PG8_EPI_ROWS( bf16_t* rp = Z + (size_t)(u.pm * BM + rt) * DIN + u.pn * BM + wc * 32 + 8 * fq;
                _Pragma("unroll") for (int bj = 0; bj < 2; ++bj) *(bf16x8*)(rp + bj * HALF) = pack8(acc[ai][bj][m][0], acc[ai][bj][m][1]); )
        } else {
            PG8_EPI_ROWS( const int n = u.pm * BM + rt; const size_t R = (size_t)(n >> 11) * 64 + ((n & 2047) >> 5); const int s = n & 31;
                _Pragma("unroll") for (int bj = 0; bj < 2; ++bj) { const int col = bj * HALF + wc * 32 + 8 * fq;
                    *(bf16x8*)(UG + ((size_t)(col >> 4) * 1024 + R) * 640 + s * 16 + (col & 15)) = pack8(acc[ai][bj][m][0], acc[ai][bj][m][1]); } )
        } } };
struct ES5 { static constexpr bool PERM = true, AFTER_DRAIN = false; const bf16_t* UG; bf16_t* YA; const float* dsk; const float* logdt;
    __device__ __forceinline__ void operator()(const f32x4 (&acc)[2][2][4][2], const Unit& u, int wr, int wc, int fr, int fq) const {
        const int g = u.tag; const float sg = __expf(logdt[g]);
        PG8_EPI_ROWS( const int Rg = (u.pm & 3) * BM + rt; const size_t tok0 = (size_t)(Rg >> 6) * SEQ + (Rg & 63) * 32;
            _Pragma("unroll") for (int bj = 0; bj < 2; ++bj) { const int col = (u.pn & 1) * BM + bj * HALF + wc * 32 + 8 * fq, t = col >> 4, h0 = col & 15;
                const bf16x8 uv = *(const bf16x8*)(UG + ((size_t)g * 1024 + Rg) * 640 + col); const f32x4 d0 = *(const f32x4*)(dsk + g * 16 + h0), d1 = *(const f32x4*)(dsk + g * 16 + h0 + 4);
                f32x4 a = acc[ai][bj][m][0], b = acc[ai][bj][m][1];
                _Pragma("unroll") for (int e = 0; e < 4; ++e) { float x = sg * a[e] + d0[e] * (float)uv[e]; a[e] = x * __builtin_amdgcn_rcpf(1.0f + __expf(-1.5957691216f * (x + 0.044715f * x * x * x)));
                    x = sg * b[e] + d1[e] * (float)uv[4 + e]; b[e] = x * __builtin_amdgcn_rcpf(1.0f + __expf(-1.5957691216f * (x + 0.044715f * x * x * x))); }
                *(bf16x8*)(YA + (tok0 + t) * 256 + g * 16 + h0) = pack8(a, b); } ) } };
struct S5Order { int G, c;
    __device__ __forceinline__ bool next(int i, Unit& u) const {
        const int L = i * G + c; if (L >= 128) return false; const int g = L >> 3;
        u.pm = g * 4 + ((L >> 1) & 3); u.pn = g * 2 + (L & 1); u.aoff = 0; u.boff = 0; u.tag = g; u.nt = 0; return true; }
    __device__ __forceinline__ void a_ready(const Unit&) const {}
    __device__ __forceinline__ void done(const Unit&) const {}
};
__device__ __forceinline__ int xcd_remap(int wgid, int nwg) { const int q = nwg / NXCD, r = nwg % NXCD, xcd = wgid % NXCD, off = wgid / NXCD; return (xcd < r ? xcd * (q + 1) : r * (q + 1) + (xcd - r) * q) + off; }
struct KvOrder { int G, c;
    __device__ __forceinline__ bool next(int i, Unit& u) const {
        const int L = i * G + c; if (L >= 256) return false;
        const int l = L >> 7, isv = (L >> 6) & 1, r = L & 63; u.tag = l * 2 + isv; u.nt = 0;
        if (!isv) { u.pm = r >> 2; u.pn = r & 3; u.aoff = (unsigned)WS_MEM16; u.boff = (unsigned)(WS_WKV_T + (size_t)(2 * l) * D * D * 2); }
        else      { u.pm = r & 3; u.pn = r >> 2; u.aoff = (unsigned)(WS_WKV_T + (size_t)(2 * l + 1) * D * D * 2); u.boff = (unsigned)WS_MEM16; }
        return true; }
    __device__ __forceinline__ void a_ready(const Unit&) const {}
    __device__ __forceinline__ void done(const Unit&) const {}
};
struct EStoreKV2 { static constexpr bool PERM = true, AFTER_DRAIN = false; bf16_t* KM; bf16_t* VT;
    __device__ __forceinline__ void operator()(const f32x4 (&acc)[2][2][4][2], const Unit& u, int wr, int wc, int fr, int fq) const {
        const int l = u.tag >> 1, isv = u.tag & 1;
        bf16_t* C = KM + (size_t)isv * ((WS_VM - WS_KM) / 2) + (size_t)l * NMEM * D + (isv ? (size_t)(u.pn >> 2) * D * D : (size_t)0);
        const int ct = isv ? (u.pn & 3) : u.pn;
        PG8_EPI_ROWS( bf16_t* rp = C + (size_t)(u.pm * BM + rt) * D + ct * BM + wc * 32 + 8 * fq;
            _Pragma("unroll") for (int bj = 0; bj < 2; ++bj) *(bf16x8*)(rp + bj * HALF) = pack8(acc[ai][bj][m][0], acc[ai][bj][m][1]); ) } };
struct XsOrder { int G, c;
    __device__ __forceinline__ bool next(int i, Unit& u) const {
        const int L = i * G + c; if (L >= 512) return false; const int w = xcd_remap(L, 512);
        u.pm = w >> 2; u.tag = w & 3; u.pn = u.pm >> 3; u.aoff = u.tag * 512; u.boff = u.tag * 512; u.nt = 0; return true; }
    __device__ __forceinline__ void a_ready(const Unit&) const {}
    __device__ __forceinline__ void done(const Unit&) const {}
};
struct XoOrder { int G, c;
    __device__ __forceinline__ bool next(int i, Unit& u) const {
        const int L = i * G + c; if (L >= 512) return false; const int w = xcd_remap(L, 512);
        u.pm = w >> 2; u.tag = w & 3; u.pn = u.tag; u.aoff = u.tag * 512; u.boff = (u.pm >> 3) * 512; u.nt = 0; return true; }
    __device__ __forceinline__ void a_ready(const Unit&) const {}
    __device__ __forceinline__ void done(const Unit&) const {}
};
struct ESoftmaxP { static constexpr bool PERM = true, AFTER_DRAIN = false; bf16_t* P; PG8_LAS float* X;
    __device__ __forceinline__ void operator()(f32x4 (&acc)[2][2][4][2], const Unit& u, int wr, int wc, int fr_, int fq) const {
        int fr = fr_; asm volatile("" : "+v"(fr));
        PG8_EPI_ROWS( float v = -3.0e38f;
            _Pragma("unroll") for (int bj = 0; bj < 2; ++bj) _Pragma("unroll") for (int n = 0; n < 2; ++n) _Pragma("unroll") for (int e = 0; e < 4; ++e) v = fmaxf(v, acc[ai][bj][m][n][e]);
            v = fmaxf(v, __shfl_xor(v, 16)); v = fmaxf(v, __shfl_xor(v, 32)); if (fq == 0) X[rt * 4 + wc] = v; )
        asm volatile("s_waitcnt lgkmcnt(0)\n\ts_barrier" ::: "memory");
        PG8_EPI_ROWS( const f32x4 mv = *(const PG8_LAS f32x4*)(X + rt * 4); const float mx = fmaxf(fmaxf(mv[0], mv[1]), fmaxf(mv[2], mv[3])); float sm = 0.f;
            _Pragma("unroll") for (int bj = 0; bj < 2; ++bj) _Pragma("unroll") for (int n = 0; n < 2; ++n) _Pragma("unroll") for (int e = 0; e < 4; ++e) { const float p = __builtin_amdgcn_exp2f(acc[ai][bj][m][n][e] - mx); acc[ai][bj][m][n][e] = p; sm += p; }
            sm += __shfl_xor(sm, 16); sm += __shfl_xor(sm, 32); if (fq == 0) X[1024 + rt * 4 + wc] = sm; )
        asm volatile("s_waitcnt lgkmcnt(0)\n\ts_barrier" ::: "memory");
        PG8_EPI_ROWS( const f32x4 sv = *(const PG8_LAS f32x4*)(X + 1024 + rt * 4); const float inv = 1.0f / ((sv[0] + sv[1]) + (sv[2] + sv[3]));
            bf16_t* rp = P + (size_t)(u.pm * BM + rt) * D + u.tag * BM + wc * 32 + 8 * fq;
            _Pragma("unroll") for (int bj = 0; bj < 2; ++bj) *(bf16x8*)(rp + bj * HALF) = pack8(acc[ai][bj][m][0] * inv, acc[ai][bj][m][1] * inv); )
    } };
struct ChainOrder { int G, c, l;
    __device__ __forceinline__ bool next(int i, Unit& u) const {
        if (i >= 4 || c >= 256) return false;
        const int v = (G % 8 == 0) ? (c % 8) * (G / 8) + c / 8 : c, tr = 2 * v + (i & 1), ty = 1 + (i >> 1), hh = tr & 3; u.pm = tr >> 2; const int b = u.pm >> 3; u.tag = ty | (hh << 2); u.nt = 4;
        if (ty == 1) { u.pn = b; u.aoff = (unsigned)(WS_QX + hh * 512); u.boff = (unsigned)(WS_KM + (size_t)l * NMEM * D * 2 + hh * 512); }
        else         { u.pn = hh; u.aoff = (unsigned)(WS_P + hh * 512); u.boff = (unsigned)(WS_VM + (size_t)l * NMEM * D * 2 + ((size_t)(b >> 2) * D * D + (b & 3) * 256) * 2); }
        return true; }
    __device__ __forceinline__ void a_ready(const Unit&) const {}
    __device__ __forceinline__ void done(const Unit&) const {}
};
struct EChain { static constexpr bool PERM = true, AFTER_DRAIN = false; ESoftmaxP e1; EStore e2;
    __device__ __forceinline__ void operator()(f32x4 (&acc)[2][2][4][2], const Unit& u, int wr, int wc, int fr, int fq) const {
        const int ty = u.tag & 3; Unit v = u; v.tag = u.tag >> 2;
        if (ty == 1) e1(acc, v, wr, wc, fr, fq); else e2(acc, v, wr, wc, fr, fq); } };
struct WinKvOrder { StaticOrder so; int lay;
    __device__ __forceinline__ bool next(int i, Unit& u) const {
        if (so.next(i, u)) { u.aoff = (unsigned)WS_H; u.boff = (unsigned)(WS_WIN_T + (size_t)lay * DIN * D * 2); u.tag = 0; return true; }
        const int L = i * so.G + so.c - so.nwg; if (L < 0 || L >= 128) return false;
        const int isv = L >> 6, r = L & 63, l = lay; u.tag = 1 | ((l * 2 + isv) << 1); u.nt = 0;
        if (!isv) { u.pm = r >> 2; u.pn = r & 3; u.aoff = (unsigned)WS_MEM16; u.boff = (unsigned)(WS_WKV_T + (size_t)(2 * l) * D * D * 2); }
        else      { u.pm = r & 3; u.pn = r >> 2; u.aoff = (unsigned)(WS_WKV_T + (size_t)(2 * l + 1) * D * D * 2); u.boff = (unsigned)WS_MEM16; }
        return true; }
    __device__ __forceinline__ void a_ready(const Unit&) const {}
    __device__ __forceinline__ void done(const Unit&) const {}
};
struct EWinKv { static constexpr bool PERM = true, AFTER_DRAIN = false; EStoreWin e0; EStoreKV2 e1;
    __device__ __forceinline__ void operator()(const f32x4 (&acc)[2][2][4][2], const Unit& u, int wr, int wc, int fr, int fq) const {
        if ((u.tag & 1) == 0) e0(acc, u, wr, wc, fr, fq); else { Unit v = u; v.tag = u.tag >> 1; e1(acc, v, wr, wc, fr, fq); } } };
}

__device__ __forceinline__ void tr_item(const float* W, int ldw, int k0, int n0s, f16* WT, int ldt, int n0d, float cs, const float* ks, LAS float* scr, int lane) {
#pragma unroll
    for (int i = 0; i < 8; ++i) { const int kk = 8 * i + (lane >> 3), nq = (lane & 7) * 4;
        f32x4 v = __builtin_nontemporal_load((const f32x4*)(W + (size_t)(k0 + kk) * ldw + n0s + nq)); const float sc = ks ? cs * ks[k0 + kk] : cs;
        scr[kk * 33 + nq] = v[0] * sc; scr[kk * 33 + nq + 1] = v[1] * sc; scr[kk * 33 + nq + 2] = v[2] * sc; scr[kk * 33 + nq + 3] = v[3] * sc; }
    asm volatile("s_waitcnt lgkmcnt(0)" ::: "memory");
    const int cc = lane & 7;
#pragma unroll
    for (int j = 0; j < 4; ++j) { const int n = (lane >> 3) + 8 * j; const LAS float* sp = scr + (8 * cc) * 33 + n; f16x8 o;
#pragma unroll
        for (int e = 0; e < 8; ++e) o[e] = (f16)sp[e * 33];
        *(f16x8*)(WT + (size_t)(n0d + n) * ldt + k0 + 8 * cc) = o; }
    asm volatile("s_waitcnt lgkmcnt(0)" ::: "memory");
}
__device__ __forceinline__ void tr_matrix_item(const float* W, int K, int N, f16* WT, int it, float cs, int ncs, const float* ks, LAS float* scr, int lane) {
    const int nblk = N / 32, kb = it / nblk, nb = it % nblk;
    tr_item(W, N, 64 * kb, 32 * nb, WT, K, 32 * nb, (32 * nb < ncs) ? cs : 1.0f, ks, scr, lane);
}
constexpr int MOE_CONV_ITEMS = NEXP * (16 * 16 + 4 * 32);
__device__ __forceinline__ void conv_moe_item(const Ctx& c, int l, int it, LAS float* scr) {
    const int e = it / 384, r = it % 384;
    if (r < 256) { const int kb = r >> 4, nb = r & 15;
        const int j0 = (nb >> 3) * 128 + (nb & 3) * 32; const float* W = (((nb >> 2) & 1) ? c.in[37] : c.in[36]) + ((size_t)l * NEXP + e) * D * DEXP;
        tr_item(W, DEXP, 64 * kb, j0, wsp<f16>(c, WS_WGU_T) + (size_t)e * 512 * D, D, 32 * nb, 1.0f, nullptr, scr, c.lane);
    } else { const int r2 = r - 256, kb = r2 >> 5, nb = r2 & 31;
        tr_item(c.in[38] + ((size_t)l * NEXP + e) * DEXP * D, D, 64 * kb, 32 * nb, wsp<f16>(c, WS_WD_T) + (size_t)e * D * DEXP, DEXP, 32 * nb, 1.0f, nullptr, scr, c.lane); }
}
__device__ __forceinline__ void ph_fold_vectors(const Ctx& c) {
    float* S1 = wsp<float>(c, WS_S1Q); float* S2 = wsp<float>(c, WS_S2Q);
    for (int it = c.wid * c.G + c.bid; it < DEPTH * D; it += c.G * 8) { const int l = it >> 10, n = it & 1023;
        const f16* wt = wsp<f16>(c, WS_WQ_T) + ((size_t)l * D + n) * D; const f16x8 a = *(const f16x8*)(wt + 8 * c.lane), b = *(const f16x8*)(wt + 512 + 8 * c.lane);
        float s1 = 0.f;
#pragma unroll
        for (int i = 0; i < 8; ++i) s1 += (float)a[i] + (float)b[i];
        const float* w = c.in[26] + (size_t)l * D * D + n; const float* bb = c.in[25] + l * D; float s2 = 0.f;
#pragma unroll 4
        for (int j = 0; j < 16; ++j) { const int k = c.lane + 64 * j; s2 += bb[k] * w[(size_t)k * D]; }
        s1 = wave_sum(s1); s2 = wave_sum(s2) * XQSCALE;
        if (c.lane == 0) { S1[it] = s1; S2[it] = s2; } }
}
__device__ __forceinline__ void ph_conv(const Ctx& c) {
    LAS float* scr = (LAS float*)(c.lds + c.wid * 16384);
    const int gw = c.wid * c.G + c.bid, NGW = c.G * 8;
    constexpr int I_IN = 16 * 72, I_SQ = 16 * 32, I_GLU = 4 * 8, I_LRU = 16, PER_L = I_IN + 5 * I_SQ + I_GLU + I_LRU;
    for (int it0 = gw; it0 < DEPTH * PER_L; it0 += NGW) {
        const int l = it0 / PER_L; int it = it0 % PER_L;
        if (it < I_IN) { tr_matrix_item(c.in[4] + (size_t)l * D * DIN, D, DIN, wsp<f16>(c, WS_WIN_T) + (size_t)l * DIN * D, it, QSCALE, 512, nullptr, scr, c.lane); continue; } it -= I_IN;
        if (it < I_SQ) { tr_matrix_item(c.in[6] + (size_t)l * D * D, D, D, wsp<f16>(c, WS_WOUT_T) + (size_t)l * D * D, it, 1.f, 0, c.in[5] + l * D, scr, c.lane); continue; } it -= I_SQ;
        if (it < I_SQ) { tr_matrix_item(c.in[26] + (size_t)l * D * D, D, D, wsp<f16>(c, WS_WQ_T) + (size_t)l * D * D, it, XQSCALE, D, c.in[24] + l * D, scr, c.lane); continue; } it -= I_SQ;
        if (it < I_SQ) { tr_matrix_item(c.in[27] + (size_t)l * D * D, D, D, wsp<f16>(c, WS_WKV_T) + (size_t)(2 * l) * D * D, it, 1.f, 0, nullptr, scr, c.lane); continue; } it -= I_SQ;
        if (it < I_SQ) { tr_matrix_item(c.in[28] + (size_t)l * D * D, D, D, wsp<f16>(c, WS_WKV_T) + (size_t)(2 * l + 1) * D * D, it, 1.f, 0, nullptr, scr, c.lane); continue; } it -= I_SQ;
        if (it < I_SQ) { tr_matrix_item(c.in[29] + (size_t)l * D * D, D, D, wsp<f16>(c, WS_WO_T) + (size_t)l * D * D, it, 1.f, 0, nullptr, scr, c.lane); continue; } it -= I_SQ;
        if (it < I_GLU) { tr_matrix_item(c.in[15] + (size_t)l * 256 * 256, 256, 256, wsp<f16>(c, WS_WGLU_T) + (size_t)l * 256 * 256, it, 1.f, 0, nullptr, scr, c.lane); continue; } it -= I_GLU;
        { const int which = it >> 3, hd = (it >> 1) & 3, sub = it & 1;
          tr_matrix_item(c.in[which ? 21 : 19] + (size_t)(l * 4 + hd) * 4096, 64, 64, wsp<f16>(c, which ? WS_WLX_T : WS_WLA_T) + (size_t)(l * 4 + hd) * 4096, sub, 1.f, 0, nullptr, scr, c.lane); }
    }
}

template <int R> __device__ __forceinline__ void ln_rows(float (&v)[R][16], const float (&gg)[16], const float (&bb)[16]) {
    float s[R];
#pragma unroll
    for (int r = 0; r < R; ++r) { s[r] = 0.f;
#pragma unroll
        for (int i = 0; i < 16; ++i) s[r] += v[r][i]; }
#pragma unroll
    for (int o = 1; o < 64; o <<= 1)
#pragma unroll
        for (int r = 0; r < R; ++r) s[r] += __shfl_xor(s[r], o);
    float q[R];
#pragma unroll
    for (int r = 0; r < R; ++r) { const float mu = s[r] * (1.0f / 1024.0f); q[r] = 0.f;
#pragma unroll
        for (int i = 0; i < 16; ++i) { v[r][i] -= mu; q[r] += v[r][i] * v[r][i]; } }
#pragma unroll
    for (int o = 1; o < 64; o <<= 1)
#pragma unroll
        for (int r = 0; r < R; ++r) q[r] += __shfl_xor(q[r], o);
#pragma unroll
    for (int r = 0; r < R; ++r) { const float rstd = 1.0f / sqrtf(q[r] * (1.0f / 1024.0f) + 1e-5f);
#pragma unroll
        for (int i = 0; i < 16; ++i) v[r][i] = v[r][i] * rstd * gg[i] + bb[i]; }
}
struct AF16 {
    const f16* A; int lda; const int* rowtok; const float* ks;
    __device__ __forceinline__ void load4(int m, int k, float (&v)[4]) const {
        int r = m; if (rowtok) { const int t = rowtok[m]; r = (t < 0 ? 0 : t) >> 1; }
        const f16x4 a = *(const f16x4*)(A + (size_t)r * lda + k);
#pragma unroll
        for (int j = 0; j < 4; ++j) v[j] = (float)a[j];
        if (ks) {
#pragma unroll
            for (int j = 0; j < 4; ++j) v[j] *= ks[k + j];
        }
    }
};
struct BF32 {
    const float* B; int ldb; const int* tile_exp; size_t estride;
    __device__ __forceinline__ const float* base(int m0) const { return tile_exp ? B + (size_t)tile_exp[1 + (m0 >> 8)] * estride : B; }
};
template <class EF>
__device__ __forceinline__ void sgemm_phase(const Ctx& c, int M, int Nc, int K, const AF16 af, const BF32 bf, const EF ef) {
    LAS float* As = (LAS float*)c.lds;
    LAS float* Bs = As + 16 * 132;
    const int tid = c.tid, tx = tid & 15, ty = tid >> 4;
    const int tilesN = Nc / 64, ntiles = (M / 128) * tilesN;
    for (int u = c.bid; u < ntiles; u += c.G) {
        const int m0 = (u / tilesN) * 128, n0 = (u % tilesN) * 64;
        const float* Bb = bf.base(m0);
        float acc[4][4];
#pragma unroll
        for (int i = 0; i < 4; ++i)
#pragma unroll
            for (int j = 0; j < 4; ++j) acc[i][j] = 0.f;
        for (int k0 = 0; k0 < K; k0 += 16) {
            { const int m = tid & 127, kq = (tid >> 7) * 4; float v[4]; af.load4(m0 + m, k0 + kq, v);
#pragma unroll
              for (int j = 0; j < 4; ++j) As[(kq + j) * 132 + m] = v[j]; }
            { const int kk = tid >> 5, n = (tid & 31) * 2; const float* bp = Bb + (size_t)(k0 + kk) * bf.ldb + n0 + n;
              Bs[kk * 68 + n] = bp[0]; Bs[kk * 68 + n + 1] = bp[1]; }
            __syncthreads();
#pragma unroll
            for (int kk = 0; kk < 16; ++kk) {
                const f32x4 a = *(const LAS f32x4*)(As + kk * 132 + 4 * ty), b = *(const LAS f32x4*)(Bs + kk * 68 + 4 * tx);
#pragma unroll
                for (int i = 0; i < 4; ++i)
#pragma unroll
                    for (int j = 0; j < 4; ++j) acc[i][j] += a[i] * b[j];
            }
            __syncthreads();
        }
#pragma unroll
        for (int i = 0; i < 4; ++i) ef(m0 + 4 * ty + i, n0 + 4 * tx, acc[i]);
    }
}
struct EpiStoreF16 { f16* C; int ldc; float scale; int nscale;
    __device__ __forceinline__ void operator()(int m, int n, const float (&a)[4]) const {
        const float s = n < nscale ? scale : 1.0f; f16x4 o;
#pragma unroll
        for (int j = 0; j < 4; ++j) o[j] = (f16)(a[j] * s);
        *(f16x4*)(C + (size_t)m * ldc + n) = o; } };
struct EpiResid { f16* H;
    __device__ __forceinline__ void operator()(int m, int n, const float (&a)[4]) const {
        f16x4* p = (f16x4*)(H + (size_t)m * D + n); f16x4 o = *p;
#pragma unroll
        for (int j = 0; j < 4; ++j) o[j] = (f16)(ALPHA * (float)o[j] + a[j]);
        *p = o; } };
struct EpiGlu { const f16* yact; const float* bg; f16* Y;
    __device__ __forceinline__ void operator()(int m, int n, const float (&a)[4]) const {
        const f16x4 y = *(const f16x4*)(yact + (size_t)m * 256 + n); f16x4 o;
#pragma unroll
        for (int j = 0; j < 4; ++j) o[j] = (f16)((float)y[j] * sigmoidf_(a[j] + bg[n + j]));
        *(f16x4*)(Y + (size_t)m * D + 512 + n) = o; } };
struct EpiSiluMul { const f16* hg; f16* he;
    __device__ __forceinline__ void operator()(int m, int n, const float (&a)[4]) const {
        const f16x4 g = *(const f16x4*)(hg + (size_t)m * 256 + n); f16x4 o;
#pragma unroll
        for (int j = 0; j < 4; ++j) { const float gv = (float)g[j]; o[j] = (f16)(gv * sigmoidf_(gv) * a[j]); }
        *(f16x4*)(he + (size_t)m * 256 + n) = o; } };
struct EpiScatter { const int* rowtok; const float* roww; f16* ys;
    __device__ __forceinline__ void operator()(int m, int n, const float (&a)[4]) const {
        const int r = rowtok[m]; if (r < 0) return; const float w = roww[m]; f16x4 o;
#pragma unroll
        for (int j = 0; j < 4; ++j) o[j] = (f16)(w * a[j]);
        *(f16x4*)(ys + (size_t)r * D + n) = o; } };

__device__ __forceinline__ void ph_ln0(const Ctx& c) {
    const int gw = c.wid * c.G + c.bid, NGW = c.G * 8;
    f16* H = wsp<f16>(c, WS_H);
    float gg[16], bb[16]; vec_load16(c.in[2], c.lane, gg); vec_load16(c.in[3], c.lane, bb);
    for (int m = gw * 4; m < NTOK; m += NGW * 4) {
        float v[4][16];
#pragma unroll
        for (int r = 0; r < 4; ++r) vec_load16_nt(c.in[0] + (size_t)(m + r) * D, c.lane, v[r]);
        ln_rows<4>(v, gg, bb);
#pragma unroll
        for (int r = 0; r < 4; ++r) row_store16(H + (size_t)(m + r) * D, c.lane, v[r]);
    }
    f16* M16 = wsp<f16>(c, WS_MEM16);
    for (int m = gw; m < NMEM; m += NGW) { float v[16]; vec_load16_nt(c.in[1] + (size_t)m * D, c.lane, v); row_store16(M16 + (size_t)m * D, c.lane, v); }
}
constexpr size_t WS_KMAX = WS_KMEAN + 512 * 1024;
__device__ __forceinline__ void ph_kmean(const Ctx& c) {
    const f16* Z = wsp<f16>(c, WS_Z); float* KMN = wsp<float>(c, WS_KMEAN); float* KMX = wsp<float>(c, WS_KMAX);
    LAS float* part = (LAS float*)c.lds;
    LAS float* pmx = part + 8 * 512;
    for (int it = c.bid; it < 128; it += c.G) {
        const f16* p = Z + ((size_t)it * 256 + c.wid * 32) * DIN + ZK + 8 * c.lane;
        float cs[8]; float mx = 0.f;
#pragma unroll
        for (int e = 0; e < 8; ++e) cs[e] = 0.f;
#pragma unroll 4
        for (int r = 0; r < 32; ++r) { const f16x8 v = *(const f16x8*)(p + (size_t)r * DIN); float q = 0.f;
#pragma unroll
            for (int e = 0; e < 8; ++e) { const float x = (float)v[e]; cs[e] += x; q += x * x; }
            q += __shfl_xor(q, 1); q += __shfl_xor(q, 2); q += __shfl_xor(q, 4); mx = fmaxf(mx, q); }
#pragma unroll
        for (int e = 0; e < 8; ++e) part[c.wid * 512 + 8 * c.lane + e] = cs[e];
        if ((c.lane & 7) == 0) pmx[c.wid * 8 + (c.lane >> 3)] = mx;
        __syncthreads();
        { float s = 0.f;
#pragma unroll
          for (int w = 0; w < 8; ++w) s += part[w * 512 + c.tid];
          KMN[it * 512 + c.tid] = s * (1.0f / 256.0f); }
        if (c.tid < 8) { float m = 0.f;
#pragma unroll
            for (int w = 0; w < 8; ++w) m = fmaxf(m, pmx[w * 8 + c.tid]);
            KMX[it * 8 + c.tid] = sqrtf(m); }
        __syncthreads();
    }
}
__device__ __forceinline__ void ph_attn_naive(const Ctx& c) {
    const f16* Z = wsp<f16>(c, WS_Z); const float* KMN = wsp<float>(c, WS_KMEAN); f16* Y = wsp<f16>(c, WS_Y);
    for (int item = c.bid * 512 + c.tid; item < NTOK * 8; item += c.G * 512) {
        const int t = item & 2047, h = (item >> 11) & 7, b = item >> 14, own = t >> 8;
        const size_t n = (size_t)b * SEQ + t;
        float q[64];
        { const f16* qp = Z + n * DIN + ZQ + h * 64;
#pragma unroll
          for (int d8 = 0; d8 < 8; ++d8) { const f16x8 v = *(const f16x8*)(qp + 8 * d8);
#pragma unroll
              for (int j = 0; j < 8; ++j) q[8 * d8 + j] = (float)v[j]; } }
        unsigned allowed = 0u;
        { float gate[8];
#pragma unroll
          for (int nb = 0; nb < 8; ++nb) { float s = 0.f; if (nb < own) { const float* kp = KMN + ((size_t)(b * 8 + nb)) * 512 + h * 64;
#pragma unroll
                  for (int d = 0; d < 64; ++d) s += q[d] * kp[d]; } gate[nb] = s; }
#pragma unroll
          for (int nb = 0; nb < 8; ++nb) { int rank = 0;
#pragma unroll
              for (int o = 0; o < 8; ++o) if (o < own && o != nb && (gate[o] > gate[nb] || (gate[o] == gate[nb] && o < nb))) ++rank;
              if (nb < own && rank < 3) allowed |= 1u << nb; } }
        const float slope2 = exp2f(-(float)(h + 1)) * LOG2E;
        float m = -1e30f, l = 0.f, o[64];
#pragma unroll
        for (int d = 0; d < 64; ++d) o[d] = 0.f;
        for (int step = 0; step <= own; ++step) {
            const int blk = step == 0 ? own : step - 1;
            const bool ok = (blk == own) || ((allowed >> blk) & 1u);
            const int jend = (blk == own) ? (t & 255) : 255;
            if (!ok) continue;
            for (int jj = 0; jj <= jend; ++jj) {
                const int j = blk * 256 + jj; const f16* kp = Z + ((size_t)b * SEQ + j) * DIN + ZK + h * 64;
                float s = 0.f;
#pragma unroll
                for (int d8 = 0; d8 < 8; ++d8) { const f16x8 v = *(const f16x8*)(kp + 8 * d8);
#pragma unroll
                    for (int jx = 0; jx < 8; ++jx) s += q[8 * d8 + jx] * (float)v[jx]; }
                s -= slope2 * (float)(t - j);
                const float mn = fmaxf(m, s), al = exp2f(m - mn), p = exp2f(s - mn);
                l = l * al + p; m = mn;
                const f16* vp = kp + (ZV - ZK);
#pragma unroll
                for (int d8 = 0; d8 < 8; ++d8) { const f16x8 v = *(const f16x8*)(vp + 8 * d8);
#pragma unroll
                    for (int jx = 0; jx < 8; ++jx) o[8 * d8 + jx] = o[8 * d8 + jx] * al + p * (float)v[jx]; }
            }
        }
        const float rl = 1.0f / l; f16* yp = Y + n * D + h * 64;
#pragma unroll
        for (int d8 = 0; d8 < 8; ++d8) { f16x8 v;
#pragma unroll
            for (int jx = 0; jx < 8; ++jx) v[jx] = (f16)(o[8 * d8 + jx] * rl);
            *(f16x8*)(yp + 8 * d8) = v; }
    }
}
namespace att {
typedef _Float16 h8 __attribute__((ext_vector_type(8)));
typedef float f32x16 __attribute__((ext_vector_type(16)));
typedef short v4i16 __attribute__((ext_vector_type(4)));
typedef unsigned u32x4 __attribute__((ext_vector_type(4)));
typedef const LAS char* lcp;
constexpr int SLOTB = 8192, LDS_K = 0, LDS_V = 2 * SLOTB, LDS_WS = 4 * SLOTB, LDS_OST = LDS_WS + 8 * 256, LDS_TOTAL = LDS_OST + 8 * 4096;
constexpr float THRL = 8.0f;
__device__ __forceinline__ int crow(int r, int hi) { return (r & 3) + 8 * (r >> 2) + 4 * hi; }
__device__ __forceinline__ float max3f(float a, float b, float c) { float r; asm("v_max3_f32 %0, %1, %2, %3" : "=v"(r) : "v"(a), "v"(b), "v"(c)); return r; }
__device__ __forceinline__ h8 vtr2(lcp p) {
    const v4i16 lo = __builtin_amdgcn_ds_read_tr16_b64_v4i16((LAS v4i16*)p), hi = __builtin_amdgcn_ds_read_tr16_b64_v4i16((LAS v4i16*)(p + 512));
    typedef short s8 __attribute__((ext_vector_type(8)));
    const s8 v = {lo[0], lo[1], lo[2], lo[3], hi[0], hi[1], hi[2], hi[3]}; return __builtin_bit_cast(h8, v); }

__device__ __forceinline__ void attn_unit(const Ctx& c, int b, int h, int qb) {
    const f16* Z = wsp<f16>(c, WS_Z); const float* KMN = wsp<float>(c, WS_KMEAN); f16* Y = wsp<f16>(c, WS_Y);
    int lane = c.lane; asm volatile("" : "+v"(lane));
    const int r32 = lane & 31, hi = lane >> 5, wid = c.wid;
    const size_t rowbase = (size_t)b * SEQ; const int q0 = qb * 256;
    const f16* Kh = Z + rowbase * DIN + ZK + h * 64; const f16* Vh = Z + rowbase * DIN + ZV + h * 64;
    const f16* ksrc = Kh + (size_t)lane * DIN + wid * 8;
    const f16* vsrc = Vh + (size_t)(16 * (wid & 3) + (lane >> 2)) * DIN + (wid >> 2) * 32 + (lane & 3) * 8;
    LAS unsigned char* lds = c.lds;
#define ATT_DMA(tile, slot) do { \
        __builtin_amdgcn_global_load_lds((const unsigned*)(ksrc + (size_t)(tile) * 64 * DIN), (LAS unsigned*)(lds + LDS_K + (slot) * SLOTB + wid * 1024), 16, 0, 0); \
        __builtin_amdgcn_global_load_lds((const unsigned*)(vsrc + (size_t)(tile) * 64 * DIN), (LAS unsigned*)(lds + LDS_V + (slot) * SLOTB + wid * 1024), 16, 0, 0); } while (0)
    ATT_DMA(4 * qb, 0);
    const f16* Qw = Z + (rowbase + q0 + wid * 32 + r32) * DIN + ZQ + h * 64 + hi * 8;
    h8 qr[4];
#pragma unroll
    for (int d0 = 0; d0 < 4; ++d0) qr[d0] = *(const h8*)(Qw + d0 * 16);
    unsigned allowed = (1u << qb) - 1u;
    if (qb > 3) {
        float gate[8];
#pragma unroll
        for (int nb = 0; nb < 7; ++nb) { float s = 0.f;
            if (nb < qb) { const float* kp = KMN + (size_t)(b * 8 + nb) * 512 + h * 64 + hi * 8;
#pragma unroll
                for (int d0 = 0; d0 < 4; ++d0) { const f32x4 k0 = *(const f32x4*)(kp + d0 * 16), k1 = *(const f32x4*)(kp + d0 * 16 + 4);
#pragma unroll
                    for (int j = 0; j < 4; ++j) s += (float)qr[d0][j] * k0[j] + (float)qr[d0][4 + j] * k1[j]; }
                s += __shfl_xor(s, 32); }
            gate[nb] = s; }
        gate[7] = 0.f; allowed = 0u;
#pragma unroll
        for (int nb = 0; nb < 7; ++nb) { int rank = 0;
#pragma unroll
            for (int o = 0; o < 7; ++o) if (o < qb && o != nb && (gate[o] > gate[nb] || (gate[o] == gate[nb] && o < nb))) ++rank;
            if (nb < qb && rank < 3) allowed |= 1u << nb; }
    }
    const float slope2 = exp2f(-(float)(h + 1)) * LOG2E;
    float kmx = 0.f;
    { const float* kx = wsp<float>(c, WS_KMAX) + (size_t)b * 64 + h;
#pragma unroll
      for (int nb = 0; nb < 8; ++nb) if (nb <= qb) kmx = fmaxf(kmx, kx[nb * 8]); }
    float qn = 0.f;
#pragma unroll
    for (int d0 = 0; d0 < 4; ++d0)
#pragma unroll
        for (int j = 0; j < 8; ++j) qn += (float)qr[d0][j] * (float)qr[d0][j];
    qn += __shfl_xor(qn, 32);
    const float qmw = __int_as_float(__builtin_amdgcn_readfirstlane(__float_as_int(sqrtf(wave_max(qn)))));
    { LAS float* qx = (LAS float*)(lds + LDS_TOTAL); if (lane == 0) qx[wid] = qmw; }
    const int qrel = wid * 32 + r32;
    float mhat = 0.f, l_reg = 0.f; f32x16 o[2];
#pragma unroll
    for (int r = 0; r < 16; ++r) { o[0][r] = 0.f; o[1][r] = 0.f; }
    LAS float* wsf = (LAS float*)(lds + LDS_WS) + wid * 64; LAS float* wsfh = wsf + 4 * hi;
    const lcp kp0 = (lcp)(lds + LDS_K) + hi * 1024 + r32 * 16;
    const lcp vp0 = (lcp)(lds + LDS_V) + ((lane >> 4) & 1) * 32 + (lane & 3) * 8 + (4 * hi + ((lane & 15) >> 2)) * 64;
    asm volatile("s_waitcnt vmcnt(0)" ::: "memory"); __syncthreads();
    float qmu = 0.f;
    { const LAS float* qx = (const LAS float*)(lds + LDS_TOTAL);
#pragma unroll
      for (int w = 0; w < 8; ++w) qmu = fmaxf(qmu, qx[w]); }
    const float rs2 = 1.0f / slope2;
    int tile_lo = (int)ceilf(((float)(q0 - 63) - (2.0f * qmu * kmx + 30.0f) * rs2) * (1.0f / 64.0f));
    tile_lo = tile_lo < 0 ? 0 : (tile_lo > 4 * qb ? 4 * qb : tile_lo); tile_lo = __builtin_amdgcn_readfirstlane(tile_lo);
    const float bw = 2.0f * qmw * kmx + 30.0f;
    const int NT = 4 + 4 * qb - tile_lo;
    bool started = false;
    for (int s = 0; s < NT; ++s) {
        const int tile = s < 4 ? 4 * qb + s : tile_lo + s - 4, slot = s & 1;
        if (s + 1 < NT) { const int nt_ = (s + 1) < 4 ? 4 * qb + s + 1 : tile_lo + s - 3; ATT_DMA(nt_, slot ^ 1); }
        const bool band = s < 4;
        const bool okrow = band ? true : (((allowed >> (tile >> 2)) & 1u) != 0u);
        const bool inreach = slope2 * (float)(q0 + 32 * wid - 64 * tile - 63) <= bw;
        const bool active = (band ? (64 * s <= 32 * wid + 31) : (__any(okrow) != 0)) && inreach;
        if (active) {
            const float NEG = -INFINITY;
            const float base = okrow ? (slope2 * (float)(64 * tile - (q0 + qrel) + 4 * hi) - mhat) : NEG, base1 = base + 32.0f * slope2;
            f32x16 p0, p1;
#pragma unroll
            for (int r = 0; r < 16; ++r) { const float kc = (float)((r & 3) + 8 * (r >> 2)); p0[r] = __builtin_fmaf(slope2, kc, base); p1[r] = __builtin_fmaf(slope2, kc, base1); }
            { const lcp kb = kp0 + slot * SLOTB; h8 kf[8];
#pragma unroll
              for (int d0 = 0; d0 < 4; ++d0) { kf[2 * d0] = *(const LAS h8*)(kb + d0 * 2048); kf[2 * d0 + 1] = *(const LAS h8*)(kb + d0 * 2048 + 512); }
#pragma unroll
              for (int d0 = 0; d0 < 4; ++d0) { p0 = __builtin_amdgcn_mfma_f32_32x32x16_f16(kf[2 * d0], qr[d0], p0, 0, 0, 0); p1 = __builtin_amdgcn_mfma_f32_32x32x16_f16(kf[2 * d0 + 1], qr[d0], p1, 0, 0, 0); } }
            asm volatile("s_nop 15\n\ts_nop 7" : "+v"(p0), "+v"(p1));
            if (band && (64 * s + 63 > 32 * wid)) { const int kb_ = 64 * s + 4 * hi;
#pragma unroll
                for (int r = 0; r < 16; ++r) { const int kv = kb_ + (r & 3) + 8 * (r >> 2); p0[r] = (kv > qrel) ? NEG : p0[r]; p1[r] = (kv + 32 > qrel) ? NEG : p1[r]; } }
            float rm;
            { float ma = max3f(p0[0], p0[1], p1[0]), mb = max3f(p0[2], p0[3], p1[1]); ma = max3f(ma, p1[2], p1[3]);
#pragma unroll
              for (int r = 4; r < 16; r += 4) { ma = max3f(ma, p0[r], p0[r + 1]); mb = max3f(mb, p0[r + 2], p0[r + 3]); ma = max3f(ma, p1[r], p1[r + 1]); mb = max3f(mb, p1[r + 2], p1[r + 3]); }
              rm = max3f(ma, mb, mb); }
            rm = fmaxf(rm, __shfl_xor(rm, 32));
            if (!started || __any(rm > THRL)) {
                const float dl = (!started) ? rm : fmaxf(rm, 0.f);
                mhat += dl;
#pragma unroll
                for (int r = 0; r < 16; ++r) { p0[r] -= dl; p1[r] -= dl; }
                if (started) { const float f = __builtin_amdgcn_exp2f(-dl); l_reg *= f; if (hi == 0) wsf[r32] = f;
#pragma unroll
                    for (int r = 0; r < 16; ++r) { const float fr_ = wsfh[(r & 3) + 8 * (r >> 2)]; o[0][r] *= fr_; o[1][r] *= fr_; } }
            }
            started = true;
            float sacc = 0.f;
#pragma unroll
            for (int r = 0; r < 16; ++r) { p0[r] = __builtin_amdgcn_exp2f(p0[r]); p1[r] = __builtin_amdgcn_exp2f(p1[r]); sacc += p0[r] + p1[r]; }
            l_reg += sacc;
            h8 pa[4];
#pragma unroll
            for (int j = 0; j < 8; ++j) { pa[0][j] = (f16)p0[j]; pa[1][j] = (f16)p0[8 + j]; pa[2][j] = (f16)p1[j]; pa[3][j] = (f16)p1[8 + j]; }
            const lcp vp = vp0 + slot * SLOTB;
#pragma unroll
            for (int d0 = 0; d0 < 2; ++d0) { h8 vf[4];
#pragma unroll
                for (int ks = 0; ks < 4; ++ks) vf[ks] = vtr2(vp + d0 * 4096 + ks * 1024);
#pragma unroll
                for (int ks = 0; ks < 4; ++ks) o[d0] = __builtin_amdgcn_mfma_f32_32x32x16_f16(pa[ks], vf[ks], o[d0], 0, 0, 0); }
        }
        asm volatile("s_waitcnt vmcnt(0)" ::: "memory"); __syncthreads();
    }
    l_reg += __shfl_xor(l_reg, 32);
    if (hi == 0) wsf[32 + r32] = l_reg;
    int hi4 = 4 * hi; asm volatile("" : "+v"(hi4));
    LAS float* wl = wsf + 32 + hi4;
    LAS f16* stg = (LAS f16*)(lds + LDS_OST) + wid * 2048 + hi4 * 64 + r32;
#pragma unroll
    for (int r = 0; r < 16; ++r) { const int kc = (r & 3) + 8 * (r >> 2); const float rl = 1.0f / wl[kc];
        stg[kc * 64] = (f16)(o[0][r] * rl); stg[kc * 64 + 32] = (f16)(o[1][r] * rl); }
    f16* Ow = Y + (rowbase + q0 + wid * 32) * D + h * 64;
    { const LAS f16* sr = (const LAS f16*)(lds + LDS_OST) + wid * 2048 + (lane >> 3) * 64 + (lane & 7) * 8; f16* og = Ow + (size_t)(lane >> 3) * D + (lane & 7) * 8;
#pragma unroll
      for (int i = 0; i < 4; ++i) { const u32x4 v = *(const LAS u32x4*)(sr + i * 512); *(u32x4*)(og + (size_t)i * 8 * D) = v; } }
    __syncthreads();
#undef ATT_DMA
}
__device__ const unsigned char ATT_ORDER[64] = {47,55,63,39,38,46,54,62,37,45,53,61,36,44,52,60,28,29,30,31,27,35,43,51,59,26,34,42,50,58,18,19,20,21,22,23,9,10,11,12,13,14,15,17,25,33,41,49,57,1,2,3,4,5,6,7,0,8,16,24,32,40,48,56};
constexpr int ATT_NBIG = 30;
}

constexpr int CW_LF = 12288;
namespace lru {
typedef _Float16 h8 __attribute__((ext_vector_type(8)));
constexpr int XS = 264;
constexpr int L_XC = 0, L_GL = 64 * XS * 2, L_RP = 2 * 64 * XS * 2, L_RS = L_RP + 64 * 8 * 4, L_HIN = L_RS + 64 * 4, L_END = L_HIN + 256 * 4;
__device__ __forceinline__ float sigm(float x) { return __builtin_amdgcn_rcpf(1.0f + __expf(-x)); }
template <int PASS>
__device__ __forceinline__ void lru_unit(const Ctx& c, int l, int b, int ck) {
    const f16* Z = wsp<f16>(c, WS_Z); float* ENDS = wsp<float>(c, WS_LRUENDS);
    unsigned* flags = (unsigned*)(c.ws + WS_CTL) + CW_LF; const unsigned epoch = (unsigned)l + 1u;
    int lane = c.lane; asm volatile("" : "+v"(lane));
    const int tid = c.wid * 64 + lane, fr = lane & 15, fq = lane >> 4, hd = c.wid >> 1, half = c.wid & 1;
    LAS f16* XC = (LAS f16*)(c.lds + L_XC); LAS f16* GL = (LAS f16*)(c.lds + L_GL);
    LAS float* RP = (LAS float*)(c.lds + L_RP); LAS float* RS = (LAS float*)(c.lds + L_RS); LAS float* HIN = (LAS float*)(c.lds + L_HIN);
    const size_t n0 = (size_t)b * SEQ + ck * 64;
    const float* cw = c.in[17] + l * 4 * 256; const float* cb = c.in[18] + l * 256;
    h8 wa[2][2], wx[2][2];
    { const f16* wat = wsp<f16>(c, WS_WLA_T) + (size_t)(l * 4 + hd) * 4096; const f16* wxt = wsp<f16>(c, WS_WLX_T) + (size_t)(l * 4 + hd) * 4096;
#pragma unroll
      for (int ks = 0; ks < 2; ++ks)
#pragma unroll
          for (int n = 0; n < 2; ++n) { wa[ks][n] = *(const h8*)(wat + (half * 32 + 16 * n + fr) * 64 + 32 * ks + 8 * fq); wx[ks][n] = *(const h8*)(wxt + (half * 32 + 16 * n + fr) * 64 + 32 * ks + 8 * fq); } }
    { const int cg = tid & 31, t0 = (tid >> 5) * 4;
      f32x4 w0[4], w1[4];
#pragma unroll
      for (int j = 0; j < 4; ++j) { w0[j] = *(const f32x4*)(cw + j * 256 + 8 * cg); w1[j] = *(const f32x4*)(cw + j * 256 + 8 * cg + 4); }
      const f32x4 b0 = *(const f32x4*)(cb + 8 * cg), b1 = *(const f32x4*)(cb + 8 * cg + 4);
      h8 xr[7];
#pragma unroll
      for (int q = 0; q < 7; ++q) { const int tt = ck * 64 + t0 - 3 + q;
          if (tt >= 0) xr[q] = *(const h8*)(Z + (n0 + t0 - 3 + q) * DIN + ZXL + 8 * cg);
          else {
#pragma unroll
              for (int e = 0; e < 8; ++e) xr[q][e] = (f16)0.f; } }
      if (PASS >= 1) {
#pragma unroll
          for (int q = 0; q < 4; ++q) *(LAS h8*)(GL + (t0 + q) * XS + 8 * cg) = *(const h8*)(Z + (n0 + t0 + q) * DIN + ZGL + 8 * cg); }
#pragma unroll
      for (int q = 0; q < 4; ++q) { float a8[8];
#pragma unroll
          for (int e = 0; e < 4; ++e) { a8[e] = b0[e]; a8[4 + e] = b1[e]; }
#pragma unroll
          for (int j = 0; j < 4; ++j)
#pragma unroll
              for (int e = 0; e < 4; ++e) { a8[e] += w0[j][e] * (float)xr[q + j][e]; a8[4 + e] += w1[j][e] * (float)xr[q + j][4 + e]; }
          h8 o;
#pragma unroll
          for (int e = 0; e < 8; ++e) o[e] = (f16)a8[e];
          *(LAS h8*)(XC + (t0 + q) * XS + 8 * cg) = o; } }
    if (PASS == 1 && tid < 256) {
        const float* ep = ENDS + ((size_t)b * 32) * 512 + tid; float hin = 0.f;
#pragma unroll 8
        for (int cc = 0; cc < ck; ++cc) hin = ep[cc * 512] * hin + ep[cc * 512 + 256];
        HIN[tid] = hin;
    }
    __syncthreads();
    f32x4 ra[4][2], ia[4][2];
#pragma unroll
    for (int m = 0; m < 4; ++m)
#pragma unroll
        for (int n = 0; n < 2; ++n) { ra[m][n] = (f32x4){0.f, 0.f, 0.f, 0.f}; ia[m][n] = (f32x4){0.f, 0.f, 0.f, 0.f}; }
    {
#pragma unroll
      for (int ks = 0; ks < 2; ++ks) { h8 af[4];
#pragma unroll
          for (int m = 0; m < 4; ++m) af[m] = *(const LAS h8*)(XC + (16 * m + fr) * XS + hd * 64 + 32 * ks + 8 * fq);
#pragma unroll
          for (int m = 0; m < 4; ++m)
#pragma unroll
              for (int n = 0; n < 2; ++n) { ra[m][n] = __builtin_amdgcn_mfma_f32_16x16x32_f16(af[m], wa[ks][n], ra[m][n], 0, 0, 0); ia[m][n] = __builtin_amdgcn_mfma_f32_16x16x32_f16(af[m], wx[ks][n], ia[m][n], 0, 0, 0); } } }
    const int ch0 = hd * 64 + half * 32 + fr;
#pragma unroll
    for (int n = 0; n < 2; ++n) { const int chn = ch0 + 16 * n;
        const float lm = c.in[23][l * 256 + chn], sp8 = 8.0f * (fmaxf(-lm, 0.f) + log1pf(__expf(-fabsf(lm)))), ba = c.in[20][l * 256 + chn], bx = c.in[22][l * 256 + chn];
#pragma unroll
        for (int m = 0; m < 4; ++m) { float p = 1.f, hh = 0.f;
#pragma unroll
            for (int e = 0; e < 4; ++e) { const float r = sigm(ra[m][n][e] + ba), ig = sigm(ia[m][n][e] + bx), la = -sp8 * r, a = __expf(la), x2 = 2.0f * la;
                const float em_s = -x2 * (1.0f + x2 * (0.5f + x2 * (0.16666667f + x2 * (0.041666668f + x2 * (0.0083333338f + x2 * 0.0013888889f)))));
                const float em = x2 > -0.5f ? em_s : 1.0f - a * a;
                const float bt = sqrtf(em) * (ig * (float)XC[(16 * m + 4 * fq + e) * XS + chn]);
                p *= a; hh = a * hh + bt; ra[m][n][e] = p; ia[m][n][e] = hh; } } }
    float xp[4][2], xh[4][2], tp[4][2], th[4][2];
#pragma unroll
    for (int m = 0; m < 4; ++m)
#pragma unroll
        for (int n = 0; n < 2; ++n) { const float PT = ra[m][n][3], HT = ia[m][n][3]; float cp = 1.f, chh = 0.f;
#pragma unroll
            for (int k = 0; k < 3; ++k) { const float pk = __shfl(PT, fr + 16 * k), hk = __shfl(HT, fr + 16 * k); if (fq > k) { chh = pk * chh + hk; cp *= pk; } }
            xp[m][n] = cp; xh[m][n] = chh; const float ip = cp * PT, ih = PT * chh + HT; tp[m][n] = __shfl(ip, fr + 48); th[m][n] = __shfl(ih, fr + 48); }
    if (PASS == 0) {
        if (fq == 0) {
#pragma unroll
            for (int n = 0; n < 2; ++n) { float CP = 1.f, CH = 0.f;
#pragma unroll
                for (int m = 0; m < 4; ++m) { CH = tp[m][n] * CH + th[m][n]; CP *= tp[m][n]; }
                float* ep = ENDS + ((size_t)b * 32 + ck) * 512 + ch0 + 16 * n; ep[0] = CP; ep[256] = CH; } }
        __syncthreads();
    } else {
        if (PASS == 2) {
            if (fq == 0) {
#pragma unroll
                for (int n = 0; n < 2; ++n) { float CP = 1.f, CH = 0.f;
#pragma unroll
                    for (int m = 0; m < 4; ++m) { CH = tp[m][n] * CH + th[m][n]; CP *= tp[m][n]; }
                    float* ep = ENDS + ((size_t)b * 32 + ck) * 512 + ch0 + 16 * n;
                    __hip_atomic_store(ep, CP, __ATOMIC_RELAXED, __HIP_MEMORY_SCOPE_AGENT); __hip_atomic_store(ep + 256, CH, __ATOMIC_RELAXED, __HIP_MEMORY_SCOPE_AGENT); } }
            asm volatile("s_waitcnt vmcnt(0)" ::: "memory");
            __syncthreads();
            if (tid == 0) __hip_atomic_store(flags + b * 32 + ck, epoch, __ATOMIC_RELAXED, __HIP_MEMORY_SCOPE_AGENT);
            if (c.wid == 0) { unsigned spins = 0;
                for (;;) { const unsigned v = (lane < ck) ? __hip_atomic_load(flags + b * 32 + (lane & 31), __ATOMIC_RELAXED, __HIP_MEMORY_SCOPE_AGENT) : epoch;
                    if (__all(v >= epoch)) break; __builtin_amdgcn_s_sleep(2); if (++spins > (1u << 22)) break; } }
            __syncthreads();
            if (tid < 256) { const float* ep = ENDS + ((size_t)b * 32) * 512 + tid; float hin = 0.f;
#pragma unroll 8
                for (int cc = 0; cc < ck; ++cc) { const float P = __hip_atomic_load(ep + cc * 512, __ATOMIC_RELAXED, __HIP_MEMORY_SCOPE_AGENT), Hh = __hip_atomic_load(ep + cc * 512 + 256, __ATOMIC_RELAXED, __HIP_MEMORY_SCOPE_AGENT); hin = P * hin + Hh; }
                HIN[tid] = hin; }
            __syncthreads();
        }
        float ssq[4][4];
#pragma unroll
        for (int m = 0; m < 4; ++m)
#pragma unroll
            for (int e = 0; e < 4; ++e) ssq[m][e] = 0.f;
#pragma unroll
        for (int n = 0; n < 2; ++n) { const int chn = ch0 + 16 * n; float hs = HIN[chn];
#pragma unroll
            for (int m = 0; m < 4; ++m) { const float hseg = xp[m][n] * hs + xh[m][n];
#pragma unroll
                for (int e = 0; e < 4; ++e) { const float hv = ra[m][n][e] * hseg + ia[m][n][e]; const float g = (float)GL[(16 * m + 4 * fq + e) * XS + chn];
                    const float u2 = 1.5957691216f * (g + 0.044715f * g * g * g), ov = hv * g * sigm(u2); ia[m][n][e] = ov; ssq[m][e] += ov * ov; }
                hs = tp[m][n] * hs + th[m][n]; } }
#pragma unroll
        for (int m = 0; m < 4; ++m)
#pragma unroll
            for (int e = 0; e < 4; ++e) { float v = ssq[m][e]; v += __shfl_xor(v, 1); v += __shfl_xor(v, 2); v += __shfl_xor(v, 4); v += __shfl_xor(v, 8); if (fr == 0) RP[(16 * m + 4 * fq + e) * 8 + c.wid] = v; }
        __syncthreads();
        if (tid < 64) { float s = 0.f;
#pragma unroll
            for (int w = 0; w < 8; ++w) s += RP[tid * 8 + w];
            RS[tid] = 1.0f / sqrtf(s * (1.0f / 256.0f) + 1e-6f); }
        __syncthreads();
#pragma unroll
        for (int m = 0; m < 4; ++m)
#pragma unroll
            for (int e = 0; e < 4; ++e) { const int t = 16 * m + 4 * fq + e; const float rs = RS[t];
#pragma unroll
                for (int n = 0; n < 2; ++n) XC[t * XS + ch0 + 16 * n] = (f16)(ia[m][n][e] * rs); }
        __syncthreads();
        f16* Y = wsp<f16>(c, WS_Y);
        for (int it = tid; it < 2048; it += 512) { const int t = it >> 5, cg = it & 31; *(h8*)(Y + (n0 + t) * D + 768 + 8 * cg) = *(const LAS h8*)(XC + t * XS + 8 * cg); }
        __syncthreads();
    }
}
template <int PASS> __device__ __forceinline__ void lru_phase(const Ctx& c, int l) {
    for (int u = c.bid; u < 512; u += c.G) lru_unit<PASS>(c, l, u >> 5, u & 31);
}
}

namespace s5 {
typedef _Float16 h8 __attribute__((ext_vector_type(8)));
__device__ __forceinline__ void tables1(const Ctx& c) {
    float* AP = wsp<float>(c, WS_S5AP); float* BB = wsp<float>(c, WS_S5BB);
    for (int it = c.bid * 512 + c.tid; it < DEPTH * 16 * 64; it += c.G * 512) {
        const int p = it & 63, lg = it >> 6;
        const float dt = expf(c.in[14][lg]), are = c.in[7][it], aim = c.in[8][it];
        const float mag = expf(dt * are), abr = mag * cosf(dt * aim), abi = mag * sinf(dt * aim);
        const float den = are * are + aim * aim, nr = abr - 1.0f, ni = abi, fre = (nr * are + ni * aim) / den, fim = (ni * are - nr * aim) / den;
        float pr = 1.0f, pi = 0.0f;
        for (int tau = 0; tau <= 32; ++tau) { AP[((size_t)lg * 33 + tau) * 128 + p] = pr; AP[((size_t)lg * 33 + tau) * 128 + 64 + p] = pi; const float nr2 = pr * abr - pi * abi, ni2 = pr * abi + pi * abr; pr = nr2; pi = ni2; }
        for (int h = 0; h < 16; ++h) { const float br = c.in[9][(size_t)it * 16 + h], bi = c.in[10][(size_t)it * 16 + h];
            BB[((size_t)lg * 64 + p) * 32 + h] = fre * br - fim * bi; BB[((size_t)lg * 64 + p) * 32 + 16 + h] = fre * bi + fim * br; }
    }
}
__device__ __forceinline__ void tables2(const Ctx& c) {
    const float* AP = wsp<float>(c, WS_S5AP); const float* BB = wsp<float>(c, WS_S5BB); float* KK = wsp<float>(c, WS_S5KK);
    f16* WE = wsp<f16>(c, WS_S5WEND); f16* T = wsp<f16>(c, WS_S5T);
    const size_t gt = (size_t)c.bid * 512 + c.tid, GT = (size_t)c.G * 512;
    for (size_t it = gt; it < (size_t)DEPTH * 16 * 32 * 256; it += GT) {
        const int h = (int)(it & 15), hp = (int)((it >> 4) & 15), tau = (int)((it >> 8) & 31), lg = (int)(it >> 13);
        const float* cr = c.in[11] + ((size_t)lg * 16 + hp) * 64; const float* ci = c.in[12] + ((size_t)lg * 16 + hp) * 64;
        const float* ap = AP + ((size_t)lg * 33 + tau) * 128; const float* bb = BB + (size_t)lg * 64 * 32 + h;
        float s = 0.f;
        for (int p = 0; p < 64; ++p) { const float er = cr[p] * ap[p] - ci[p] * ap[64 + p], ei = cr[p] * ap[64 + p] + ci[p] * ap[p]; s += er * bb[p * 32] - ei * bb[p * 32 + 16]; }
        KK[it] = s / expf(c.in[14][lg]);
    }
    for (size_t it = gt; it < (size_t)DEPTH * 16 * 128 * 512; it += GT) {
        const int kk = (int)(it & 511), pp = (int)((it >> 9) & 127), lg = (int)(it >> 16), p = pp & 63, s = kk >> 4, h = kk & 15;
        const float* ap = AP + ((size_t)lg * 33 + (31 - s)) * 128; const float* bb = BB + ((size_t)lg * 64 + p) * 32 + h;
        const float ar = ap[p], ai = ap[64 + p], br = bb[0], bi = bb[16];
        WE[it] = (f16)(((pp < 64) ? (ar * br - ai * bi) : (ar * bi + ai * br)) / expf(c.in[14][lg]));
    }
    for (size_t it = gt; it < (size_t)DEPTH * 16 * 512 * 128; it += GT) {
        const int pp = (int)(it & 127), row = (int)((it >> 7) & 511), lg = (int)(it >> 16), p = pp & 63, t = row >> 4, hp = row & 15;
        const float cr = c.in[11][((size_t)lg * 16 + hp) * 64 + p], ci = c.in[12][((size_t)lg * 16 + hp) * 64 + p];
        const float* ap = AP + ((size_t)lg * 33 + (t + 1)) * 128; const float ar = ap[p], ai = ap[64 + p];
        T[((size_t)lg * 512 + row) * 640 + 512 + pp] = (f16)((pp < 64) ? (cr * ar - ci * ai) : -(cr * ai + ci * ar));
    }
}
__device__ __forceinline__ void tables3(const Ctx& c) {
    const float* KK = wsp<float>(c, WS_S5KK); f16* T = wsp<f16>(c, WS_S5T);
    for (size_t it = (size_t)c.bid * 512 + c.tid; it < (size_t)DEPTH * 16 * 512 * 64; it += (size_t)c.G * 512) {
        const int k8 = (int)(it & 63), row = (int)((it >> 6) & 511), lg = (int)(it >> 15), s = k8 >> 1, h0 = (k8 & 1) * 8, t = row >> 4, hp = row & 15;
        h8 o;
        if (s <= t) { const float* kp = KK + (((size_t)lg * 32 + (t - s)) * 16 + hp) * 16 + h0; const f32x4 a = *(const f32x4*)kp, b = *(const f32x4*)(kp + 4);
#pragma unroll
            for (int e = 0; e < 4; ++e) { o[e] = (f16)a[e]; o[4 + e] = (f16)b[e]; } }
        else {
#pragma unroll
            for (int e = 0; e < 8; ++e) o[e] = (f16)0.f; }
        *(h8*)(T + ((size_t)lg * 512 + row) * 640 + 8 * k8) = o;
    }
}
__device__ __forceinline__ void carry_phase(const Ctx& c, int l) {
    f16* UG = wsp<f16>(c, WS_UG); const f16* WE = wsp<f16>(c, WS_S5WEND) + (size_t)l * 16 * 128 * 512; const float* AP = wsp<float>(c, WS_S5AP);
    int lane = c.lane; asm volatile("" : "+v"(lane));
    const int fr = lane & 15, fq = lane >> 4, tid = c.wid * 64 + lane;
    constexpr int AS = 520;
    LAS f16* AL = (LAS f16*)c.lds;
    LAS float* XL = (LAS float*)(c.lds + 67584);
    for (int u = c.bid; u < 256; u += c.G) { const int g = u >> 4, b = u & 15;
        const f16* arow = UG + ((size_t)g * 1024 + b * 64) * 640; const f16* wrow = WE + ((size_t)g * 128 + c.wid * 16 + fr) * 512;
#pragma unroll
        for (int i = 0; i < 8; ++i) { const int idx = tid + i * 512, r = idx >> 6, cg = idx & 63; *(LAS h8*)(AL + r * AS + 8 * cg) = *(const h8*)(arow + (size_t)r * 640 + 8 * cg); }
        h8 bf[16];
#pragma unroll
        for (int ks = 0; ks < 16; ++ks) bf[ks] = *(const h8*)(wrow + 32 * ks + 8 * fq);
        __syncthreads();
        f32x4 acc[4];
#pragma unroll
        for (int m = 0; m < 4; ++m) acc[m] = (f32x4){0.f, 0.f, 0.f, 0.f};
#pragma unroll
        for (int ks = 0; ks < 16; ++ks) {
#pragma unroll
            for (int m = 0; m < 4; ++m) { const h8 af = *(const LAS h8*)(AL + (16 * m + fr) * AS + 32 * ks + 8 * fq); acc[m] = __builtin_amdgcn_mfma_f32_16x16x32_f16(af, bf[ks], acc[m], 0, 0, 0); } }
#pragma unroll
        for (int m = 0; m < 4; ++m)
#pragma unroll
            for (int e = 0; e < 4; ++e) XL[(16 * m + 4 * fq + e) * 128 + c.wid * 16 + fr] = acc[m][e];
        __syncthreads();
        if (tid < 64) { const float* ap = AP + ((size_t)(l * 16 + g) * 33 + 32) * 128; const float ar = ap[tid], ai = ap[64 + tid]; float xr = 0.f, xi = 0.f;
            f16* xo = UG + ((size_t)g * 1024 + b * 64) * 640 + 512 + tid;
            for (int cc = 0; cc < 64; ++cc) { xo[(size_t)cc * 640] = (f16)xr; xo[(size_t)cc * 640 + 64] = (f16)xi;
                const float lr = XL[cc * 128 + tid], li = XL[cc * 128 + 64 + tid]; const float nr = ar * xr - ai * xi + lr, ni = ar * xi + ai * xr + li; xr = nr; xi = ni; } }
        __syncthreads();
    }
}
}

__device__ __forceinline__ void ph_s5_naive(const Ctx& c, int l) {
    const f16* Z = wsp<f16>(c, WS_Z); f16* YA = wsp<f16>(c, WS_YACT);
    const int gw = c.wid * c.G + c.bid, NGW = c.G * 8, p = c.lane;
    for (int u = gw; u < 256; u += NGW) {
        const int b = u >> 4, g = u & 15;
        const double dt = exp((double)c.in[14][l * 16 + g]);
        const double are = c.in[7][(l * 16 + g) * 64 + p], aim = c.in[8][(l * 16 + g) * 64 + p];
        const double mag = exp(dt * are), abr = mag * cos(dt * aim), abi = mag * sin(dt * aim);
        const double den = are * are + aim * aim, nr = abr - 1.0, ni = abi;
        const double fre = (nr * are + ni * aim) / den, fim = (ni * are - nr * aim) / den;
        float bbr[16], bbi[16], cr[16], ci[16];
#pragma unroll
        for (int h = 0; h < 16; ++h) {
            const double br = c.in[9][((size_t)(l * 16 + g) * 64 + p) * 16 + h], bi = c.in[10][((size_t)(l * 16 + g) * 64 + p) * 16 + h];
            bbr[h] = (float)(fre * br - fim * bi); bbi[h] = (float)(fre * bi + fim * br);
            cr[h] = c.in[11][((size_t)(l * 16 + g) * 16 + h) * 64 + p]; ci[h] = c.in[12][((size_t)(l * 16 + g) * 16 + h) * 64 + p];
        }
        const float ar = (float)abr, ai = (float)abi;
        const float dsk = c.lane < 16 ? c.in[13][l * 256 + g * 16 + c.lane] : 0.f;
        float xr = 0.f, xi = 0.f;
        for (int t = 0; t < SEQ; ++t) {
            const size_t n = (size_t)b * SEQ + t;
            const f16* up = Z + n * DIN + ZU + g * 16; const f16x8 u0 = *(const f16x8*)up, u1 = *(const f16x8*)(up + 8);
            float uu[16];
#pragma unroll
            for (int h = 0; h < 8; ++h) { uu[h] = (float)u0[h]; uu[8 + h] = (float)u1[h]; }
            float br = 0.f, bi = 0.f;
#pragma unroll
            for (int h = 0; h < 16; ++h) { br += bbr[h] * uu[h]; bi += bbi[h] * uu[h]; }
            const float nxr = ar * xr - ai * xi + br, nxi = ar * xi + ai * xr + bi; xr = nxr; xi = nxi;
            float yv = 0.f;
#pragma unroll
            for (int h = 0; h < 16; ++h) { const float s = wave_sum(cr[h] * xr - ci[h] * xi); if (c.lane == h) yv = s; }
            float ul = 0.f;
#pragma unroll
            for (int h = 0; h < 16; ++h) if (c.lane == h) ul = uu[h];
            if (c.lane < 16) YA[n * 256 + g * 16 + c.lane] = (f16)gelu_tanh(yv + dsk * ul);
        }
    }
}
__device__ __forceinline__ void ph_lru_conv(const Ctx& c, int l) {
    const f16* Z = wsp<f16>(c, WS_Z); float* XC = wsp<float>(c, WS_XC);
    const float* cw = c.in[17] + l * 4 * 256; const float* cb = c.in[18] + l * 256;
    for (size_t it = (size_t)c.bid * 512 + c.tid; it < (size_t)NTOK * 256; it += (size_t)c.G * 512) {
        const int ch = (int)(it & 255); const size_t n = it >> 8; const int t = (int)(n & 2047);
        float s = cb[ch];
#pragma unroll
        for (int j = 0; j < 4; ++j) { const int tt = t - 3 + j; if (tt >= 0) s += cw[j * 256 + ch] * (float)Z[(n - 3 + j) * DIN + ZXL + ch]; }
        XC[it] = s;
    }
}
__device__ __forceinline__ void ph_lru_gate(const Ctx& c, int l) {
    const float* XC = wsp<float>(c, WS_XC); float* LA = wsp<float>(c, WS_LA); float* LB = wsp<float>(c, WS_LB);
    const float* wa = c.in[19] + (size_t)l * 4 * 64 * 64; const float* wx = c.in[21] + (size_t)l * 4 * 64 * 64;
    const float* ba = c.in[20] + l * 256; const float* bx = c.in[22] + l * 256; const float* lam = c.in[23] + l * 256;
    for (size_t it = (size_t)c.bid * 512 + c.tid; it < (size_t)NTOK * 256; it += (size_t)c.G * 512) {
        const int ch = (int)(it & 255), hd = ch >> 6, j = ch & 63; const size_t n = it >> 8;
        const float* xp = XC + n * 256 + hd * 64; const float* wap = wa + (size_t)hd * 4096 + j; const float* wxp = wx + (size_t)hd * 4096 + j;
        float sa = ba[ch], sx = bx[ch];
        for (int i = 0; i < 64; ++i) { const float xv = xp[i]; sa += xv * wap[i * 64]; sx += xv * wxp[i * 64]; }
        const float r = sigmoidf_(sa), ig = sigmoidf_(sx);
        const float lm = lam[ch], sp = fmaxf(-lm, 0.f) + log1pf(expf(-fabsf(lm)));
        const float log_a = -8.0f * r * sp;
        LA[it] = expf(log_a); LB[it] = sqrtf(-expm1f(2.0f * log_a)) * (ig * XC[it]);
    }
}
__device__ __forceinline__ void ph_lru_scan(const Ctx& c) {
    const f16* Z = wsp<f16>(c, WS_Z); const float* LA = wsp<float>(c, WS_LA); const float* LB = wsp<float>(c, WS_LB); f16* Y = wsp<f16>(c, WS_Y);
    for (int it = c.bid * 512 + c.tid; it < BATCH * 256; it += c.G * 512) {
        const int ch = it & 255, b = it >> 8; float h = 0.f;
        for (int t = 0; t < SEQ; ++t) { const size_t n = (size_t)b * SEQ + t;
            h = LA[n * 256 + ch] * h + LB[n * 256 + ch];
            Y[n * D + 768 + ch] = (f16)(h * gelu_tanh((float)Z[n * DIN + ZGL + ch])); }
    }
}
__device__ __forceinline__ void ph_norm_attn(const Ctx& c) {
    f16* Y = wsp<f16>(c, WS_Y);
    int r0, r1;
    if (c.bid < 128) { const int w = c.bid * 8 + c.wid; r0 = w * 8; r1 = r0 + 8; } else { const int w = (c.bid - 128) * 8 + c.wid; r0 = 8192 + w * 24; r1 = r0 + 24; }
    if (c.G != 256) { const int w = c.bid * 8 + c.wid, per = (NTOK + c.G * 8 - 1) / (c.G * 8); r0 = w * per; r1 = r0 + per < NTOK ? r0 + per : NTOK; }
    for (int m = r0; m < r1; ++m) { f16* rp = Y + (size_t)m * D + 8 * c.lane; const f16x8 v = *(const f16x8*)rp; float s = 0.f;
#pragma unroll
        for (int i = 0; i < 8; ++i) s += (float)v[i] * (float)v[i];
        const float ra = 1.0f / sqrtf(wave_sum(s) * (1.0f / 512.0f) + 1e-6f); f16x8 o;
#pragma unroll
        for (int i = 0; i < 8; ++i) o[i] = (f16)((float)v[i] * ra);
        *(f16x8*)rp = o; }
}
__device__ __forceinline__ void ph_ln_inplace(const Ctx& c, const float* g, const float* b) {
    f16* H = wsp<f16>(c, WS_H); const int gw = c.wid * c.G + c.bid, NGW = c.G * 8;
    float gg[16], bb[16]; vec_load16(g, c.lane, gg); vec_load16(b, c.lane, bb);
    for (int m = gw * 4; m < NTOK; m += NGW * 4) {
        float v[4][16];
#pragma unroll
        for (int r = 0; r < 4; ++r) row_load16(H + (size_t)(m + r) * D, c.lane, v[r]);
        ln_rows<4>(v, gg, bb);
#pragma unroll
        for (int r = 0; r < 4; ++r) row_store16(H + (size_t)(m + r) * D, c.lane, v[r]);
    }
}
__device__ __forceinline__ void ph_xattn_naive(const Ctx& c, int l) {
    const f16* QX = wsp<f16>(c, WS_QX); const f16* KM = wsp<f16>(c, WS_KM) + (size_t)l * NMEM * D; const f16* VM = wsp<f16>(c, WS_VM) + (size_t)l * NMEM * D;
    f16* OC = wsp<f16>(c, WS_OC);
    LAS float* pl = (LAS float*)c.lds + c.wid * 256;
    const int gw = c.bid * 8 + c.wid, NGW = c.G * 8;
    for (int it = gw; it < NTOK * 4; it += NGW) {
        const int hh = it & 3; const size_t n = (size_t)(it >> 2); const int b = (int)(n >> 11);
        const f16* qp = QX + n * D + hh * 256; const f16* kb = KM + (size_t)b * 256 * D + hh * 256; const f16* vb = VM + (size_t)b * 256 * D + hh * 256;
        float s[4] = {0.f, 0.f, 0.f, 0.f};
        for (int d8 = 0; d8 < 32; ++d8) { const f16x8 qv = *(const f16x8*)(qp + 8 * d8);
#pragma unroll
            for (int kk = 0; kk < 4; ++kk) { const f16x8 kv = *(const f16x8*)(kb + (size_t)(c.lane + 64 * kk) * D + 8 * d8);
#pragma unroll
                for (int j = 0; j < 8; ++j) s[kk] += (float)qv[j] * (float)kv[j]; } }
        const float mx = wave_max(fmaxf(fmaxf(s[0], s[1]), fmaxf(s[2], s[3])));
        float ps = 0.f;
#pragma unroll
        for (int kk = 0; kk < 4; ++kk) { s[kk] = exp2f(s[kk] - mx); ps += s[kk]; }
        const float rl = 1.0f / wave_sum(ps);
#pragma unroll
        for (int kk = 0; kk < 4; ++kk) pl[c.lane + 64 * kk] = s[kk] * rl;
        asm volatile("s_waitcnt lgkmcnt(0)" ::: "memory");
        float o[4] = {0.f, 0.f, 0.f, 0.f};
        for (int key = 0; key < 256; ++key) { const float p = pl[key]; const f16x4 vv = *(const f16x4*)(vb + (size_t)key * D + 4 * c.lane);
#pragma unroll
            for (int j = 0; j < 4; ++j) o[j] += p * (float)vv[j]; }
        f16x4 ov;
#pragma unroll
        for (int j = 0; j < 4; ++j) ov[j] = (f16)o[j];
        *(f16x4*)(OC + n * D + hh * 256 + 4 * c.lane) = ov;
        asm volatile("s_waitcnt lgkmcnt(0)" ::: "memory");
    }
}
__device__ __forceinline__ void ph_ln2_route(const Ctx& c, int l) {
    typedef _Float16 h8 __attribute__((ext_vector_type(8)));
    f16* H = wsp<f16>(c, WS_H); int* TE = wsp<int>(c, WS_TOKE); float* TW = wsp<float>(c, WS_TOKW); int* HIST = wsp<int>(c, WS_HIST);
    const float* wrg = c.in[32] + (size_t)l * D * 4; const float* brg = c.in[33] + l * 4; const float* wre = c.in[34] + (size_t)l * D * 16; const float* bre = c.in[35] + l * 16;
    constexpr int WS_ = 1032;
    LAS f16* WR = (LAS f16*)c.lds;
    LAS float* LG = (LAS float*)(c.lds + 66560) + c.wid * 512;
    LAS int* hl = (LAS int*)(c.lds + 66560 + 16384);
    int lane = c.lane; asm volatile("" : "+v"(lane));
    const int fr = lane & 15, fq = lane >> 4;
    for (int k = c.tid; k < D; k += 512) { const f32x4 g4 = *(const f32x4*)(wrg + (size_t)k * 4);
        const f32x4 e0 = *(const f32x4*)(wre + (size_t)k * 16), e1 = *(const f32x4*)(wre + (size_t)k * 16 + 4), e2 = *(const f32x4*)(wre + (size_t)k * 16 + 8), e3 = *(const f32x4*)(wre + (size_t)k * 16 + 12);
#pragma unroll
        for (int o = 0; o < 4; ++o) { WR[o * WS_ + k] = (f16)g4[o]; WR[(4 + o) * WS_ + k] = (f16)e0[o]; WR[(8 + o) * WS_ + k] = (f16)e1[o]; WR[(12 + o) * WS_ + k] = (f16)e2[o]; WR[(16 + o) * WS_ + k] = (f16)e3[o]; }
#pragma unroll
        for (int o = 20; o < 32; ++o) WR[o * WS_ + k] = (f16)0.f; }
    if (c.tid < 16) hl[c.tid] = 0;
    float gg[16], bb[16]; vec_load16(c.in[30] + l * D, lane, gg); vec_load16(c.in[31] + l * D, lane, bb);
    __syncthreads();
    for (int blk = c.bid; blk < NTOK / 128; blk += c.G) {
        const int m0 = blk * 128 + c.wid * 16;
#pragma unroll 1
        for (int r = 0; r < 16; r += 4) { float v[4][16];
#pragma unroll
            for (int q = 0; q < 4; ++q) row_load16(H + (size_t)(m0 + r + q) * D, lane, v[q]);
            ln_rows<4>(v, gg, bb);
#pragma unroll
            for (int q = 0; q < 4; ++q) row_store16(H + (size_t)(m0 + r + q) * D, lane, v[q]); }
        asm volatile("s_waitcnt vmcnt(0)" ::: "memory");
        f32x4 acc[2] = {(f32x4){0.f, 0.f, 0.f, 0.f}, (f32x4){0.f, 0.f, 0.f, 0.f}};
        const f16* arow = H + (size_t)(m0 + fr) * D + 8 * fq;
#pragma unroll 8
        for (int ks = 0; ks < 32; ++ks) { const h8 af = *(const h8*)(arow + 32 * ks);
            const h8 b0 = *(const LAS h8*)(WR + fr * WS_ + 32 * ks + 8 * fq), b1 = *(const LAS h8*)(WR + (16 + fr) * WS_ + 32 * ks + 8 * fq);
            acc[0] = __builtin_amdgcn_mfma_f32_16x16x32_f16(af, b0, acc[0], 0, 0, 0); acc[1] = __builtin_amdgcn_mfma_f32_16x16x32_f16(af, b1, acc[1], 0, 0, 0); }
#pragma unroll
        for (int e = 0; e < 4; ++e) { LG[(4 * fq + e) * 32 + fr] = acc[0][e]; LG[(4 * fq + e) * 32 + 16 + fr] = acc[1][e]; }
        asm volatile("s_waitcnt lgkmcnt(0)" ::: "memory");
        if (lane < 16) { const int m = m0 + lane; float lg[20];
#pragma unroll
            for (int q = 0; q < 5; ++q) { const f32x4 t4 = *(const LAS f32x4*)(LG + lane * 32 + 4 * q); lg[4 * q] = t4[0]; lg[4 * q + 1] = t4[1]; lg[4 * q + 2] = t4[2]; lg[4 * q + 3] = t4[3]; }
            float gl[4];
#pragma unroll
            for (int o = 0; o < 4; ++o) gl[o] = lg[o] + brg[o];
            int gi = 0; float gmax = gl[0];
#pragma unroll
            for (int o = 1; o < 4; ++o) if (gl[o] > gmax) { gmax = gl[o]; gi = o; }
            float gs = 0.f;
#pragma unroll
            for (int o = 0; o < 4; ++o) gs += expf(gl[o] - gmax);
            const float gw_ = 1.0f / gs;
            float el[4];
#pragma unroll
            for (int o = 0; o < 4; ++o) { float x = 0.f;
#pragma unroll
                for (int g = 0; g < 4; ++g) if (g == gi) x = lg[4 + 4 * g + o] + bre[4 * g + o];
                el[o] = x; }
            int i1 = 0; float v1 = el[0];
#pragma unroll
            for (int o = 1; o < 4; ++o) if (el[o] > v1) { v1 = el[o]; i1 = o; }
            int i2 = -1; float v2 = 0.f;
#pragma unroll
            for (int o = 0; o < 4; ++o) if (o != i1 && (i2 < 0 || el[o] > v2)) { i2 = o; v2 = el[o]; }
            const float p2 = expf(v2 - v1), w1 = gw_ / (1.0f + p2), w2 = gw_ * p2 / (1.0f + p2);
            const int e1 = gi * 4 + i1, e2 = gi * 4 + i2;
            TE[2 * m] = e1; TE[2 * m + 1] = e2; TW[2 * m] = w1; TW[2 * m + 1] = w2;
            atomicAdd((int*)(hl + e1), 1); atomicAdd((int*)(hl + e2), 1);
        }
        __syncthreads();
        if (c.tid < 16) { HIST[blk * 16 + c.tid] = hl[c.tid]; hl[c.tid] = 0; }
        __syncthreads();
    }
}
__device__ __forceinline__ void ph_lists(const Ctx& c) {
    const int* TE = wsp<int>(c, WS_TOKE); const float* TW = wsp<float>(c, WS_TOKW); const int* HIST = wsp<int>(c, WS_HIST);
    int* RT = wsp<int>(c, WS_ROWTOK); float* RW = wsp<float>(c, WS_ROWW); int* TX = wsp<int>(c, WS_TILEEXP); int* RSRC = wsp<int>(c, WS_ROWSRC);
    LAS int* sh = (LAS int*)c.lds;
    for (int blk = c.bid; blk < NTOK / 128; blk += c.G) {
        { const int e = c.tid & 15, part = c.tid >> 4; int cnt = 0, before = 0;
          for (int i = 0; i < 8; ++i) { const int b2 = part * 8 + i; const int hv = HIST[b2 * 16 + e]; cnt += hv; if (b2 < blk) before += hv; }
          sh[512 + part * 16 + e] = cnt; sh[1024 + part * 16 + e] = before; }
        int my_e = -1, my_rank = 0; float my_w = 0.f;
        if (c.tid < 256) { my_e = TE[blk * 256 + c.tid]; my_w = TW[blk * 256 + c.tid]; }
        if (c.wid < 4) {
            const unsigned long long lt = (c.lane == 0) ? 0ull : (~0ull >> (64 - c.lane));
#pragma unroll
            for (int ee = 0; ee < 16; ++ee) { const unsigned long long m = __ballot(my_e == ee); if (my_e == ee) my_rank = __popcll(m & lt); if (c.lane == 0) sh[64 + c.wid * 16 + ee] = __popcll(m); }
        }
        __syncthreads();
        if (c.tid < 16) { int cnt = 0, before = 0; for (int p = 0; p < 32; ++p) { cnt += sh[512 + p * 16 + c.tid]; before += sh[1024 + p * 16 + c.tid]; } sh[c.tid] = cnt; sh[32 + c.tid] = before; }
        __syncthreads();
        if (c.tid < 16) { int off = 0; for (int e = 0; e < 16; ++e) { if (e == c.tid) break; off += (sh[e] + 255) & ~255; } sh[16 + c.tid] = off; }
        __syncthreads();
        if (c.tid < 256) { int pos = sh[16 + my_e] + sh[32 + my_e] + my_rank;
            for (int w = 0; w < 4; ++w) if (w < c.wid) pos += sh[64 + w * 16 + my_e];
            RT[pos] = blk * 256 + c.tid; RW[pos] = my_w; RSRC[pos] = blk * 128 + (c.tid >> 1); }
        if (blk < 16 && c.tid >= 256) { const int e = blk, cnt = sh[e], pad = ((cnt + 255) & ~255) - cnt, i = c.tid - 256; if (i < pad) { RT[sh[16 + e] + cnt + i] = -1; RW[sh[16 + e] + cnt + i] = 0.f; RSRC[sh[16 + e] + cnt + i] = 0; } }
        if (blk == 0 && c.tid == 0) { int nt = 0; for (int e = 0; e < 16; ++e) { const int k = (sh[e] + 255) >> 8; for (int i = 0; i < k; ++i) TX[1 + nt + i] = e; nt += k; } TX[0] = nt; }
        __syncthreads();
    }
}
__device__ __forceinline__ void ph_final(const Ctx& c, int l) {
    f16* H = wsp<f16>(c, WS_H); const f16* YS = wsp<f16>(c, WS_YS); const int gw = c.wid * c.G + c.bid, NGW = c.G * 8;
    float gg[16], bb[16]; vec_load16(c.in[39] + l * D, c.lane, gg); vec_load16(c.in[40] + l * D, c.lane, bb);
    for (int m = gw * 2; m < NTOK; m += NGW * 2) {
        float v[2][16];
#pragma unroll
        for (int r = 0; r < 2; ++r) { float a[16], b[16]; row_load16_nt(H + (size_t)(m + r) * D, c.lane, v[r]); row_load16_nt(YS + (size_t)(2 * (m + r)) * D, c.lane, a); row_load16_nt(YS + (size_t)(2 * (m + r) + 1) * D, c.lane, b);
#pragma unroll
            for (int i = 0; i < 16; ++i) v[r][i] = ALPHA * v[r][i] + (a[i] + b[i]); }
        ln_rows<2>(v, gg, bb);
#pragma unroll
        for (int r = 0; r < 2; ++r) {
            if (l == DEPTH - 1) { float* o = c.out + (size_t)(m + r) * D;
                __builtin_nontemporal_store((f32x4){v[r][0], v[r][1], v[r][2], v[r][3]}, (f32x4*)(o + 8 * c.lane)); __builtin_nontemporal_store((f32x4){v[r][4], v[r][5], v[r][6], v[r][7]}, (f32x4*)(o + 8 * c.lane + 4));
                __builtin_nontemporal_store((f32x4){v[r][8], v[r][9], v[r][10], v[r][11]}, (f32x4*)(o + 512 + 8 * c.lane)); __builtin_nontemporal_store((f32x4){v[r][12], v[r][13], v[r][14], v[r][15]}, (f32x4*)(o + 512 + 8 * c.lane + 4));
            } else row_store16(H + (size_t)(m + r) * D, c.lane, v[r]); }
    }
}

constexpr int CW_Q = 8192;
__device__ __forceinline__ void b2_queue(const Ctx& c, int l, unsigned* ctr, volatile LAS unsigned* slot) {
    for (;;) {
        if (c.tid == 0) slot[0] = __hip_atomic_fetch_add(ctr, 1u, __ATOMIC_RELAXED, __HIP_MEMORY_SCOPE_AGENT);
        __syncthreads();
        const int idx = (int)slot[0];
        __syncthreads();
        if (idx >= 1536) break;
        if (idx < 16 * att::ATT_NBIG) { const int cb = att::ATT_ORDER[idx >> 4]; att::attn_unit(c, idx & 15, cb >> 3, cb & 7); }
        else if (idx < 16 * att::ATT_NBIG + 512) { const int u = idx - 16 * att::ATT_NBIG; lru::lru_unit<2>(c, l, u >> 5, u & 31); }
        else { const int k = idx - 512; const int cb = att::ATT_ORDER[k >> 4]; att::attn_unit(c, k & 15, cb >> 3, cb & 7); }
    }
}

constexpr int PH_PRO = 0, PH_L0 = 1, PL = 13, NPHASE = PH_L0 + DEPTH * PL;
enum { L_WIN = 0, L_B1, L_B2, L_GLU, L_WOUT, L_WQ, L_XATTN, L_WO, L_LN2R, L_LISTS, L_MOE1, L_MOE2, L_FIN };

struct Args { const float* in[41]; float* out; unsigned char* ws; int ph_lo, ph_hi; };

__global__ void __launch_bounds__(512, 2) fwd_kernel(Args args) {
    extern __shared__ __attribute__((aligned(16))) unsigned char lds_raw[];
    Ctx c0;
    c0.in = args.in;
    c0.out = args.out; c0.ws = args.ws; c0.lds = (LAS unsigned char*)lds_raw;
    c0.tid = threadIdx.x; c0.lane = c0.tid & 63; c0.wid = __builtin_amdgcn_readfirstlane(c0.tid >> 6); c0.G = gridDim.x; c0.bid = blockIdx.x;
    volatile LAS unsigned* MISC = (volatile LAS unsigned*)(c0.lds + MISC_OFF);
    if (c0.tid < 32) MISC[c0.tid] = 0u;
    __syncthreads();
    XcdBarrier bar; bar.bar = (unsigned*)(c0.ws + WS_CTL) + CW_BAR; bar.x = 0; bar.st = nullptr;
    const int lo = args.ph_lo, hi = args.ph_hi;
    const bool multi = (hi - lo) > 1;
    if (multi) bar = xcd_barrier_post((unsigned*)(c0.ws + WS_CTL) + CW_BAR, MISC + 8);
#define IN(k) (lo <= (k) && (k) < hi)
#define SEAM(k) do { if (IN(k) && IN((k) + 1)) xcd_barrier(bar); } while (0)
#define GEMM(EPI, SCHED, g, S, E) pg8::gemm_phase<EPI, SCHED, true, true>(c.lds, g, S, E, c.tid)

    if (IN(PH_PRO)) { const Ctx c = fresh(c0); s5::tables1(c); ph_conv(c); ph_ln0(c); } SEAM(PH_PRO);
#define LAYER_BODY(l) do {         const int P0 = PH_L0 + l * PL; \
        if (IN(P0 + L_WIN)) for (int rep_ = 0; rep_ < REPS(L_WIN); ++rep_) { if (rep_) __syncthreads(); const Ctx c = fresh(c0); \
            if (l == 0) { s5::tables2(c); ph_fold_vectors(c); } \
            if (c.bid >= 128) { LAS float* scr = (LAS float*)(c.lds + c.wid * 16384);       \
                for (int it = (c.bid - 128) * 8 + c.wid; it < MOE_CONV_ITEMS; it += 128 * 8) conv_moe_item(c, l, it, scr); } \
            __syncthreads(); \
            pg8::Gemm g{(const f16*)c.ws, (const f16*)c.ws, D, D, D}; pg8::WinKvOrder S; S.so.init(NTOK, DIN, c.G, c.bid); S.lay = l; \
            pg8::EWinKv E{pg8::EStoreWin{wsp<f16>(c, WS_Z), wsp<f16>(c, WS_UG)}, pg8::EStoreKV2{wsp<f16>(c, WS_KM), wsp<f16>(c, WS_VM)}}; GEMM(pg8::EWinKv, pg8::WinKvOrder, g, S, E); } \
        SEAM(P0 + L_WIN); \
        if (IN(P0 + L_B1)) for (int rep_ = 0; rep_ < REPS(L_B1); ++rep_) { if (rep_) __syncthreads(); const Ctx c = fresh(c0); if (l == 0) s5::tables3(c); ph_kmean(c); s5::carry_phase(c, l); } \
        SEAM(P0 + L_B1); \
        if (IN(P0 + L_B2)) for (int rep_ = 0; rep_ < REPS(L_B2); ++rep_) { if (rep_) __syncthreads(); const Ctx c = fresh(c0); \
            { pg8::Gemm g{wsp<f16>(c, WS_UG), wsp<f16>(c, WS_S5T) + (size_t)l * 16 * 512 * 640, 640, 640, 640}; pg8::S5Order S{c.G, c.bid}; \
              pg8::ES5 E{wsp<f16>(c, WS_UG), wsp<f16>(c, WS_YACT), c.in[13] + l * 256, c.in[14] + l * 16}; GEMM(pg8::ES5, pg8::S5Order, g, S, E); } \
            __syncthreads(); \
            b2_queue(c, l, (unsigned*)(c.ws + WS_CTL) + CW_Q + 64 * (l * 4 + rep_), MISC + 16); } \
        SEAM(P0 + L_B2); \
        if (IN(P0 + L_GLU)) for (int rep_ = 0; rep_ < REPS(L_GLU); ++rep_) { if (rep_) __syncthreads(); const Ctx c = fresh(c0); \
            pg8::Gemm g{wsp<f16>(c, WS_YACT), wsp<f16>(c, WS_WGLU_T) + (size_t)l * 256 * 256, 256, 256, 256}; pg8::StaticOrder S; S.init(NTOK, 256, c.G, c.bid); \
            pg8::EGlu E{wsp<f16>(c, WS_YACT), c.in[16] + l * 256, wsp<f16>(c, WS_Y), (LAS float*)(c.lds + 132096)}; GEMM(pg8::EGlu, pg8::StaticOrder, g, S, E); \
            ph_norm_attn(c); } \
        SEAM(P0 + L_GLU); \
        if (IN(P0 + L_WOUT)) { const Ctx c = fresh(c0); \
            pg8::Gemm g{wsp<f16>(c, WS_Y), wsp<f16>(c, WS_WOUT_T) + (size_t)l * D * D, D, D, D}; pg8::StaticOrder S; S.init(NTOK, D, c.G, c.bid); \
            pg8::EResidStats E{wsp<f16>(c, WS_H), wsp<float>(c, WS_STATS1), (LAS float*)(c.lds + 132096)}; GEMM(pg8::EResidStats, pg8::StaticOrder, g, S, E); } \
        SEAM(P0 + L_WOUT); \
        if (IN(P0 + L_WQ)) { const Ctx c = fresh(c0); \
            pg8::Gemm g{wsp<f16>(c, WS_H), wsp<f16>(c, WS_WQ_T) + (size_t)l * D * D, D, D, D}; pg8::StaticOrder S; S.init(NTOK, D, c.G, c.bid); \
            pg8::EStoreLN E{wsp<f16>(c, WS_QX), D, wsp<float>(c, WS_STATS1), wsp<float>(c, WS_S1Q) + l * D, wsp<float>(c, WS_S2Q) + l * D}; GEMM(pg8::EStoreLN, pg8::StaticOrder, g, S, E); } \
        SEAM(P0 + L_WQ); \
        if (IN(P0 + L_XATTN)) { const Ctx c = fresh(c0); \
            pg8::Gemm g{(const f16*)c.ws, (const f16*)c.ws, 256, D, D}; pg8::ChainOrder S{c.G, c.bid, l}; \
            pg8::EChain E{pg8::ESoftmaxP{wsp<f16>(c, WS_P), (LAS float*)(c.lds + 132096)}, pg8::EStore{wsp<f16>(c, WS_OC), D}}; \
            GEMM(pg8::EChain, pg8::ChainOrder, g, S, E); } \
        SEAM(P0 + L_XATTN); \
        if (IN(P0 + L_WO)) { const Ctx c = fresh(c0); \
            pg8::Gemm g{wsp<f16>(c, WS_OC), wsp<f16>(c, WS_WO_T) + (size_t)l * D * D, D, D, D}; pg8::StaticOrder S; S.init(NTOK, D, c.G, c.bid); \
            pg8::EResidLN E{wsp<f16>(c, WS_H), wsp<float>(c, WS_STATS1), c.in[24] + l * D, c.in[25] + l * D}; GEMM(pg8::EResidLN, pg8::StaticOrder, g, S, E); } \
        SEAM(P0 + L_WO); \
        if (IN(P0 + L_LN2R)) for (int rep_ = 0; rep_ < REPS(L_LN2R); ++rep_) { if (rep_) __syncthreads(); const Ctx c = fresh(c0); ph_ln2_route(c, l); } \
        SEAM(P0 + L_LN2R); \
        if (IN(P0 + L_LISTS)) for (int rep_ = 0; rep_ < REPS(L_LISTS); ++rep_) { if (rep_) __syncthreads(); const Ctx c = fresh(c0); ph_lists(c); } \
        SEAM(P0 + L_LISTS); \
        if (IN(P0 + L_MOE1)) for (int rep_ = 0; rep_ < REPS(L_MOE1); ++rep_) { if (rep_) __syncthreads(); const Ctx c = fresh(c0); \
            pg8::Gemm g{wsp<f16>(c, WS_H), wsp<f16>(c, WS_WGU_T), D, D, D, wsp<int>(c, WS_ROWSRC)}; pg8::MoeOrder S; S.init(wsp<int>(c, WS_TILEEXP), 2, c.G, c.bid); \
            pg8::ESiluMul E{wsp<f16>(c, WS_HE)}; pg8::gemm_phase<pg8::ESiluMul, pg8::MoeOrder, true, true, true>(c.lds, g, S, E, c.tid); } \
        SEAM(P0 + L_MOE1); \
        if (IN(P0 + L_MOE2)) for (int rep_ = 0; rep_ < REPS(L_MOE2); ++rep_) { if (rep_) __syncthreads(); const Ctx c = fresh(c0); \
            pg8::Gemm g{wsp<f16>(c, WS_HE), wsp<f16>(c, WS_WD_T), DEXP, DEXP, DEXP}; pg8::MoeOrder S; S.init(wsp<int>(c, WS_TILEEXP), 4, c.G, c.bid); \
            pg8::EScatter E{wsp<int>(c, WS_ROWTOK), wsp<float>(c, WS_ROWW), wsp<f16>(c, WS_YS)}; GEMM(pg8::EScatter, pg8::MoeOrder, g, S, E); } \
        SEAM(P0 + L_MOE2); \
        if (IN(P0 + L_FIN)) for (int rep_ = 0; rep_ < REPS(L_FIN); ++rep_) { if (rep_) __syncthreads(); const Ctx c = fresh(c0); ph_final(c, l); } \
        if (l + 1 < DEPTH) SEAM(P0 + L_FIN); \
     } while (0)
    LAYER_BODY(0);
    LAYER_BODY(1);
#undef LAYER_BODY
#undef IN
#undef SEAM
#undef GEMM
}

extern "C" void kernel_launch(void* const* d_in, const int* in_sizes, int n_in, void* d_out, int out_size, void* d_ws, size_t ws_size, hipStream_t stream) {
    static int grid = 0;
    if (grid == 0) {
        if (n_in != 41 || out_size != NTOK * D || ws_size < WS_END) { fprintf(stderr, "kernel_launch: unexpected problem (n_in %d out %d ws %zu)\n", n_in, out_size, ws_size); grid = -1; return; }
        if (hipFuncSetAttribute((const void*)fwd_kernel, hipFuncAttributeMaxDynamicSharedMemorySize, LDS_BYTES) != hipSuccess) { fprintf(stderr, "kernel_launch: hipFuncSetAttribute failed\n"); grid = -1; return; }
        int dev = 0, cus = 0, per_cu = 0;
        hipGetDevice(&dev); hipDeviceGetAttribute(&cus, hipDeviceAttributeMultiprocessorCount, dev);
        hipOccupancyMaxActiveBlocksPerMultiprocessor(&per_cu, (const void*)fwd_kernel, 512, LDS_BYTES);
        (void)hipGetLastError();
        if (per_cu < 1) fprintf(stderr, "kernel_launch: occupancy query says %d\n", per_cu);
        grid = cus > 256 ? 256 : cus;
        if (grid != 256) fprintf(stderr, "kernel_launch: grid %d != 256\n", grid);
    }
    if (grid < 0) return;
    hipMemsetAsync((char*)d_ws + WS_CTL, 0, CTL_ZERO_BYTES, stream);
    Args a{};
    for (int i = 0; i < 41; ++i) a.in[i] = (const float*)d_in[i];
    a.out = (float*)d_out; a.ws = (unsigned char*)d_ws;
#if MK_ONE_LAUNCH
    a.ph_lo = 0; a.ph_hi = NPHASE;
    hipLaunchKernelGGL(fwd_kernel, dim3(grid), dim3(512), LDS_BYTES, stream, a);
#else
    for (int p = 0; p < NPHASE; ++p) { a.ph_lo = p; a.ph_hi = p + 1; hipLaunchKernelGGL(fwd_kernel, dim3(grid), dim3(512), LDS_BYTES, stream, a); }
#endif
}
```

```cpp
#include <hip/hip_runtime.h>
#include <cstdio>
#include <cstdint>

#ifndef MK_ONE_LAUNCH
#define MK_ONE_LAUNCH 1
#endif
#ifndef PROBE_REP
#define PROBE_REP -1
#endif
#ifndef PROBE_N
#define PROBE_N 2
#endif
#define REPS(k) (((k) == PROBE_REP) ? (PROBE_N + 1) : 1)

typedef _Float16 f16;
typedef _Float16 f16x8 __attribute__((ext_vector_type(8)));
typedef _Float16 f16x4 __attribute__((ext_vector_type(4)));
typedef float f32x4 __attribute__((ext_vector_type(4)));
#define LAS __attribute__((address_space(3)))
#define GAS __attribute__((address_space(1)))
typedef GAS unsigned gu32;

constexpr int BATCH = 16, SEQ = 2048, NTOK = BATCH * SEQ, D = 1024, DIN = 2304, DEPTH = 2;
constexpr int MEMLEN = 256, NMEM = BATCH * MEMLEN;
constexpr int ZQ = 0, ZK = 512, ZV = 1024, ZU = 1536, ZXL = 1792, ZGL = 2048;
constexpr int NEXP = 16, DEXP = 256;
constexpr float ALPHA = 1.4142135623730951f;
constexpr float LOG2E = 1.4426950408889634f;
constexpr float QSCALE = 0.125f * LOG2E;
constexpr float XQSCALE = 0.0625f * LOG2E;
constexpr int MOE_MAXROWS = 2 * NTOK + NEXP * 256;

constexpr size_t MiB = 1u << 20;
constexpr size_t WS_CTL = 0, CTL_ZERO_BYTES = 64 * 1024;
constexpr size_t WS_KMEAN = 1 * MiB;
constexpr size_t WS_TOKE = 2 * MiB;
constexpr size_t WS_TOKW = 3 * MiB;
constexpr size_t WS_HIST = 4 * MiB;
constexpr size_t WS_ROWTOK = 5 * MiB;
constexpr size_t WS_ROWW = 6 * MiB;
constexpr size_t WS_TILEEXP = 7 * MiB;
constexpr size_t WS_ROWSRC = 9 * MiB;
constexpr size_t WS_S1Q = 10 * MiB, WS_S2Q = 10 * MiB + 64 * 1024;
constexpr size_t WS_STATS1 = 11 * MiB;
constexpr size_t WS_LRUENDS = 8 * MiB;
constexpr size_t WS_MEM16 = 16 * MiB;
constexpr size_t WS_KM = 24 * MiB;
constexpr size_t WS_VM = 40 * MiB;
constexpr size_t WS_H = 56 * MiB;
constexpr size_t WS_WREG = 120 * MiB;
constexpr size_t WS_S5AP = 120 * MiB, WS_S5BB = 121 * MiB, WS_S5KK = 122 * MiB, WS_S5WEND = 124 * MiB, WS_S5T = 128 * MiB, WS_UG = 152 * MiB;
constexpr size_t WS_XC = 120 * MiB;
constexpr size_t WS_LA = 152 * MiB;
constexpr size_t WS_LB = 184 * MiB;
constexpr size_t WS_ARENA = 280 * MiB;
constexpr size_t WS_Z = WS_ARENA;
constexpr size_t WS_Y = WS_ARENA + 144 * MiB;
constexpr size_t WS_YACT = WS_ARENA + 208 * MiB;
constexpr size_t WS_QX = WS_ARENA;
constexpr size_t WS_P = WS_ARENA + 64 * MiB;
constexpr size_t WS_OC = WS_ARENA + 128 * MiB;
constexpr size_t WS_YS = WS_ARENA;
constexpr size_t WS_XG = WS_ARENA;
constexpr size_t WS_HE = WS_ARENA + 136 * MiB;
constexpr size_t WS_END = 512 * MiB;
static_assert(WS_HE + (size_t)MOE_MAXROWS * 256 * 2 <= WS_END && WS_YACT + (size_t)NTOK * 256 * 2 <= WS_END, "ws map");

constexpr size_t WS_W = 216 * MiB;
constexpr size_t WS_WQN = WS_W + 56 * MiB;
constexpr size_t WS_MT = WS_ARENA, WS_NT = WS_ARENA + 32 * MiB;
constexpr size_t WS_S1X = 10 * MiB + 128 * 1024, WS_S2X = 10 * MiB + 256 * 1024;
static_assert(WS_WQN + 4 * MiB <= WS_ARENA, "wqn");
constexpr size_t WS_WIN_T = WS_W, WS_WOUT_T = WS_W + 9 * MiB, WS_WQ_T = WS_W + 13 * MiB, WS_WKV_T = WS_W + 17 * MiB, WS_WO_T = WS_W + 25 * MiB, WS_WGLU_T = WS_W + 29 * MiB, WS_WLA_T = WS_W + 29 * MiB + 512 * 1024, WS_WLX_T = WS_W + 29 * MiB + 768 * 1024, WS_WGU_T = WS_W + 30 * MiB, WS_WD_T = WS_W + 46 * MiB;
static_assert(WS_WD_T + (size_t)NEXP * D * DEXP * 2 <= WS_ARENA, "weights region");
constexpr int CW_BAR = 4096;

constexpr int LDS_BYTES = 147456;
constexpr int MISC_OFF = 131072 + 320;

#define XB_TMO      128
#define XB_XCNT(j)  (256  + 64 * (j))
#define XB_XSUB(j)  (1280 + 64 * (j))
#define XB_XGEN(j)  (2304 + 64 * (j))
#define XB_TOP      3328
#define XB_TOPGEN   3392
#define XCD_BAR_WORDS 3456
#define XB_SPIN_CAP (1u << 18)

__device__ __forceinline__ unsigned xb_ld(unsigned* p)              { return __hip_atomic_load(p, __ATOMIC_RELAXED, __HIP_MEMORY_SCOPE_AGENT); }
__device__ __forceinline__ unsigned xb_add(unsigned* p, unsigned v) { return __hip_atomic_fetch_add(p, v, __ATOMIC_RELAXED, __HIP_MEMORY_SCOPE_AGENT); }
__device__ __forceinline__ unsigned xb_xcc_id() { return (unsigned)__builtin_amdgcn_s_getreg((3 << 11) | 20) & 0xFu; }
#define XB_SPIN(cond, bar) do { unsigned _sp = 0; while (cond) { __builtin_amdgcn_s_sleep(1); \
    if ((++_sp & 255u) == 0u) { if (xb_ld(&(bar)[XB_TMO])) break; if (_sp > XB_SPIN_CAP) { atomicAdd(&(bar)[XB_TMO], 1u); break; } } } } while (0)

struct XcdBarrier { unsigned* bar; unsigned x; volatile LAS unsigned* st; };

__device__ __forceinline__ XcdBarrier xcd_barrier_post(unsigned* bar, volatile LAS unsigned* st) {
    XcdBarrier b; b.bar = bar; b.x = xb_xcc_id(); b.st = st;
    if (threadIdx.x == 0) (void)xb_add(&bar[XB_XCNT(b.x)], 1u);
    return b;
}
__device__ __forceinline__ void xcd_barrier_complete(unsigned* bar, unsigned x, unsigned& nloc, unsigned& nx) {
    const unsigned G = gridDim.x * gridDim.y * gridDim.z;
    unsigned sum, cnt, mine, sp = 0u;
    for (;;) {
        sum = 0u; cnt = 0u; mine = 0u;
#pragma unroll
        for (unsigned j = 0; j < 16; ++j) { const unsigned c = xb_ld(&bar[XB_XCNT(j)]); sum += c; cnt += (c > 0u) ? 1u : 0u; mine = (j == x) ? c : mine; }
        if (sum == G) break;
        __builtin_amdgcn_s_sleep(1);
        if ((++sp & 255u) == 0u) { if (xb_ld(&bar[XB_TMO])) break; if (sp > XB_SPIN_CAP) { atomicAdd(&bar[XB_TMO], 1u); break; } }
    }
    nloc = mine > 0u ? mine : 1u; nx = cnt > 0u ? cnt : 1u;
}
__device__ __forceinline__ void xcd_barrier(const XcdBarrier& b) {
    asm volatile("s_waitcnt vmcnt(0)" ::: "memory");
    __syncthreads();
    if (threadIdx.x == 0) {
        unsigned* bar = b.bar;
        __builtin_amdgcn_s_waitcnt(0);
        unsigned nloc = b.st[0], nx = b.st[1];
        if (nloc == 0u) { xcd_barrier_complete(bar, b.x, nloc, nx); b.st[0] = nloc; b.st[1] = nx; }
        const unsigned old = xb_add(&bar[XB_XSUB(b.x)], 1u);
        const unsigned gen = old / nloc;
        if (old + 1u == (gen + 1u) * nloc) {
            __builtin_amdgcn_fence(__ATOMIC_RELEASE, "agent");
            asm volatile("s_waitcnt vmcnt(0)" ::: "memory");
            const unsigned og = xb_add(&bar[XB_TOP], 1u);
            const unsigned tg = og / nx;
            if (og + 1u == (tg + 1u) * nx) xb_add(&bar[XB_TOPGEN], 1u);
            else XB_SPIN(xb_ld(&bar[XB_TOPGEN]) == tg, bar);
            __builtin_amdgcn_fence(__ATOMIC_ACQUIRE, "agent");
            xb_add(&bar[XB_XGEN(b.x)], 1u);
            asm volatile("s_waitcnt vmcnt(0)" ::: "memory");
        } else {
            XB_SPIN(xb_ld(&bar[XB_XGEN(b.x)]) == gen, bar);
            __builtin_amdgcn_fence(__ATOMIC_ACQUIRE, "agent");
            asm volatile("s_waitcnt vmcnt(0)" ::: "memory");
        }
    }
    __syncthreads();
}

__device__ __forceinline__ float wave_sum(float v) {
#pragma unroll
    for (int o = 1; o < 64; o <<= 1) v += __shfl_xor(v, o);
    return v;
}
__device__ __forceinline__ float wave_max(float v) {
#pragma unroll
    for (int o = 1; o < 64; o <<= 1) v = fmaxf(v, __shfl_xor(v, o));
    return v;
}
__device__ __forceinline__ float gelu_tanh(float x) {
    const float u = 0.7978845608028654f * (x + 0.044715f * x * x * x);
    return 0.5f * x * (1.0f + tanhf(u));
}
__device__ __forceinline__ float sigmoidf_(float x) { return 1.0f / (1.0f + expf(-x)); }

struct Ctx {
    const float* const* in;
    float* out;
    unsigned char* ws;
    LAS unsigned char* lds;
    int tid, lane, wid, G, bid;
};
template <class T> __device__ __forceinline__ T* wsp(const Ctx& c, size_t off) { return (T*)(c.ws + off); }
__device__ __forceinline__ Ctx fresh(const Ctx& c0) { Ctx c = c0; asm volatile("" : "+v"(c.tid)); c.lane = c.tid & 63; unsigned long long z = 0ull; asm volatile("" : "+s"(z)); c.ws = c.ws + z;
    asm volatile("" : "+s"(c.bid), "+s"(c.G), "+s"(c.wid)); return c; }

__device__ __forceinline__ void row_load16(const f16* row, int lane, float (&v)[16]) {
    const f16x8 a = *(const f16x8*)(row + 8 * lane), b = *(const f16x8*)(row + 512 + 8 * lane);
#pragma unroll
    for (int i = 0; i < 8; ++i) { v[i] = (float)a[i]; v[8 + i] = (float)b[i]; }
}
__device__ __forceinline__ void row_store16(f16* row, int lane, const float (&v)[16]) {
    f16x8 a, b;
#pragma unroll
    for (int i = 0; i < 8; ++i) { a[i] = (f16)v[i]; b[i] = (f16)v[8 + i]; }
    *(f16x8*)(row + 8 * lane) = a; *(f16x8*)(row + 512 + 8 * lane) = b;
}
__device__ __forceinline__ void vec_load16(const float* p, int lane, float (&v)[16]) {
    const f32x4 a0 = *(const f32x4*)(p + 8 * lane), a1 = *(const f32x4*)(p + 8 * lane + 4), b0 = *(const f32x4*)(p + 512 + 8 * lane), b1 = *(const f32x4*)(p + 512 + 8 * lane + 4);
#pragma unroll
    for (int i = 0; i < 4; ++i) { v[i] = a0[i]; v[4 + i] = a1[i]; v[8 + i] = b0[i]; v[12 + i] = b1[i]; }
}
__device__ __forceinline__ void row_load16_nt(const f16* row, int lane, float (&v)[16]) {
    const f16x8 a = __builtin_nontemporal_load((const f16x8*)(row + 8 * lane)), b = __builtin_nontemporal_load((const f16x8*)(row + 512 + 8 * lane));
#pragma unroll
    for (int i = 0; i < 8; ++i) { v[i] = (float)a[i]; v[8 + i] = (float)b[i]; }
}
__device__ __forceinline__ void vec_load16_nt(const float* p, int lane, float (&v)[16]) {
    const f32x4 a0 = __builtin_nontemporal_load((const f32x4*)(p + 8 * lane)), a1 = __builtin_nontemporal_load((const f32x4*)(p + 8 * lane + 4)), b0 = __builtin_nontemporal_load((const f32x4*)(p + 512 + 8 * lane)), b1 = __builtin_nontemporal_load((const f32x4*)(p + 512 + 8 * lane + 4));
#pragma unroll
    for (int i = 0; i < 4; ++i) { v[i] = a0[i]; v[4 + i] = a1[i]; v[8 + i] = b0[i]; v[12 + i] = b1[i]; }
}
__device__ __forceinline__ void ln_row(float (&v)[16], const float* g, const float* b, int lane) {
    float s = 0.f;
#pragma unroll
    for (int i = 0; i < 16; ++i) s += v[i];
    const float mu = wave_sum(s) * (1.0f / 1024.0f);
    float q = 0.f;
#pragma unroll
    for (int i = 0; i < 16; ++i) { v[i] -= mu; q += v[i] * v[i]; }
    const float rstd = 1.0f / sqrtf(wave_sum(q) * (1.0f / 1024.0f) + 1e-5f);
    float gg[16], bb[16]; vec_load16(g, lane, gg); vec_load16(b, lane, bb);
#pragma unroll
    for (int i = 0; i < 16; ++i) v[i] = v[i] * rstd * gg[i] + bb[i];
}

namespace pg8 {
#define PG8_LAS __attribute__((address_space(3)))
typedef _Float16 bf16_t;
typedef _Float16 bf16x8 __attribute__((ext_vector_type(8)));
typedef float f32x4 __attribute__((ext_vector_type(4)));
typedef unsigned u32x4 __attribute__((ext_vector_type(4)));
constexpr int BM = 256, BK = 64, HALF = 128, HTB = HALF * BK * 2  , STAGE_BYTES = 8 * HTB, NXCD = 8, WGM = 8;

__host__ __device__ __forceinline__ int lds_byte(int r, int c) { const int st = (r >> 4) * 2 + (c >> 5), rr = r & 15, cc = c & 31, ob = rr * 64 + cc * 2; return st * 1024 + (ob ^ (((ob >> 9) & 1) << 5)); }
__host__ __device__ __forceinline__ void stage_rc(int b, int& R, int& C) { const int st = b / 1024, sb = b % 1024, swz = sb ^ (((sb >> 9) & 1) << 5); R = (st >> 1) * 16 + swz / 64; C = (st & 1) * 32 + (swz % 64) / 2; }
__host__ __device__ __forceinline__ int perm32(int rho) { const int n = rho >> 4, i = rho & 15; return 8 * (i >> 2) + 4 * n + (i & 3); }

struct Unit { int pm, pn; unsigned aoff, boff; int tag; int nt; };
struct Gemm { const bf16_t* A; const bf16_t* Bt; int K, lda, ldb; const int* arow = nullptr; };

struct StaticOrder {
    int nM, nN, nwg, G, c;
    __host__ __device__ void init(int M, int N, int G_, int c_) { nM = M / BM; nN = N / BM; nwg = nM * nN; G = G_; c = c_; }
    __host__ __device__ bool next(int i, Unit& u) const {
        const long L = (long)i * G + c; if (L >= nwg) return false;
        int wgid = (int)L; { const int q = nwg / NXCD, r = nwg % NXCD, xcd = wgid % NXCD, off = wgid / NXCD; wgid = (xcd < r ? xcd * (q + 1) : r * (q + 1) + (xcd - r) * q) + off; }
        const int nig = WGM * nN, gid = wgid / nig, fm = gid * WGM, gsz = (nM - fm) < WGM ? (nM - fm) : WGM;
        u.pm = fm + ((wgid % nig) % gsz); u.pn = (wgid % nig) / gsz; u.aoff = 0; u.boff = 0; u.tag = 0; u.nt = 0; return true;
    }
    __device__ __forceinline__ void a_ready(const Unit&) const {}
    __device__ __forceinline__ void done(const Unit&) const {}
};
template <class Epi, class Sched, bool ALIGN_EPI = false, bool SP2 = false, bool GATHER = false>
__device__ __forceinline__ void gemm_phase(PG8_LAS unsigned char* lds, const Gemm g, const Sched& S, const Epi& E, const int tid) {
    const int wid = __builtin_amdgcn_readfirstlane(tid >> 6), lane = tid & 63, wr = wid >> 2, wc = wid & 3, fr = lane & 15, fq = lane >> 4;
    const int ntg = g.K / BK; int nt = ntg;
    unsigned voffA[2], voffB[2];
#pragma unroll
    for (int i = 0; i < 2; ++i) { int R, C; stage_rc(tid * 16 + i * 8192, R, C); const int Rb = Epi::PERM ? ((R & ~31) + perm32(R & 31)) : R;
        voffA[i] = (unsigned)(R * g.lda + C) * 2u; voffB[i] = (unsigned)(Rb * g.ldb + C) * 2u; }
    const unsigned kstep = (unsigned)(BK * 2);
    const unsigned hstepA = (unsigned)HALF * g.lda * 2u, hstepB = (unsigned)HALF * g.ldb * 2u;
    static_assert(!GATHER || SP2, "GATHER is written for the SP2 loop only");
    const unsigned tstepA = GATHER ? 0u : 2u * hstepA, tstepB = 2u * hstepB;
    const unsigned ldsw = (unsigned)wid * 1024u;
    const int aoff = lds_byte(wr * 64 + fr, fq * 8), boff = lds_byte(wc * 32 + fr, fq * 8);
#define PG8_SA(b, h) (((b) * 2 + (h)) * HTB)
#define PG8_SB(b, h) ((4 + (b) * 2 + (h)) * HTB)
#define PG8_STAGE(bufoff, gbase, voff) do { _Pragma("unroll") for (int _i = 0; _i < 2; ++_i) \
        __builtin_amdgcn_global_load_lds((const unsigned*)((const char*)(gbase) + (voff)[_i]), (PG8_LAS unsigned*)(lds + (bufoff) + ldsw + _i * 8192), 16, 0, 0); } while (0)
#define PG8_STAGE_A(b, h, gbase, usenext) do { if constexpr (GATHER) { if (usenext) PG8_STAGE(PG8_SA(b, h), gbase, (h) ? nv1 : nv0); else PG8_STAGE(PG8_SA(b, h), gbase, (h) ? vo1 : vo0); } \
        else PG8_STAGE(PG8_SA(b, h), (gbase) + ((h) ? hstepA : 0u), voffA); } while (0)
#define PG8_LOADVO(u, o0, o1) do { _Pragma("unroll") for (int _i = 0; _i < 2; ++_i) { int R_, C_; stage_rc(tid * 16 + _i * 8192, R_, C_); \
        o0[_i] = (unsigned)g.arow[(u).pm * BM + R_] * (unsigned)(g.lda * 2) + (unsigned)C_ * 2u; o1[_i] = (unsigned)g.arow[(u).pm * BM + HALF + R_] * (unsigned)(g.lda * 2) + (unsigned)C_ * 2u; } } while (0)
    unsigned vo0[2] = {0u, 0u}, vo1[2] = {0u, 0u}, nv0[2] = {0u, 0u}, nv1[2] = {0u, 0u};
#define PG8_LDA(dst, b, h) do { _Pragma("unroll") for (int m = 0; m < 4; ++m) _Pragma("unroll") for (int k = 0; k < 2; ++k) dst[m][k] = *(const PG8_LAS bf16x8*)(lds + PG8_SA(b, h) + aoff + m * 2048 + k * 1024); } while (0)
#define PG8_LDB(dst, b, h) do { _Pragma("unroll") for (int n = 0; n < 2; ++n) _Pragma("unroll") for (int k = 0; k < 2; ++k) dst[n][k] = *(const PG8_LAS bf16x8*)(lds + PG8_SB(b, h) + boff + n * 2048 + k * 1024); } while (0)
#define PG8_MMA(ai, bj, At, Bt) do { __builtin_amdgcn_s_setprio(1); _Pragma("unroll") for (int m = 0; m < 4; ++m) _Pragma("unroll") for (int n = 0; n < 2; ++n) _Pragma("unroll") for (int k = 0; k < 2; ++k) \
        acc[ai][bj][m][n] = __builtin_amdgcn_mfma_f32_16x16x32_f16(Bt[n][k], At[m][k], acc[ai][bj][m][n], 0, 0, 0); __builtin_amdgcn_s_setprio(0); } while (0)
#define PG8_WAIT_V(n) asm volatile("s_waitcnt vmcnt(" #n ")" ::: "memory")
#define PG8_WAIT_L(n) asm volatile("s_waitcnt lgkmcnt(" #n ")" ::: "memory")
#define PG8_BAR __builtin_amdgcn_s_barrier()
#define PG8_SCHED __builtin_amdgcn_sched_barrier(0)
    Unit cur, nxt; int ui = 0;
    if (!S.next(0, cur)) return;
    nt = cur.nt ? cur.nt : ntg;
    f32x4 acc[2][2][4][2];
#pragma unroll
    for (int a = 0; a < 2; ++a)
#pragma unroll
        for (int b = 0; b < 2; ++b)
#pragma unroll
            for (int m = 0; m < 4; ++m)
#pragma unroll
                for (int n = 0; n < 2; ++n) acc[a][b][m][n] = (f32x4){0.f, 0.f, 0.f, 0.f};
    bf16x8 At[4][2], B0[2][2], B1[2][2];
    const char* cA = (const char*)g.A + (size_t)cur.pm * tstepA + cur.aoff; const char* cB = (const char*)g.Bt + (size_t)cur.pn * tstepB + cur.boff;
    S.a_ready(cur);
    if constexpr (SP2) {
        if constexpr (GATHER) PG8_LOADVO(cur, vo0, vo1);
        PG8_STAGE(PG8_SB(0, 0), cB, voffB); PG8_STAGE(PG8_SB(0, 1), cB + hstepB, voffB); PG8_STAGE_A(0, 0, cA, false); PG8_STAGE_A(0, 1, cA, false);
        if (wr == 1) PG8_BAR;
        PG8_WAIT_V(2); PG8_BAR;
        PG8_STAGE(PG8_SB(1, 0), cB + kstep, voffB); PG8_STAGE_A(1, 0, cA + kstep, false); PG8_STAGE(PG8_SB(1, 1), cB + hstepB + kstep, voffB);
        PG8_WAIT_V(6); PG8_BAR;
    } else {
        PG8_STAGE(PG8_SB(0, 0), cB, voffB); PG8_STAGE(PG8_SA(0, 0), cA, voffA); PG8_STAGE(PG8_SB(0, 1), cB + hstepB, voffB); PG8_STAGE(PG8_SA(0, 1), cA + hstepA, voffA);
        if (wr == 1) PG8_BAR;
        PG8_WAIT_V(4); PG8_BAR;
        PG8_STAGE(PG8_SB(1, 0), cB + kstep, voffB); PG8_STAGE(PG8_SA(1, 0), cA + kstep, voffA); PG8_STAGE(PG8_SB(1, 1), cB + hstepB + kstep, voffB);
        PG8_WAIT_V(6); PG8_BAR;
    }
    for (;;) {
        const bool has_next = S.next(ui + 1, nxt);
        if constexpr (GATHER) { if (has_next) PG8_LOADVO(nxt, nv0, nv1); else { nv0[0] = vo0[0]; nv0[1] = vo0[1]; nv1[0] = vo1[0]; nv1[1] = vo1[1]; } }
        const char* nA = has_next ? (const char*)g.A + (size_t)nxt.pm * tstepA + nxt.aoff : cA; const char* nB = has_next ? (const char*)g.Bt + (size_t)nxt.pn * tstepB + nxt.boff : cB;
#pragma nounroll
        for (int t = 0; t < nt; t += 2) {
            const bool last = (t == nt - 2);
            const char* a1 = cA + (size_t)(t + 1) * kstep;
            const char* a2 = last ? nA : cA + (size_t)(t + 2) * kstep; const char* b2 = last ? nB : cB + (size_t)(t + 2) * kstep;
            const char* a3 = a2 + kstep; const char* b3 = b2 + kstep;
            if (last && has_next) S.a_ready(nxt);
            if constexpr (SP2) {
            PG8_LDB(B0, 0, 0); PG8_LDB(B1, 0, 1); PG8_SCHED; PG8_LDA(At, 0, 0); PG8_STAGE_A(1, 1, a1, false);
            PG8_WAIT_V(8); PG8_WAIT_L(0); PG8_BAR; PG8_MMA(0, 0, At, B0); PG8_MMA(0, 1, At, B1); PG8_BAR; PG8_SCHED;
            PG8_LDA(At, 0, 1); PG8_STAGE(PG8_SB(0, 0), b2, voffB); PG8_STAGE(PG8_SB(0, 1), b2 + hstepB, voffB); PG8_STAGE_A(0, 0, a2, last);
            PG8_WAIT_V(8); PG8_WAIT_L(0); PG8_BAR; PG8_MMA(1, 0, At, B0); PG8_MMA(1, 1, At, B1); PG8_BAR; PG8_SCHED;
            PG8_LDB(B0, 1, 0); PG8_LDB(B1, 1, 1); PG8_SCHED; PG8_LDA(At, 1, 0); PG8_STAGE_A(0, 1, a2, last);
            PG8_WAIT_V(8); PG8_WAIT_L(0); PG8_BAR; PG8_MMA(0, 0, At, B0); PG8_MMA(0, 1, At, B1); PG8_BAR; PG8_SCHED;
            PG8_LDA(At, 1, 1); PG8_STAGE(PG8_SB(1, 0), b3, voffB); PG8_STAGE(PG8_SB(1, 1), b3 + hstepB, voffB); PG8_STAGE_A(1, 0, a3, last);
            PG8_WAIT_V(8); PG8_WAIT_L(0); PG8_BAR; PG8_MMA(1, 0, At, B0); PG8_MMA(1, 1, At, B1); PG8_BAR; PG8_SCHED;
            } else {
            PG8_LDB(B0, 0, 0); PG8_SCHED; PG8_LDA(At, 0, 0); PG8_STAGE(PG8_SA(1, 1), a1 + hstepA, voffA);
            PG8_WAIT_L(8); PG8_BAR; PG8_WAIT_L(0); PG8_MMA(0, 0, At, B0); PG8_BAR; PG8_SCHED;
            PG8_LDB(B1, 0, 1); PG8_STAGE(PG8_SB(0, 0), b2, voffB);
            PG8_BAR; PG8_WAIT_L(0); PG8_MMA(0, 1, At, B1); PG8_BAR;
            PG8_LDA(At, 0, 1); PG8_STAGE(PG8_SA(0, 0), a2, voffA);
            PG8_BAR; PG8_WAIT_L(0); PG8_MMA(1, 0, At, B0); PG8_BAR; PG8_SCHED;
            PG8_STAGE(PG8_SB(0, 1), b2 + hstepB, voffB);
            PG8_WAIT_V(6); PG8_BAR; PG8_MMA(1, 1, At, B1); PG8_BAR;
            PG8_LDB(B0, 1, 0); PG8_SCHED; PG8_LDA(At, 1, 0); PG8_STAGE(PG8_SA(0, 1), a2 + hstepA, voffA);
            PG8_WAIT_L(8); PG8_BAR; PG8_WAIT_L(0); PG8_MMA(0, 0, At, B0); PG8_BAR; PG8_SCHED;
            PG8_LDB(B1, 1, 1); PG8_STAGE(PG8_SB(1, 0), b3, voffB);
            PG8_BAR; PG8_WAIT_L(0); PG8_MMA(0, 1, At, B1); PG8_BAR;
            PG8_LDA(At, 1, 1); PG8_STAGE(PG8_SA(1, 0), a3, voffA);
            PG8_BAR; PG8_WAIT_L(0); PG8_MMA(1, 0, At, B0); PG8_BAR; PG8_SCHED;
            PG8_STAGE(PG8_SB(1, 1), b3 + hstepB, voffB);
            PG8_WAIT_V(6); PG8_BAR; PG8_MMA(1, 1, At, B1); PG8_BAR;
            }
        }
        if constexpr (ALIGN_EPI) { if (wr == 0) PG8_BAR; }
        if constexpr (!Epi::AFTER_DRAIN) { E(acc, cur, wr, wc, fr, fq); S.done(cur); }
        if (!has_next) break;
#pragma unroll
        for (int a = 0; a < 2; ++a)
#pragma unroll
            for (int b = 0; b < 2; ++b)
#pragma unroll
                for (int m = 0; m < 4; ++m)
#pragma unroll
                    for (int n = 0; n < 2; ++n) acc[a][b][m][n] = (f32x4){0.f, 0.f, 0.f, 0.f};
        cur = nxt; cA = nA; cB = nB; ++ui; nt = cur.nt ? cur.nt : ntg;
        if constexpr (GATHER) { vo0[0] = nv0[0]; vo0[1] = nv0[1]; vo1[0] = nv1[0]; vo1[1] = nv1[1]; }
        if constexpr (ALIGN_EPI) { if (wr == 1) PG8_BAR; }
    }
    PG8_WAIT_V(0);
    if constexpr (!ALIGN_EPI) { if (wr == 0) PG8_BAR; }
    PG8_BAR;
    if constexpr (Epi::AFTER_DRAIN) { E.fused(acc, cur, wr, wc, fr, fq, lds, wid, lane); S.done(cur); }
#undef PG8_SA
#undef PG8_SB
#undef PG8_STAGE
#undef PG8_STAGE_A
#undef PG8_LOADVO
#undef PG8_LDA
#undef PG8_LDB
#undef PG8_MMA
#undef PG8_WAIT_V
#undef PG8_WAIT_L
#undef PG8_BAR
#undef PG8_SCHED
}
}
namespace pg8 {
#define PG8_EPI_ROWS(...) \
    _Pragma("unroll") for (int ai = 0; ai < 2; ++ai) _Pragma("unroll") for (int m = 0; m < 4; ++m) { const int rt = ai * HALF + wr * 64 + m * 16 + fr; __VA_ARGS__ }
__device__ __forceinline__ bf16x8 pack8(const f32x4 a, const f32x4 b) { bf16x8 o; o[0] = (bf16_t)a[0]; o[1] = (bf16_t)a[1]; o[2] = (bf16_t)a[2]; o[3] = (bf16_t)a[3]; o[4] = (bf16_t)b[0]; o[5] = (bf16_t)b[1]; o[6] = (bf16_t)b[2]; o[7] = (bf16_t)b[3]; return o; }
struct EStore { static constexpr bool PERM = true, AFTER_DRAIN = false; bf16_t* C; int ldc;
    __device__ __forceinline__ void operator()(const f32x4 (&acc)[2][2][4][2], const Unit& u, int wr, int wc, int fr, int fq) const {
        PG8_EPI_ROWS( bf16_t* rp = C + (size_t)(u.pm * BM + rt) * ldc + u.pn * BM + wc * 32 + 8 * fq;
            _Pragma("unroll") for (int bj = 0; bj < 2; ++bj) *(bf16x8*)(rp + bj * HALF) = pack8(acc[ai][bj][m][0], acc[ai][bj][m][1]); ) } };
struct EStoreKV { static constexpr bool PERM = true, AFTER_DRAIN = false; bf16_t* KM; bf16_t* VM;
    __device__ __forceinline__ void operator()(const f32x4 (&acc)[2][2][4][2], const Unit& u, int wr, int wc, int fr, int fq) const {
        const int mat = u.pn >> 2, j = u.pn & 3; bf16_t* C = KM + (size_t)(mat & 1) * ((WS_VM - WS_KM) / 2) + (size_t)(mat >> 1) * NMEM * D;
        PG8_EPI_ROWS( bf16_t* rp = C + (size_t)(u.pm * BM + rt) * D + j * BM + wc * 32 + 8 * fq;
            _Pragma("unroll") for (int bj = 0; bj < 2; ++bj) *(bf16x8*)(rp + bj * HALF) = pack8(acc[ai][bj][m][0], acc[ai][bj][m][1]); ) } };
struct EResid { static constexpr bool PERM = true, AFTER_DRAIN = false; bf16_t* H;
    __device__ __forceinline__ void operator()(const f32x4 (&acc)[2][2][4][2], const Unit& u, int wr, int wc, int fr, int fq) const {
        PG8_EPI_ROWS( bf16_t* rp = H + (size_t)(u.pm * BM + rt) * D + u.pn * BM + wc * 32 + 8 * fq;
            _Pragma("unroll") for (int bj = 0; bj < 2; ++bj) { const bf16x8 h = *(const bf16x8*)(rp + bj * HALF); f32x4 a = acc[ai][bj][m][0], b = acc[ai][bj][m][1];
                _Pragma("unroll") for (int e = 0; e < 4; ++e) { a[e] += ALPHA * (float)h[e]; b[e] += ALPHA * (float)h[4 + e]; }
                *(bf16x8*)(rp + bj * HALF) = pack8(a, b); } ) } };
struct EResidStats { static constexpr bool PERM = true, AFTER_DRAIN = false; bf16_t* H; float* ST; PG8_LAS float* X;
    __device__ __forceinline__ void operator()(f32x4 (&acc)[2][2][4][2], const Unit& u, int wr, int wc, int fr_, int fq) const {
        int fr = fr_; asm volatile("" : "+v"(fr));
        bf16x8 hv[2][4][2];
        PG8_EPI_ROWS( const bf16_t* rp = H + (size_t)(u.pm * BM + rt) * D + u.pn * BM + wc * 32 + 8 * fq;
            _Pragma("unroll") for (int bj = 0; bj < 2; ++bj) hv[ai][m][bj] = *(const bf16x8*)(rp + bj * HALF); )
        PG8_EPI_ROWS( bf16_t* rp = H + (size_t)(u.pm * BM + rt) * D + u.pn * BM + wc * 32 + 8 * fq; float sm = 0.f, sq = 0.f;
            _Pragma("unroll") for (int bj = 0; bj < 2; ++bj) { const bf16x8 h = hv[ai][m][bj]; f32x4 a = acc[ai][bj][m][0], b = acc[ai][bj][m][1];
                _Pragma("unroll") for (int e = 0; e < 4; ++e) { a[e] += ALPHA * (float)h[e]; b[e] += ALPHA * (float)h[4 + e]; sm += a[e] + b[e]; sq += a[e] * a[e] + b[e] * b[e]; }
                *(bf16x8*)(rp + bj * HALF) = pack8(a, b); }
            sm += __shfl_xor(sm, 16); sm += __shfl_xor(sm, 32); sq += __shfl_xor(sq, 16); sq += __shfl_xor(sq, 32);
            if (fq == 0) { X[(rt * 4 + wc) * 2] = sm; X[(rt * 4 + wc) * 2 + 1] = sq; } )
        asm volatile("s_waitcnt lgkmcnt(0)\n\ts_barrier" ::: "memory");
        { const int t = wr * 0 + (int)(threadIdx.x);
          if (t < 256) { const f32x4 p0 = *(const PG8_LAS f32x4*)(X + t * 8), p1 = *(const PG8_LAS f32x4*)(X + t * 8 + 4);
              float* o = ST + ((size_t)(u.pm * BM + t) * 4 + u.pn) * 2; o[0] = (p0[0] + p0[2]) + (p1[0] + p1[2]); o[1] = (p0[1] + p0[3]) + (p1[1] + p1[3]); } }
    } };
__device__ __forceinline__ void ln_stats4(const float* ST, size_t row, float& mu, float& rstd) {
    const f32x4 p0 = *(const f32x4*)(ST + row * 8), p1 = *(const f32x4*)(ST + row * 8 + 4);
    const float S = (p0[0] + p0[2]) + (p1[0] + p1[2]), Q = (p0[1] + p0[3]) + (p1[1] + p1[3]); mu = S * (1.0f / 1024.0f);
    const float var = fmaxf(Q * (1.0f / 1024.0f) - mu * mu, 0.f); rstd = 1.0f / sqrtf(var + 1e-5f); }
struct EStoreLN { static constexpr bool PERM = true, AFTER_DRAIN = false; bf16_t* C; int ldc; const float* ST; const float* s1; const float* s2;
    __device__ __forceinline__ void operator()(const f32x4 (&acc)[2][2][4][2], const Unit& u, int wr, int wc, int fr, int fq) const {
        const int c0 = u.pn * BM + wc * 32 + 8 * fq;
        f32x4 s1v[2][2], s2v[2][2]; float rsv[2][4], mrv[2][4];
        _Pragma("unroll") for (int bj = 0; bj < 2; ++bj) { const int col = c0 + bj * HALF; s1v[bj][0] = *(const f32x4*)(s1 + col); s1v[bj][1] = *(const f32x4*)(s1 + col + 4); s2v[bj][0] = *(const f32x4*)(s2 + col); s2v[bj][1] = *(const f32x4*)(s2 + col + 4); }
        PG8_EPI_ROWS( const size_t row = (size_t)(u.pm * BM + rt); float mu, rs; ln_stats4(ST, row, mu, rs); rsv[ai][m] = rs; mrv[ai][m] = -mu * rs; )
        PG8_EPI_ROWS( const size_t row = (size_t)(u.pm * BM + rt); const float rs = rsv[ai][m], mr = mrv[ai][m];
            _Pragma("unroll") for (int bj = 0; bj < 2; ++bj) { const int col = c0 + bj * HALF;
                f32x4 a = acc[ai][bj][m][0], b = acc[ai][bj][m][1];
                _Pragma("unroll") for (int e = 0; e < 4; ++e) { a[e] = rs * a[e] + (mr * s1v[bj][0][e] + s2v[bj][0][e]); b[e] = rs * b[e] + (mr * s1v[bj][1][e] + s2v[bj][1][e]); }
                *(bf16x8*)(C + row * ldc + col) = pack8(a, b); } ) } };
struct EResidLN { static constexpr bool PERM = true, AFTER_DRAIN = false; bf16_t* H; const float* ST; const float* g; const float* b;
    __device__ __forceinline__ void operator()(const f32x4 (&acc)[2][2][4][2], const Unit& u, int wr, int wc, int fr, int fq) const {
        const int c0 = u.pn * BM + wc * 32 + 8 * fq;
        float muv[2][4], rsv[2][4];
        PG8_EPI_ROWS( const size_t row = (size_t)(u.pm * BM + rt); float mu, rs; ln_stats4(ST, row, mu, rs); muv[ai][m] = mu; rsv[ai][m] = rs * ALPHA; )
        _Pragma("unroll") for (int bj = 0; bj < 2; ++bj) { const int col = c0 + bj * HALF; bf16x8 hv[2][4];
            const f32x4 g0 = *(const f32x4*)(g + col), g1 = *(const f32x4*)(g + col + 4), b0 = *(const f32x4*)(b + col), b1 = *(const f32x4*)(b + col + 4);
            PG8_EPI_ROWS( hv[ai][m] = *(const bf16x8*)(H + (size_t)(u.pm * BM + rt) * D + col); )
            PG8_EPI_ROWS( const float mu = muv[ai][m], rs = rsv[ai][m]; const bf16x8 h = hv[ai][m]; f32x4 a = acc[ai][bj][m][0], bq = acc[ai][bj][m][1];
                _Pragma("unroll") for (int e = 0; e < 4; ++e) { a[e] += ((float)h[e] - mu) * rs * g0[e] + ALPHA * b0[e]; bq[e] += ((float)h[4 + e] - mu) * rs * g1[e] + ALPHA * b1[e]; }
                *(bf16x8*)(H + (size_t)(u.pm * BM + rt) * D + col) = pack8(a, bq); ) } } };
struct EGlu { static constexpr bool PERM = true, AFTER_DRAIN = false; const bf16_t* yact; const float* bg; bf16_t* Y; PG8_LAS float* X;
    __device__ __forceinline__ void operator()(f32x4 (&acc)[2][2][4][2], const Unit& u, int wr, int wc, int fr_, int fq) const {
        int fr = fr_; asm volatile("" : "+v"(fr));
        bf16x8 yv[2][4][2]; f32x4 bv[2][2];
        _Pragma("unroll") for (int bj = 0; bj < 2; ++bj) { const int col = bj * HALF + wc * 32 + 8 * fq; bv[bj][0] = *(const f32x4*)(bg + col); bv[bj][1] = *(const f32x4*)(bg + col + 4); }
        PG8_EPI_ROWS( const size_t row = (size_t)(u.pm * BM + rt);
            _Pragma("unroll") for (int bj = 0; bj < 2; ++bj) yv[ai][m][bj] = *(const bf16x8*)(yact + row * 256 + bj * HALF + wc * 32 + 8 * fq); )
        PG8_EPI_ROWS( float ss = 0.f;
            _Pragma("unroll") for (int bj = 0; bj < 2; ++bj) { const bf16x8 y = yv[ai][m][bj];
                f32x4 a = acc[ai][bj][m][0] + bv[bj][0], b = acc[ai][bj][m][1] + bv[bj][1];
                _Pragma("unroll") for (int e = 0; e < 4; ++e) { a[e] = (float)y[e] * __builtin_amdgcn_rcpf(1.0f + __expf(-a[e])); b[e] = (float)y[4 + e] * __builtin_amdgcn_rcpf(1.0f + __expf(-b[e])); ss += a[e] * a[e] + b[e] * b[e]; }
                acc[ai][bj][m][0] = a; acc[ai][bj][m][1] = b; }
            ss += __shfl_xor(ss, 16); ss += __shfl_xor(ss, 32); if (fq == 0) X[rt * 4 + wc] = ss; )
        asm volatile("s_waitcnt lgkmcnt(0)\n\ts_barrier" ::: "memory");
        PG8_EPI_ROWS( const size_t row = (size_t)(u.pm * BM + rt); const f32x4 sv = *(const PG8_LAS f32x4*)(X + rt * 4);
            const float rs = 1.0f / sqrtf(((sv[0] + sv[1]) + (sv[2] + sv[3])) * (1.0f / 256.0f) + 1e-6f);
            _Pragma("unroll") for (int bj = 0; bj < 2; ++bj) *(bf16x8*)(Y + row * D + 512 + bj * HALF + wc * 32 + 8 * fq) = pack8(acc[ai][bj][m][0] * rs, acc[ai][bj][m][1] * rs); ) } };
struct ESiluMul { static constexpr bool PERM = true, AFTER_DRAIN = false; bf16_t* HE;
    __device__ __forceinline__ void operator()(const f32x4 (&acc)[2][2][4][2], const Unit& u, int wr, int wc, int fr, int fq) const {
        const int jb = u.pn & 1;
        PG8_EPI_ROWS( f32x4 a = acc[ai][0][m][0], b = acc[ai][0][m][1]; const f32x4 ua = acc[ai][1][m][0], ub = acc[ai][1][m][1];
            _Pragma("unroll") for (int e = 0; e < 4; ++e) { a[e] = a[e] * __builtin_amdgcn_rcpf(1.0f + __expf(-a[e])) * ua[e]; b[e] = b[e] * __builtin_amdgcn_rcpf(1.0f + __expf(-b[e])) * ub[e]; }
            *(bf16x8*)(HE + (size_t)(u.pm * BM + rt) * DEXP + jb * HALF + wc * 32 + 8 * fq) = pack8(a, b); ) } };
struct EScatter { static constexpr bool PERM = true, AFTER_DRAIN = false; const int* rowtok; const float* roww; bf16_t* YS;
    __device__ __forceinline__ void operator()(const f32x4 (&acc)[2][2][4][2], const Unit& u, int wr, int wc, int fr, int fq) const {
        const int j = u.pn & 3; int rv[2][4]; float wv[2][4];
        PG8_EPI_ROWS( const int lr = u.pm * BM + rt; rv[ai][m] = rowtok[lr]; wv[ai][m] = roww[lr]; )
        PG8_EPI_ROWS( const int r = rv[ai][m]; const float w = wv[ai][m];
            if (r >= 0) { bf16_t* rp = YS + (size_t)r * D + j * BM + wc * 32 + 8 * fq;
                _Pragma("unroll") for (int bj = 0; bj < 2; ++bj) *(bf16x8*)(rp + bj * HALF) = pack8(acc[ai][bj][m][0] * w, acc[ai][bj][m][1] * w); } ) } };
struct MoeOrder { const int* tx; int NJ, G, c, nwg;
    __device__ __forceinline__ void init(const int* tx_, int NJ_, int G_, int c_) { tx = tx_; NJ = NJ_; G = G_; c = c_; nwg = __builtin_amdgcn_readfirstlane(tx_[0]) * NJ_; }
    __device__ __forceinline__ bool next(int i, Unit& u) const {
        const long L = (long)i * G + c; if (L >= nwg) return false;
        int wgid = (int)L; { const int q = nwg / NXCD, r = nwg % NXCD, xcd = wgid % NXCD, off = wgid / NXCD; wgid = (xcd < r ? xcd * (q + 1) : r * (q + 1) + (xcd - r) * q) + off; }
        u.pm = wgid / NJ; u.pn = __builtin_amdgcn_readfirstlane(tx[1 + u.pm]) * NJ + (wgid % NJ); u.aoff = 0; u.boff = 0; u.tag = 0; u.nt = 0; return true; }
    __device__ __forceinline__ void a_ready(const Unit&) const {}
    __device__ __forceinline__ void done(const Unit&) const {}
};
struct EStoreWin { static constexpr bool PERM = true, AFTER_DRAIN = false; bf16_t* Z; bf16_t* UG;
    __device__ __forceinline__ void operator()(const f32x4 (&acc)[2][2][4][2], const Unit& u, int wr, int wc, int fr, int fq) const {
        if (u.pn != 6) {
            PG8_EPI_ROWS( bf16_t* rp = Z + (size_t)(u.pm * BM + rt) * DIN + u.pn * BM + wc * 32 + 8 * fq;
                _Pragma("unroll") for (int bj = 0; bj < 2; ++bj) *(bf16x8*)(rp + bj * HALF) = pack8(acc[ai][bj][m][0], acc[ai][bj][m][1]); )
        } else {
            PG8_EPI_ROWS( const int n = u.pm * BM + rt; const size_t R = (size_t)(n >> 11) * 64 + ((n & 2047) >> 5); const int s = n & 31;
                _Pragma("unroll") for (int bj = 0; bj < 2; ++bj) { const int col = bj * HALF + wc * 32 + 8 * fq;
                    *(bf16x8*)(UG + ((size_t)(col >> 4) * 1024 + R) * 640 + s * 16 + (col & 15)) = pack8(acc[ai][bj][m][0], acc[ai][bj][m][1]); } )
        } } };
struct ES5 { static constexpr bool PERM = true, AFTER_DRAIN = false; const bf16_t* UG; bf16_t* YA; const float* dsk; const float* logdt;
    __device__ __forceinline__ void operator()(const f32x4 (&acc)[2][2][4][2], const Unit& u, int wr, int wc, int fr, int fq) const {
        const int g = u.tag; const float sg = __expf(logdt[g]);
        const int h0 = (8 * fq) & 15; const f32x4 d0 = *(const f32x4*)(dsk + g * 16 + h0), d1 = *(const f32x4*)(dsk + g * 16 + h0 + 4);
        bf16x8 uvv[2][4][2];
        PG8_EPI_ROWS( const int Rg = (u.pm & 3) * BM + rt;
            _Pragma("unroll") for (int bj = 0; bj < 2; ++bj) { const int col = (u.pn & 1) * BM + bj * HALF + wc * 32 + 8 * fq; uvv[ai][m][bj] = *(const bf16x8*)(UG + ((size_t)g * 1024 + Rg) * 640 + col); } )
        PG8_EPI_ROWS( const int Rg = (u.pm & 3) * BM + rt; const size_t tok0 = (size_t)(Rg >> 6) * SEQ + (Rg & 63) * 32;
            _Pragma("unroll") for (int bj = 0; bj < 2; ++bj) { const int col = (u.pn & 1) * BM + bj * HALF + wc * 32 + 8 * fq, t = col >> 4;
                const bf16x8 uv = uvv[ai][m][bj];
                f32x4 a = acc[ai][bj][m][0], b = acc[ai][bj][m][1];
                _Pragma("unroll") for (int e = 0; e < 4; ++e) { float x = sg * a[e] + d0[e] * (float)uv[e]; a[e] = x * __builtin_amdgcn_rcpf(1.0f + __expf(-1.5957691216f * (x + 0.044715f * x * x * x)));
                    x = sg * b[e] + d1[e] * (float)uv[4 + e]; b[e] = x * __builtin_amdgcn_rcpf(1.0f + __expf(-1.5957691216f * (x + 0.044715f * x * x * x))); }
                *(bf16x8*)(YA + (tok0 + t) * 256 + g * 16 + h0) = pack8(a, b); } ) } };
struct S5Order { int G, c;
    __device__ __forceinline__ bool next(int i, Unit& u) const {
        const int L = i * G + c; if (L >= 128) return false; const int g = L >> 3;
        u.pm = g * 4 + ((L >> 1) & 3); u.pn = g * 2 + (L & 1); u.aoff = 0; u.boff = 0; u.tag = g; u.nt = 0; return true; }
    __device__ __forceinline__ void a_ready(const Unit&) const {}
    __device__ __forceinline__ void done(const Unit&) const {}
};
__device__ __forceinline__ int xcd_remap(int wgid, int nwg) { const int q = nwg / NXCD, r = nwg % NXCD, xcd = wgid % NXCD, off = wgid / NXCD; return (xcd < r ? xcd * (q + 1) : r * (q + 1) + (xcd - r) * q) + off; }
struct KvOrder { int G, c;
    __device__ __forceinline__ bool next(int i, Unit& u) const {
        const int L = i * G + c; if (L >= 256) return false;
        const int l = L >> 7, isv = (L >> 6) & 1, r = L & 63; u.tag = l * 2 + isv; u.nt = 0;
        if (!isv) { u.pm = r >> 2; u.pn = r & 3; u.aoff = (unsigned)WS_MEM16; u.boff = (unsigned)(WS_WKV_T + (size_t)(2 * l) * D * D * 2); }
        else      { u.pm = r & 3; u.pn = r >> 2; u.aoff = (unsigned)(WS_WKV_T + (size_t)(2 * l + 1) * D * D * 2); u.boff = (unsigned)WS_MEM16; }
        return true; }
    __device__ __forceinline__ void a_ready(const Unit&) const {}
    __device__ __forceinline__ void done(const Unit&) const {}
};
struct EStoreKV2 { static constexpr bool PERM = true, AFTER_DRAIN = false; bf16_t* KM; bf16_t* VT;
    __device__ __forceinline__ void operator()(const f32x4 (&acc)[2][2][4][2], const Unit& u, int wr, int wc, int fr, int fq) const {
        const int l = u.tag >> 1, isv = u.tag & 1;
        bf16_t* C = KM + (size_t)isv * ((WS_VM - WS_KM) / 2) + (size_t)l * NMEM * D;
        PG8_EPI_ROWS( bf16_t* rp = C + (size_t)(u.pm * BM + rt) * D + u.pn * BM + wc * 32 + 8 * fq;
            _Pragma("unroll") for (int bj = 0; bj < 2; ++bj) *(bf16x8*)(rp + bj * HALF) = pack8(acc[ai][bj][m][0], acc[ai][bj][m][1]); ) } };
struct XsOrder { int G, c;
    __device__ __forceinline__ bool next(int i, Unit& u) const {
        const int L = i * G + c; if (L >= 512) return false; const int w = xcd_remap(L, 512);
        u.pm = w >> 2; u.tag = w & 3; u.pn = u.pm >> 3; u.aoff = u.tag * 512; u.boff = u.tag * 512; u.nt = 0; return true; }
    __device__ __forceinline__ void a_ready(const Unit&) const {}
    __device__ __forceinline__ void done(const Unit&) const {}
};
struct XoOrder { int G, c;
    __device__ __forceinline__ bool next(int i, Unit& u) const {
        const int L = i * G + c; if (L >= 512) return false; const int w = xcd_remap(L, 512);
        u.pm = w >> 2; u.tag = w & 3; u.pn = u.tag; u.aoff = u.tag * 512; u.boff = (u.pm >> 3) * 512; u.nt = 0; return true; }
    __device__ __forceinline__ void a_ready(const Unit&) const {}
    __device__ __forceinline__ void done(const Unit&) const {}
};
struct ESoftmaxP { static constexpr bool PERM = true, AFTER_DRAIN = false; bf16_t* P; PG8_LAS float* X;
    __device__ __forceinline__ void operator()(f32x4 (&acc)[2][2][4][2], const Unit& u, int wr, int wc, int fr_, int fq) const {
        int fr = fr_; asm volatile("" : "+v"(fr));
        PG8_EPI_ROWS( float v = -3.0e38f;
            _Pragma("unroll") for (int bj = 0; bj < 2; ++bj) _Pragma("unroll") for (int n = 0; n < 2; ++n) _Pragma("unroll") for (int e = 0; e < 4; ++e) v = fmaxf(v, acc[ai][bj][m][n][e]);
            v = fmaxf(v, __shfl_xor(v, 16)); v = fmaxf(v, __shfl_xor(v, 32)); if (fq == 0) X[rt * 4 + wc] = v; )
        asm volatile("s_waitcnt lgkmcnt(0)\n\ts_barrier" ::: "memory");
        PG8_EPI_ROWS( const f32x4 mv = *(const PG8_LAS f32x4*)(X + rt * 4); const float mx = fmaxf(fmaxf(mv[0], mv[1]), fmaxf(mv[2], mv[3])); float sm = 0.f;
            _Pragma("unroll") for (int bj = 0; bj < 2; ++bj) _Pragma("unroll") for (int n = 0; n < 2; ++n) _Pragma("unroll") for (int e = 0; e < 4; ++e) { const float p = __builtin_amdgcn_exp2f(acc[ai][bj][m][n][e] - mx); acc[ai][bj][m][n][e] = p; sm += p; }
            sm += __shfl_xor(sm, 16); sm += __shfl_xor(sm, 32); if (fq == 0) X[1024 + rt * 4 + wc] = sm; )
        asm volatile("s_waitcnt lgkmcnt(0)\n\ts_barrier" ::: "memory");
        PG8_EPI_ROWS( const f32x4 sv = *(const PG8_LAS f32x4*)(X + 1024 + rt * 4); const float inv = 1.0f / ((sv[0] + sv[1]) + (sv[2] + sv[3]));
            bf16_t* rp = P + (size_t)(u.pm * BM + rt) * D + u.tag * BM + wc * 32 + 8 * fq;
            _Pragma("unroll") for (int bj = 0; bj < 2; ++bj) *(bf16x8*)(rp + bj * HALF) = pack8(acc[ai][bj][m][0] * inv, acc[ai][bj][m][1] * inv); )
    } };
struct ChainOrder { int G, c, l;
    __device__ __forceinline__ bool next(int i, Unit& u) const {
        if (i >= 4 || c >= 256) return false;
        const int v = (G % 8 == 0) ? (c % 8) * (G / 8) + c / 8 : c, tr = 2 * v + (i & 1), ty = 1 + (i >> 1), hh = tr & 3; u.pm = tr >> 2; const int b = u.pm >> 3; u.tag = ty | (hh << 2); u.nt = 4;
        if (ty == 1) { u.pn = b; u.aoff = (unsigned)(WS_QX + hh * 512); u.boff = (unsigned)(WS_KM + (size_t)l * NMEM * D * 2 + hh * 512); }
        else         { u.pn = hh; u.aoff = (unsigned)(WS_P + hh * 512); u.boff = (unsigned)(WS_VM + (size_t)l * NMEM * D * 2 + ((size_t)(b >> 2) * D * D + (b & 3) * 256) * 2); }
        return true; }
    __device__ __forceinline__ void a_ready(const Unit&) const {}
    __device__ __forceinline__ void done(const Unit&) const {}
};
struct EChain { static constexpr bool PERM = true, AFTER_DRAIN = false; ESoftmaxP e1; EStore e2;
    __device__ __forceinline__ void operator()(f32x4 (&acc)[2][2][4][2], const Unit& u, int wr, int wc, int fr, int fq) const {
        const int ty = u.tag & 3; Unit v = u; v.tag = u.tag >> 2;
        if (ty == 1) e1(acc, v, wr, wc, fr, fq); else e2(acc, v, wr, wc, fr, fq); } };
struct WinKvOrder { StaticOrder so; int lay;
    __device__ __forceinline__ bool next(int i, Unit& u) const {
        if (so.next(i, u)) { u.aoff = (unsigned)WS_H; u.boff = (unsigned)(WS_WIN_T + (size_t)lay * DIN * D * 2); u.tag = 0; return true; }
        const int L = i * so.G + so.c - so.nwg; if (L < 0 || L >= 128) return false;
        const int isv = L >> 6, r = L & 63, l = lay; u.tag = 1 | ((l * 2 + isv) << 1); u.nt = 0;
        if (!isv) { u.pm = r >> 2; u.pn = r & 3; u.aoff = (unsigned)WS_MEM16; u.boff = (unsigned)(WS_WKV_T + (size_t)(2 * l) * D * D * 2); }
        else      { u.pm = r >> 2; u.pn = r & 3; u.aoff = (unsigned)WS_MEM16; u.boff = (unsigned)(WS_WKV_T + (size_t)(2 * l + 1) * D * D * 2); }
        return true; }
    __device__ __forceinline__ void a_ready(const Unit&) const {}
    __device__ __forceinline__ void done(const Unit&) const {}
};
struct EWinKv { static constexpr bool PERM = true, AFTER_DRAIN = false; EStoreWin e0; EStoreKV2 e1;
    __device__ __forceinline__ void operator()(const f32x4 (&acc)[2][2][4][2], const Unit& u, int wr, int wc, int fr, int fq) const {
        if ((u.tag & 1) == 0) e0(acc, u, wr, wc, fr, fq); else { Unit v = u; v.tag = u.tag >> 1; e1(acc, v, wr, wc, fr, fq); } } };
struct PreOrder { int G, c, l;
    __device__ __forceinline__ bool next(int i, Unit& u) const {
        int L;
        if (G == 256) { if (c < 128) { if (i > 0) return false; L = c; } else { if (i >= 3) return false; L = 128 + (c - 128) * 3 + i; } }
        else { L = i * G + c; if (L >= 512) return false; }
        const int kind = L >> 8, r = L & 255, b = r >> 4, hh = (r >> 2) & 3, q = r & 3; u.nt = 4; u.tag = kind | (b << 1) | (hh << 5);
        if (!kind) { u.pm = b; u.pn = q; u.aoff = (unsigned)(WS_KM + (size_t)l * NMEM * D * 2 + hh * 512); u.boff = (unsigned)(WS_WQN + (size_t)l * D * D * 2 + hh * 512); }
        else       { u.pm = q; u.pn = b; u.aoff = (unsigned)(WS_WO_T + (size_t)l * D * D * 2 + hh * 512); u.boff = (unsigned)(WS_VM + (size_t)l * NMEM * D * 2 + hh * 512); }
        return true; }
    __device__ __forceinline__ void a_ready(const Unit&) const {}
    __device__ __forceinline__ void done(const Unit&) const {}
};
struct EStorePre { static constexpr bool PERM = true, AFTER_DRAIN = false; bf16_t* MT;
    __device__ __forceinline__ void operator()(const f32x4 (&acc)[2][2][4][2], const Unit& u, int wr, int wc, int fr, int fq) const {
        const int kind = u.tag & 1, b = (u.tag >> 1) & 15, hh = u.tag >> 5;
        bf16_t* C = MT + ((size_t)kind * 16 + b) * D * D; const int rowbase = kind ? u.pm * BM : hh * BM, col0 = (kind ? hh * BM : u.pn * BM) + wc * 32 + 8 * fq;
        PG8_EPI_ROWS( bf16_t* rp = C + (size_t)(rowbase + rt) * D + col0;
            _Pragma("unroll") for (int bj = 0; bj < 2; ++bj) *(bf16x8*)(rp + bj * HALF) = pack8(acc[ai][bj][m][0], acc[ai][bj][m][1]); ) } };
struct BatchBOrder { StaticOrder so; unsigned bbase;
    __device__ __forceinline__ bool next(int i, Unit& u) const { if (!so.next(i, u)) return false; u.boff = bbase + (unsigned)(u.pm >> 3) * (unsigned)(D * D * 2); return true; }
    __device__ __forceinline__ void a_ready(const Unit&) const {}
    __device__ __forceinline__ void done(const Unit&) const {}
};
struct ESoftmaxLN { static constexpr bool PERM = true, AFTER_DRAIN = false; bf16_t* P; PG8_LAS float* X; const float* ST; const float* s1x; const float* s2x;
    __device__ __forceinline__ void operator()(f32x4 (&acc)[2][2][4][2], const Unit& u, int wr, int wc, int fr_, int fq) const {
        int fr = fr_; asm volatile("" : "+v"(fr));
        { const int c0 = (u.pm >> 3) * D + u.pn * BM + wc * 32 + 8 * fq;
          f32x4 s1v[2][2], s2v[2][2]; float rsv[2][4], mrv[2][4];
          _Pragma("unroll") for (int bj = 0; bj < 2; ++bj) { const int col = c0 + bj * HALF; s1v[bj][0] = *(const f32x4*)(s1x + col); s1v[bj][1] = *(const f32x4*)(s1x + col + 4); s2v[bj][0] = *(const f32x4*)(s2x + col); s2v[bj][1] = *(const f32x4*)(s2x + col + 4); }
          PG8_EPI_ROWS( const size_t row = (size_t)(u.pm * BM + rt); float mu, rs; ln_stats4(ST, row, mu, rs); rsv[ai][m] = rs; mrv[ai][m] = -mu * rs; )
          PG8_EPI_ROWS( const float rs = rsv[ai][m], mr = mrv[ai][m];
              _Pragma("unroll") for (int bj = 0; bj < 2; ++bj) _Pragma("unroll") for (int n = 0; n < 2; ++n) _Pragma("unroll") for (int e = 0; e < 4; ++e) acc[ai][bj][m][n][e] = rs * acc[ai][bj][m][n][e] + (mr * s1v[bj][n][e] + s2v[bj][n][e]); ) }
        PG8_EPI_ROWS( float v = -3.0e38f;
            _Pragma("unroll") for (int bj = 0; bj < 2; ++bj) _Pragma("unroll") for (int n = 0; n < 2; ++n) _Pragma("unroll") for (int e = 0; e < 4; ++e) v = fmaxf(v, acc[ai][bj][m][n][e]);
            v = fmaxf(v, __shfl_xor(v, 16)); v = fmaxf(v, __shfl_xor(v, 32)); if (fq == 0) X[rt * 4 + wc] = v; )
        asm volatile("s_waitcnt lgkmcnt(0)\n\ts_barrier" ::: "memory");
        PG8_EPI_ROWS( const f32x4 mv = *(const PG8_LAS f32x4*)(X + rt * 4); const float mx = fmaxf(fmaxf(mv[0], mv[1]), fmaxf(mv[2], mv[3])); float sm = 0.f;
            _Pragma("unroll") for (int bj = 0; bj < 2; ++bj) _Pragma("unroll") for (int n = 0; n < 2; ++n) _Pragma("unroll") for (int e = 0; e < 4; ++e) { const float p = __builtin_amdgcn_exp2f(acc[ai][bj][m][n][e] - mx); acc[ai][bj][m][n][e] = p; sm += p; }
            sm += __shfl_xor(sm, 16); sm += __shfl_xor(sm, 32); if (fq == 0) X[1024 + rt * 4 + wc] = sm; )
        asm volatile("s_waitcnt lgkmcnt(0)\n\ts_barrier" ::: "memory");
        PG8_EPI_ROWS( const f32x4 sv = *(const PG8_LAS f32x4*)(X + 1024 + rt * 4); const float inv = 1.0f / ((sv[0] + sv[1]) + (sv[2] + sv[3]));
            bf16_t* rp = P + (size_t)(u.pm * BM + rt) * D + u.pn * BM + wc * 32 + 8 * fq;
            _Pragma("unroll") for (int bj = 0; bj < 2; ++bj) *(bf16x8*)(rp + bj * HALF) = pack8(acc[ai][bj][m][0] * inv, acc[ai][bj][m][1] * inv); )
    } };
}

__device__ __forceinline__ void tr_item(const float* W, int ldw, int k0, int n0s, f16* WT, int ldt, int n0d, float cs, const float* ks, LAS float* scr, int lane) {
#pragma unroll
    for (int i = 0; i < 8; ++i) { const int kk = 8 * i + (lane >> 3), nq = (lane & 7) * 4;
        f32x4 v = __builtin_nontemporal_load((const f32x4*)(W + (size_t)(k0 + kk) * ldw + n0s + nq)); const float sc = ks ? cs * ks[k0 + kk] : cs;
        scr[kk * 33 + nq] = v[0] * sc; scr[kk * 33 + nq + 1] = v[1] * sc; scr[kk * 33 + nq + 2] = v[2] * sc; scr[kk * 33 + nq + 3] = v[3] * sc; }
    asm volatile("s_waitcnt lgkmcnt(0)" ::: "memory");
    const int cc = lane & 7;
#pragma unroll
    for (int j = 0; j < 4; ++j) { const int n = (lane >> 3) + 8 * j; const LAS float* sp = scr + (8 * cc) * 33 + n; f16x8 o;
#pragma unroll
        for (int e = 0; e < 8; ++e) o[e] = (f16)sp[e * 33];
        *(f16x8*)(WT + (size_t)(n0d + n) * ldt + k0 + 8 * cc) = o; }
    asm volatile("s_waitcnt lgkmcnt(0)" ::: "memory");
}
__device__ __forceinline__ void tr_matrix_item(const float* W, int K, int N, f16* WT, int it, float cs, int ncs, const float* ks, LAS float* scr, int lane) {
    const int nblk = N / 32, kb = it / nblk, nb = it % nblk;
    tr_item(W, N, 64 * kb, 32 * nb, WT, K, 32 * nb, (32 * nb < ncs) ? cs : 1.0f, ks, scr, lane);
}
constexpr int MOE_CONV_ITEMS = NEXP * (16 * 16 + 4 * 32);
__device__ __forceinline__ void conv_moe_item(const Ctx& c, int l, int it, LAS float* scr) {
    const int e = it / 384, r = it % 384;
    if (r < 256) { const int kb = r >> 4, nb = r & 15;
        const int j0 = (nb >> 3) * 128 + (nb & 3) * 32; const float* W = (((nb >> 2) & 1) ? c.in[37] : c.in[36]) + ((size_t)l * NEXP + e) * D * DEXP;
        tr_item(W, DEXP, 64 * kb, j0, wsp<f16>(c, WS_WGU_T) + (size_t)e * 512 * D, D, 32 * nb, 1.0f, nullptr, scr, c.lane);
    } else { const int r2 = r - 256, kb = r2 >> 5, nb = r2 & 31;
        tr_item(c.in[38] + ((size_t)l * NEXP + e) * DEXP * D, D, 64 * kb, 32 * nb, wsp<f16>(c, WS_WD_T) + (size_t)e * D * DEXP, DEXP, 32 * nb, 1.0f, nullptr, scr, c.lane); }
}
__device__ __forceinline__ void ph_fold_vectors(const Ctx& c) {
    float* S1 = wsp<float>(c, WS_S1Q); float* S2 = wsp<float>(c, WS_S2Q);
    for (int it = c.wid * c.G + c.bid; it < DEPTH * D; it += c.G * 8) { const int l = it >> 10, n = it & 1023;
        const f16* wt = wsp<f16>(c, WS_WQ_T) + ((size_t)l * D + n) * D; const f16x8 a = *(const f16x8*)(wt + 8 * c.lane), b = *(const f16x8*)(wt + 512 + 8 * c.lane);
        float s1 = 0.f;
#pragma unroll
        for (int i = 0; i < 8; ++i) s1 += (float)a[i] + (float)b[i];
        const float* w = c.in[26] + (size_t)l * D * D + n; const float* bb = c.in[25] + l * D; float s2 = 0.f;
#pragma unroll 4
        for (int j = 0; j < 16; ++j) { const int k = c.lane + 64 * j; s2 += bb[k] * w[(size_t)k * D]; }
        s1 = wave_sum(s1); s2 = wave_sum(s2) * XQSCALE;
        if (c.lane == 0) { S1[it] = s1; S2[it] = s2; } }
}
__device__ __forceinline__ void ph_conv(const Ctx& c) {
    LAS float* scr = (LAS float*)(c.lds + c.wid * 16384);
    const int gw = c.wid * c.G + c.bid, NGW = c.G * 8;
    constexpr int I_IN = 16 * 72, I_SQ = 16 * 32, I_GLU = 4 * 8, I_LRU = 16, PER_L = I_IN + 5 * I_SQ + I_GLU + I_LRU;
    for (int it0 = gw; it0 < DEPTH * PER_L; it0 += NGW) {
        const int l = it0 / PER_L; int it = it0 % PER_L;
        if (it < I_IN) { tr_matrix_item(c.in[4] + (size_t)l * D * DIN, D, DIN, wsp<f16>(c, WS_WIN_T) + (size_t)l * DIN * D, it, QSCALE, 512, nullptr, scr, c.lane); continue; } it -= I_IN;
        if (it < I_SQ) { tr_matrix_item(c.in[6] + (size_t)l * D * D, D, D, wsp<f16>(c, WS_WOUT_T) + (size_t)l * D * D, it, 1.f, 0, c.in[5] + l * D, scr, c.lane); continue; } it -= I_SQ;
        if (it < I_SQ) { tr_matrix_item(c.in[26] + (size_t)l * D * D, D, D, wsp<f16>(c, WS_WQ_T) + (size_t)l * D * D, it, XQSCALE, D, c.in[24] + l * D, scr, c.lane); continue; } it -= I_SQ;
        if (it < I_SQ) { tr_matrix_item(c.in[27] + (size_t)l * D * D, D, D, wsp<f16>(c, WS_WKV_T) + (size_t)(2 * l) * D * D, it, 1.f, 0, nullptr, scr, c.lane); continue; } it -= I_SQ;
        if (it < I_SQ) { tr_matrix_item(c.in[28] + (size_t)l * D * D, D, D, wsp<f16>(c, WS_WKV_T) + (size_t)(2 * l + 1) * D * D, it, 1.f, 0, nullptr, scr, c.lane); continue; } it -= I_SQ;
        if (it < I_SQ) { tr_matrix_item(c.in[29] + (size_t)l * D * D, D, D, wsp<f16>(c, WS_WO_T) + (size_t)l * D * D, it, 1.f, 0, nullptr, scr, c.lane); continue; } it -= I_SQ;
        if (it < I_GLU) { tr_matrix_item(c.in[15] + (size_t)l * 256 * 256, 256, 256, wsp<f16>(c, WS_WGLU_T) + (size_t)l * 256 * 256, it, 1.f, 0, nullptr, scr, c.lane); continue; } it -= I_GLU;
        { const int which = it >> 3, hd = (it >> 1) & 3, sub = it & 1;
          tr_matrix_item(c.in[which ? 21 : 19] + (size_t)(l * 4 + hd) * 4096, 64, 64, wsp<f16>(c, which ? WS_WLX_T : WS_WLA_T) + (size_t)(l * 4 + hd) * 4096, sub, 1.f, 0, nullptr, scr, c.lane); }
    }
    for (int it = gw; it < DEPTH * D; it += NGW) { float v[16]; vec_load16_nt(c.in[26] + (size_t)it * D, c.lane, v); const float sc = XQSCALE * c.in[24][it];
#pragma unroll
        for (int i = 0; i < 16; ++i) v[i] *= sc;
        row_store16(wsp<f16>(c, WS_WQN) + (size_t)it * D, c.lane, v); }
}
__device__ __forceinline__ void ph_fold_x(const Ctx& c, int l) {
    const f16* MT = wsp<f16>(c, WS_MT); const f16* KM = wsp<f16>(c, WS_KM) + (size_t)l * NMEM * D; const float* S2 = wsp<float>(c, WS_S2Q) + l * D;
    float* S1X = wsp<float>(c, WS_S1X); float* S2X = wsp<float>(c, WS_S2X);
    for (int it = c.wid * c.G + c.bid; it < BATCH * D; it += c.G * 8) { const int b = it >> 10, n = it & 1023, hh = n >> 8, key = n & 255;
        float v[16]; row_load16(MT + (size_t)it * D, c.lane, v); float s1 = 0.f;
#pragma unroll
        for (int i = 0; i < 16; ++i) s1 += v[i];
        const f16x4 kv = *(const f16x4*)(KM + ((size_t)b * 256 + key) * D + hh * 256 + 4 * c.lane); const f32x4 sv = *(const f32x4*)(S2 + hh * 256 + 4 * c.lane);
        float s2 = (float)kv[0] * sv[0] + (float)kv[1] * sv[1] + (float)kv[2] * sv[2] + (float)kv[3] * sv[3];
        s1 = wave_sum(s1); s2 = wave_sum(s2);
        if (c.lane == 0) { S1X[it] = s1; S2X[it] = s2; } }
}

template <int R> __device__ __forceinline__ void ln_rows(float (&v)[R][16], const float (&gg)[16], const float (&bb)[16]) {
    float s[R];
#pragma unroll
    for (int r = 0; r < R; ++r) { s[r] = 0.f;
#pragma unroll
        for (int i = 0; i < 16; ++i) s[r] += v[r][i]; }
#pragma unroll
    for (int o = 1; o < 64; o <<= 1)
#pragma unroll
        for (int r = 0; r < R; ++r) s[r] += __shfl_xor(s[r], o);
    float q[R];
#pragma unroll
    for (int r = 0; r < R; ++r) { const float mu = s[r] * (1.0f / 1024.0f); q[r] = 0.f;
#pragma unroll
        for (int i = 0; i < 16; ++i) { v[r][i] -= mu; q[r] += v[r][i] * v[r][i]; } }
#pragma unroll
    for (int o = 1; o < 64; o <<= 1)
#pragma unroll
        for (int r = 0; r < R; ++r) q[r] += __shfl_xor(q[r], o);
#pragma unroll
    for (int r = 0; r < R; ++r) { const float rstd = 1.0f / sqrtf(q[r] * (1.0f / 1024.0f) + 1e-5f);
#pragma unroll
        for (int i = 0; i < 16; ++i) v[r][i] = v[r][i] * rstd * gg[i] + bb[i]; }
}
struct AF16 {
    const f16* A; int lda; const int* rowtok; const float* ks;
    __device__ __forceinline__ void load4(int m, int k, float (&v)[4]) const {
        int r = m; if (rowtok) { const int t = rowtok[m]; r = (t < 0 ? 0 : t) >> 1; }
        const f16x4 a = *(const f16x4*)(A + (size_t)r * lda + k);
#pragma unroll
        for (int j = 0; j < 4; ++j) v[j] = (float)a[j];
        if (ks) {
#pragma unroll
            for (int j = 0; j < 4; ++j) v[j] *= ks[k + j];
        }
    }
};
struct BF32 {
    const float* B; int ldb; const int* tile_exp; size_t estride;
    __device__ __forceinline__ const float* base(int m0) const { return tile_exp ? B + (size_t)tile_exp[1 + (m0 >> 8)] * estride : B; }
};
template <class EF>
__device__ __forceinline__ void sgemm_phase(const Ctx& c, int M, int Nc, int K, const AF16 af, const BF32 bf, const EF ef) {
    LAS float* As = (LAS float*)c.lds;
    LAS float* Bs = As + 16 * 132;
    const int tid = c.tid, tx = tid & 15, ty = tid >> 4;
    const int tilesN = Nc / 64, ntiles = (M / 128) * tilesN;
    for (int u = c.bid; u < ntiles; u += c.G) {
        const int m0 = (u / tilesN) * 128, n0 = (u % tilesN) * 64;
        const float* Bb = bf.base(m0);
        float acc[4][4];
#pragma unroll
        for (int i = 0; i < 4; ++i)
#pragma unroll
            for (int j = 0; j < 4; ++j) acc[i][j] = 0.f;
        for (int k0 = 0; k0 < K; k0 += 16) {
            { const int m = tid & 127, kq = (tid >> 7) * 4; float v[4]; af.load4(m0 + m, k0 + kq, v);
#pragma unroll
              for (int j = 0; j < 4; ++j) As[(kq + j) * 132 + m] = v[j]; }
            { const int kk = tid >> 5, n = (tid & 31) * 2; const float* bp = Bb + (size_t)(k0 + kk) * bf.ldb + n0 + n;
              Bs[kk * 68 + n] = bp[0]; Bs[kk * 68 + n + 1] = bp[1]; }
            __syncthreads();
#pragma unroll
            for (int kk = 0; kk < 16; ++kk) {
                const f32x4 a = *(const LAS f32x4*)(As + kk * 132 + 4 * ty), b = *(const LAS f32x4*)(Bs + kk * 68 + 4 * tx);
#pragma unroll
                for (int i = 0; i < 4; ++i)
#pragma unroll
                    for (int j = 0; j < 4; ++j) acc[i][j] += a[i] * b[j];
            }
            __syncthreads();
        }
#pragma unroll
        for (int i = 0; i < 4; ++i) ef(m0 + 4 * ty + i, n0 + 4 * tx, acc[i]);
    }
}
struct EpiStoreF16 { f16* C; int ldc; float scale; int nscale;
    __device__ __forceinline__ void operator()(int m, int n, const float (&a)[4]) const {
        const float s = n < nscale ? scale : 1.0f; f16x4 o;
#pragma unroll
        for (int j = 0; j < 4; ++j) o[j] = (f16)(a[j] * s);
        *(f16x4*)(C + (size_t)m * ldc + n) = o; } };
struct EpiResid { f16* H;
    __device__ __forceinline__ void operator()(int m, int n, const float (&a)[4]) const {
        f16x4* p = (f16x4*)(H + (size_t)m * D + n); f16x4 o = *p;
#pragma unroll
        for (int j = 0; j < 4; ++j) o[j] = (f16)(ALPHA * (float)o[j] + a[j]);
        *p = o; } };
struct EpiGlu { const f16* yact; const float* bg; f16* Y;
    __device__ __forceinline__ void operator()(int m, int n, const float (&a)[4]) const {
        const f16x4 y = *(const f16x4*)(yact + (size_t)m * 256 + n); f16x4 o;
#pragma unroll
        for (int j = 0; j < 4; ++j) o[j] = (f16)((float)y[j] * sigmoidf_(a[j] + bg[n + j]));
        *(f16x4*)(Y + (size_t)m * D + 512 + n) = o; } };
struct EpiSiluMul { const f16* hg; f16* he;
    __device__ __forceinline__ void operator()(int m, int n, const float (&a)[4]) const {
        const f16x4 g = *(const f16x4*)(hg + (size_t)m * 256 + n); f16x4 o;
#pragma unroll
        for (int j = 0; j < 4; ++j) { const float gv = (float)g[j]; o[j] = (f16)(gv * sigmoidf_(gv) * a[j]); }
        *(f16x4*)(he + (size_t)m * 256 + n) = o; } };
struct EpiScatter { const int* rowtok; const float* roww; f16* ys;
    __device__ __forceinline__ void operator()(int m, int n, const float (&a)[4]) const {
        const int r = rowtok[m]; if (r < 0) return; const float w = roww[m]; f16x4 o;
#pragma unroll
        for (int j = 0; j < 4; ++j) o[j] = (f16)(w * a[j]);
        *(f16x4*)(ys + (size_t)r * D + n) = o; } };

__device__ __forceinline__ void ph_ln0(const Ctx& c) {
    const int gw = c.wid * c.G + c.bid, NGW = c.G * 8;
    f16* H = wsp<f16>(c, WS_H);
    float gg[16], bb[16]; vec_load16(c.in[2], c.lane, gg); vec_load16(c.in[3], c.lane, bb);
    for (int m = gw * 4; m < NTOK; m += NGW * 4) {
        float v[4][16];
#pragma unroll
        for (int r = 0; r < 4; ++r) vec_load16_nt(c.in[0] + (size_t)(m + r) * D, c.lane, v[r]);
        ln_rows<4>(v, gg, bb);
#pragma unroll
        for (int r = 0; r < 4; ++r) row_store16(H + (size_t)(m + r) * D, c.lane, v[r]);
    }
    f16* M16 = wsp<f16>(c, WS_MEM16);
    for (int m = gw; m < NMEM; m += NGW) { float v[16]; vec_load16_nt(c.in[1] + (size_t)m * D, c.lane, v); row_store16(M16 + (size_t)m * D, c.lane, v); }
}
constexpr size_t WS_KMAX = WS_KMEAN + 512 * 1024;
__device__ __forceinline__ void ph_kmean(const Ctx& c) {
    const f16* Z = wsp<f16>(c, WS_Z); float* KMN = wsp<float>(c, WS_KMEAN); float* KMX = wsp<float>(c, WS_KMAX);
    LAS float* part = (LAS float*)c.lds;
    LAS float* pmx = part + 8 * 512;
    for (int it = c.bid; it < 128; it += c.G) {
        const f16* p = Z + ((size_t)it * 256 + c.wid * 32) * DIN + ZK + 8 * c.lane;
        float cs[8]; float mx = 0.f;
#pragma unroll
        for (int e = 0; e < 8; ++e) cs[e] = 0.f;
#pragma unroll 4
        for (int r = 0; r < 32; ++r) { const f16x8 v = *(const f16x8*)(p + (size_t)r * DIN); float q = 0.f;
#pragma unroll
            for (int e = 0; e < 8; ++e) { const float x = (float)v[e]; cs[e] += x; q += x * x; }
            q += __shfl_xor(q, 1); q += __shfl_xor(q, 2); q += __shfl_xor(q, 4); mx = fmaxf(mx, q); }
#pragma unroll
        for (int e = 0; e < 8; ++e) part[c.wid * 512 + 8 * c.lane + e] = cs[e];
        if ((c.lane & 7) == 0) pmx[c.wid * 8 + (c.lane >> 3)] = mx;
        __syncthreads();
        { float s = 0.f;
#pragma unroll
          for (int w = 0; w < 8; ++w) s += part[w * 512 + c.tid];
          KMN[it * 512 + c.tid] = s * (1.0f / 256.0f); }
        if (c.tid < 8) { float m = 0.f;
#pragma unroll
            for (int w = 0; w < 8; ++w) m = fmaxf(m, pmx[w * 8 + c.tid]);
            KMX[it * 8 + c.tid] = sqrtf(m); }
        __syncthreads();
    }
}
__device__ __forceinline__ void ph_attn_naive(const Ctx& c) {
    const f16* Z = wsp<f16>(c, WS_Z); const float* KMN = wsp<float>(c, WS_KMEAN); f16* Y = wsp<f16>(c, WS_Y);
    for (int item = c.bid * 512 + c.tid; item < NTOK * 8; item += c.G * 512) {
        const int t = item & 2047, h = (item >> 11) & 7, b = item >> 14, own = t >> 8;
        const size_t n = (size_t)b * SEQ + t;
        float q[64];
        { const f16* qp = Z + n * DIN + ZQ + h * 64;
#pragma unroll
          for (int d8 = 0; d8 < 8; ++d8) { const f16x8 v = *(const f16x8*)(qp + 8 * d8);
#pragma unroll
              for (int j = 0; j < 8; ++j) q[8 * d8 + j] = (float)v[j]; } }
        unsigned allowed = 0u;
        { float gate[8];
#pragma unroll
          for (int nb = 0; nb < 8; ++nb) { float s = 0.f; if (nb < own) { const float* kp = KMN + ((size_t)(b * 8 + nb)) * 512 + h * 64;
#pragma unroll
                  for (int d = 0; d < 64; ++d) s += q[d] * kp[d]; } gate[nb] = s; }
#pragma unroll
          for (int nb = 0; nb < 8; ++nb) { int rank = 0;
#pragma unroll
              for (int o = 0; o < 8; ++o) if (o < own && o != nb && (gate[o] > gate[nb] || (gate[o] == gate[nb] && o < nb))) ++rank;
              if (nb < own && rank < 3) allowed |= 1u << nb; } }
        const float slope2 = exp2f(-(float)(h + 1)) * LOG2E;
        float m = -1e30f, l = 0.f, o[64];
#pragma unroll
        for (int d = 0; d < 64; ++d) o[d] = 0.f;
        for (int step = 0; step <= own; ++step) {
            const int blk = step == 0 ? own : step - 1;
            const bool ok = (blk == own) || ((allowed >> blk) & 1u);
            const int jend = (blk == own) ? (t & 255) : 255;
            if (!ok) continue;
            for (int jj = 0; jj <= jend; ++jj) {
                const int j = blk * 256 + jj; const f16* kp = Z + ((size_t)b * SEQ + j) * DIN + ZK + h * 64;
                float s = 0.f;
#pragma unroll
                for (int d8 = 0; d8 < 8; ++d8) { const f16x8 v = *(const f16x8*)(kp + 8 * d8);
#pragma unroll
                    for (int jx = 0; jx < 8; ++jx) s += q[8 * d8 + jx] * (float)v[jx]; }
                s -= slope2 * (float)(t - j);
                const float mn = fmaxf(m, s), al = exp2f(m - mn), p = exp2f(s - mn);
                l = l * al + p; m = mn;
                const f16* vp = kp + (ZV - ZK);
#pragma unroll
                for (int d8 = 0; d8 < 8; ++d8) { const f16x8 v = *(const f16x8*)(vp + 8 * d8);
#pragma unroll
                    for (int jx = 0; jx < 8; ++jx) o[8 * d8 + jx] = o[8 * d8 + jx] * al + p * (float)v[jx]; }
            }
        }
        const float rl = 1.0f / l; f16* yp = Y + n * D + h * 64;
#pragma unroll
        for (int d8 = 0; d8 < 8; ++d8) { f16x8 v;
#pragma unroll
            for (int jx = 0; jx < 8; ++jx) v[jx] = (f16)(o[8 * d8 + jx] * rl);
            *(f16x8*)(yp + 8 * d8) = v; }
    }
}
namespace att {
typedef _Float16 h8 __attribute__((ext_vector_type(8)));
typedef float f32x16 __attribute__((ext_vector_type(16)));
typedef short v4i16 __attribute__((ext_vector_type(4)));
typedef unsigned u32x4 __attribute__((ext_vector_type(4)));
typedef const LAS char* lcp;
constexpr int SLOTB = 8192, LDS_K = 0, LDS_V = 2 * SLOTB, LDS_WS = 4 * SLOTB, LDS_OST = LDS_WS + 8 * 256, LDS_TOTAL = LDS_OST + 8 * 4096;
constexpr float THRL = 8.0f;
__device__ __forceinline__ int crow(int r, int hi) { return (r & 3) + 8 * (r >> 2) + 4 * hi; }
__device__ __forceinline__ float max3f(float a, float b, float c) { float r; asm("v_max3_f32 %0, %1, %2, %3" : "=v"(r) : "v"(a), "v"(b), "v"(c)); return r; }
__device__ __forceinline__ h8 vtr2(lcp p) {
    const v4i16 lo = __builtin_amdgcn_ds_read_tr16_b64_v4i16((LAS v4i16*)p), hi = __builtin_amdgcn_ds_read_tr16_b64_v4i16((LAS v4i16*)(p + 512));
    typedef short s8 __attribute__((ext_vector_type(8)));
    const s8 v = {lo[0], lo[1], lo[2], lo[3], hi[0], hi[1], hi[2], hi[3]}; return __builtin_bit_cast(h8, v); }

__device__ __forceinline__ void attn_unit(const Ctx& c, int b, int h, int qb) {
    const f16* Z = wsp<f16>(c, WS_Z); const float* KMN = wsp<float>(c, WS_KMEAN); f16* Y = wsp<f16>(c, WS_Y);
    int lane = c.lane; asm volatile("" : "+v"(lane));
    const int r32 = lane & 31, hi = lane >> 5, wid = c.wid;
    const size_t rowbase = (size_t)b * SEQ; const int q0 = qb * 256;
    const f16* Kh = Z + rowbase * DIN + ZK + h * 64; const f16* Vh = Z + rowbase * DIN + ZV + h * 64;
    const f16* ksrc = Kh + (size_t)lane * DIN + wid * 8;
    const f16* vsrc = Vh + (size_t)(16 * (wid & 3) + (lane >> 2)) * DIN + (wid >> 2) * 32 + (lane & 3) * 8;
    LAS unsigned char* lds = c.lds;
#define ATT_DMA(tile, slot) do { \
        __builtin_amdgcn_global_load_lds((const unsigned*)(ksrc + (size_t)(tile) * 64 * DIN), (LAS unsigned*)(lds + LDS_K + (slot) * SLOTB + wid * 1024), 16, 0, 0); \
        __builtin_amdgcn_global_load_lds((const unsigned*)(vsrc + (size_t)(tile) * 64 * DIN), (LAS unsigned*)(lds + LDS_V + (slot) * SLOTB + wid * 1024), 16, 0, 0); } while (0)
    ATT_DMA(4 * qb, 0);
    const f16* Qw = Z + (rowbase + q0 + wid * 32 + r32) * DIN + ZQ + h * 64 + hi * 8;
    h8 qr[4];
#pragma unroll
    for (int d0 = 0; d0 < 4; ++d0) qr[d0] = *(const h8*)(Qw + d0 * 16);
    unsigned allowed = (1u << qb) - 1u;
    if (qb > 3) {
        float gate[8];
#pragma unroll
        for (int nb = 0; nb < 7; ++nb) { float s = 0.f;
            if (nb < qb) { const float* kp = KMN + (size_t)(b * 8 + nb) * 512 + h * 64 + hi * 8;
#pragma unroll
                for (int d0 = 0; d0 < 4; ++d0) { const f32x4 k0 = *(const f32x4*)(kp + d0 * 16), k1 = *(const f32x4*)(kp + d0 * 16 + 4);
#pragma unroll
                    for (int j = 0; j < 4; ++j) s += (float)qr[d0][j] * k0[j] + (float)qr[d0][4 + j] * k1[j]; }
                s += __shfl_xor(s, 32); }
            gate[nb] = s; }
        gate[7] = 0.f; allowed = 0u;
#pragma unroll
        for (int nb = 0; nb < 7; ++nb) { int rank = 0;
#pragma unroll
            for (int o = 0; o < 7; ++o) if (o < qb && o != nb && (gate[o] > gate[nb] || (gate[o] == gate[nb] && o < nb))) ++rank;
            if (nb < qb && rank < 3) allowed |= 1u << nb; }
    }
    const float slope2 = exp2f(-(float)(h + 1)) * LOG2E;
    float kmx = 0.f;
    { const float* kx = wsp<float>(c, WS_KMAX) + (size_t)b * 64 + h;
#pragma unroll
      for (int nb = 0; nb < 8; ++nb) if (nb <= qb) kmx = fmaxf(kmx, kx[nb * 8]); }
    float qn = 0.f;
#pragma unroll
    for (int d0 = 0; d0 < 4; ++d0)
#pragma unroll
        for (int j = 0; j < 8; ++j) qn += (float)qr[d0][j] * (float)qr[d0][j];
    qn += __shfl_xor(qn, 32);
    const float qmw = __int_as_float(__builtin_amdgcn_readfirstlane(__float_as_int(sqrtf(wave_max(qn)))));
    { LAS float* qx = (LAS float*)(lds + LDS_TOTAL); if (lane == 0) qx[wid] = qmw; }
    const int qrel = wid * 32 + r32;
    float mhat = 0.f, l_reg = 0.f; f32x16 o[2];
#pragma unroll
    for (int r = 0; r < 16; ++r) { o[0][r] = 0.f; o[1][r] = 0.f; }
    LAS float* wsf = (LAS float*)(lds + LDS_WS) + wid * 64; LAS float* wsfh = wsf + 4 * hi;
    const lcp kp0 = (lcp)(lds + LDS_K) + hi * 1024 + r32 * 16;
    const lcp vp0 = (lcp)(lds + LDS_V) + ((lane >> 4) & 1) * 32 + (lane & 3) * 8 + (4 * hi + ((lane & 15) >> 2)) * 64;
    asm volatile("s_waitcnt vmcnt(0)" ::: "memory"); __syncthreads();
    float qmu = 0.f;
    { const LAS float* qx = (const LAS float*)(lds + LDS_TOTAL);
#pragma unroll
      for (int w = 0; w < 8; ++w) qmu = fmaxf(qmu, qx[w]); }
    const float rs2 = 1.0f / slope2;
    int tile_lo = (int)ceilf(((float)(q0 - 63) - (2.0f * qmu * kmx + 30.0f) * rs2) * (1.0f / 64.0f));
    tile_lo = tile_lo < 0 ? 0 : (tile_lo > 4 * qb ? 4 * qb : tile_lo); tile_lo = __builtin_amdgcn_readfirstlane(tile_lo);
    const float bw = 2.0f * qmw * kmx + 30.0f;
    const int NT = 4 + 4 * qb - tile_lo;
    bool started = false;
    for (int s = 0; s < NT; ++s) {
        const int tile = s < 4 ? 4 * qb + s : tile_lo + s - 4, slot = s & 1;
        if (s + 1 < NT) { const int nt_ = (s + 1) < 4 ? 4 * qb + s + 1 : tile_lo + s - 3; ATT_DMA(nt_, slot ^ 1); }
        const bool band = s < 4;
        const bool okrow = band ? true : (((allowed >> (tile >> 2)) & 1u) != 0u);
        const bool inreach = slope2 * (float)(q0 + 32 * wid - 64 * tile - 63) <= bw;
        const bool active = (band ? (64 * s <= 32 * wid + 31) : (__any(okrow) != 0)) && inreach;
        if (active) {
            const float NEG = -INFINITY;
            const float base = okrow ? (slope2 * (float)(64 * tile - (q0 + qrel) + 4 * hi) - mhat) : NEG, base1 = base + 32.0f * slope2;
            f32x16 p0, p1;
#pragma unroll
            for (int r = 0; r < 16; ++r) { const float kc = (float)((r & 3) + 8 * (r >> 2)); p0[r] = __builtin_fmaf(slope2, kc, base); p1[r] = __builtin_fmaf(slope2, kc, base1); }
            { const lcp kb = kp0 + slot * SLOTB; h8 kf[8];
#pragma unroll
              for (int d0 = 0; d0 < 4; ++d0) { kf[2 * d0] = *(const LAS h8*)(kb + d0 * 2048); kf[2 * d0 + 1] = *(const LAS h8*)(kb + d0 * 2048 + 512); }
#pragma unroll
              for (int d0 = 0; d0 < 4; ++d0) { p0 = __builtin_amdgcn_mfma_f32_32x32x16_f16(kf[2 * d0], qr[d0], p0, 0, 0, 0); p1 = __builtin_amdgcn_mfma_f32_32x32x16_f16(kf[2 * d0 + 1], qr[d0], p1, 0, 0, 0); } }
            asm volatile("s_nop 15\n\ts_nop 7" : "+v"(p0), "+v"(p1));
            if (band && (64 * s + 63 > 32 * wid)) { const int kb_ = 64 * s + 4 * hi;
#pragma unroll
                for (int r = 0; r < 16; ++r) { const int kv = kb_ + (r & 3) + 8 * (r >> 2); p0[r] = (kv > qrel) ? NEG : p0[r]; p1[r] = (kv + 32 > qrel) ? NEG : p1[r]; } }
            float rm;
            { float ma = max3f(p0[0], p0[1], p1[0]), mb = max3f(p0[2], p0[3], p1[1]); ma = max3f(ma, p1[2], p1[3]);
#pragma unroll
              for (int r = 4; r < 16; r += 4) { ma = max3f(ma, p0[r], p0[r + 1]); mb = max3f(mb, p0[r + 2], p0[r + 3]); ma = max3f(ma, p1[r], p1[r + 1]); mb = max3f(mb, p1[r + 2], p1[r + 3]); }
              rm = max3f(ma, mb, mb); }
            rm = fmaxf(rm, __shfl_xor(rm, 32));
            if (!started || __any(rm > THRL)) {
                const float dl = (!started) ? rm : fmaxf(rm, 0.f);
                mhat += dl;
#pragma unroll
                for (int r = 0; r < 16; ++r) { p0[r] -= dl; p1[r] -= dl; }
                if (started) { const float f = __builtin_amdgcn_exp2f(-dl); l_reg *= f; if (hi == 0) wsf[r32] = f;
#pragma unroll
                    for (int r = 0; r < 16; ++r) { const float fr_ = wsfh[(r & 3) + 8 * (r >> 2)]; o[0][r] *= fr_; o[1][r] *= fr_; } }
            }
            started = true;
            float sacc = 0.f;
#pragma unroll
            for (int r = 0; r < 16; ++r) { p0[r] = __builtin_amdgcn_exp2f(p0[r]); p1[r] = __builtin_amdgcn_exp2f(p1[r]); sacc += p0[r] + p1[r]; }
            l_reg += sacc;
            h8 pa[4];
#pragma unroll
            for (int j = 0; j < 8; ++j) { pa[0][j] = (f16)p0[j]; pa[1][j] = (f16)p0[8 + j]; pa[2][j] = (f16)p1[j]; pa[3][j] = (f16)p1[8 + j]; }
            const lcp vp = vp0 + slot * SLOTB;
#pragma unroll
            for (int d0 = 0; d0 < 2; ++d0) { h8 vf[4];
#pragma unroll
                for (int ks = 0; ks < 4; ++ks) vf[ks] = vtr2(vp + d0 * 4096 + ks * 1024);
#pragma unroll
                for (int ks = 0; ks < 4; ++ks) o[d0] = __builtin_amdgcn_mfma_f32_32x32x16_f16(pa[ks], vf[ks], o[d0], 0, 0, 0); }
        }
        asm volatile("s_waitcnt vmcnt(0)" ::: "memory"); __syncthreads();
    }
    l_reg += __shfl_xor(l_reg, 32);
    if (hi == 0) wsf[32 + r32] = l_reg;
    int hi4 = 4 * hi; asm volatile("" : "+v"(hi4));
    LAS float* wl = wsf + 32 + hi4;
    LAS f16* stg = (LAS f16*)(lds + LDS_OST) + wid * 2048 + hi4 * 64 + r32;
#pragma unroll
    for (int r = 0; r < 16; ++r) { const int kc = (r & 3) + 8 * (r >> 2); const float rl = 1.0f / wl[kc];
        stg[kc * 64] = (f16)(o[0][r] * rl); stg[kc * 64 + 32] = (f16)(o[1][r] * rl); }
    f16* Ow = Y + (rowbase + q0 + wid * 32) * D + h * 64;
    { const LAS f16* sr = (const LAS f16*)(lds + LDS_OST) + wid * 2048 + (lane >> 3) * 64 + (lane & 7) * 8; f16* og = Ow + (size_t)(lane >> 3) * D + (lane & 7) * 8;
#pragma unroll
      for (int i = 0; i < 4; ++i) { const u32x4 v = *(const LAS u32x4*)(sr + i * 512); *(u32x4*)(og + (size_t)i * 8 * D) = v; } }
    __syncthreads();
#undef ATT_DMA
}
__device__ const unsigned char ATT_ORDER[64] = {47,55,63,39,38,46,54,62,37,45,53,61,36,44,52,60,28,29,30,31,27,35,43,51,59,26,34,42,50,58,18,19,20,21,22,23,9,10,11,12,13,14,15,17,25,33,41,49,57,1,2,3,4,5,6,7,0,8,16,24,32,40,48,56};
constexpr int ATT_NBIG = 30;
}
namespace xatt {
typedef _Float16 h8 __attribute__((ext_vector_type(8)));
typedef float f32x16 __attribute__((ext_vector_type(16)));
typedef unsigned u32x4 __attribute__((ext_vector_type(4)));
typedef const LAS char* lcp;
constexpr int XSLOT = 32768, L_WSF = 140288;
__device__ __forceinline__ void xattn_unit(const Ctx& c, int l, int pm, int hh) {
    const f16* QX = wsp<f16>(c, WS_QX); const f16* KM = wsp<f16>(c, WS_KM) + (size_t)l * NMEM * D; const f16* VM = wsp<f16>(c, WS_VM) + (size_t)l * NMEM * D; f16* OC = wsp<f16>(c, WS_OC);
    int lane = c.lane; asm volatile("" : "+v"(lane));
    const int r32 = lane & 31, hi = lane >> 5, wid = c.wid, b = pm >> 3;
    LAS unsigned char* lds = c.lds;
    const f16* kbase = KM + ((size_t)b * 256 + lane) * D + hh * 256;
    const f16* vbase = VM + ((size_t)b * 256 + (lane >> 2)) * D + hh * 256 + (lane & 3) * 8;
#define XA_DMA_K(tile, slotoff) do { _Pragma("unroll") for (int j_ = 0; j_ < 4; ++j_) { const int cc_ = 4 * wid + j_; \
        __builtin_amdgcn_global_load_lds((const unsigned*)(kbase + (size_t)(tile) * 64 * D + cc_ * 8), (LAS unsigned*)(lds + (slotoff) + cc_ * 1024), 16, 0, 0); } } while (0)
#define XA_DMA_V(tile, slotoff) do { _Pragma("unroll") for (int j_ = 0; j_ < 4; ++j_) { const int pi_ = 4 * wid + j_; \
        __builtin_amdgcn_global_load_lds((const unsigned*)(vbase + ((size_t)(tile) * 64 + 16 * (pi_ & 3)) * D + (pi_ >> 2) * 32), (LAS unsigned*)(lds + (slotoff) + pi_ * 1024), 16, 0, 0); } } while (0)
#define XA_BAR(n) asm volatile("s_waitcnt vmcnt(" #n ") lgkmcnt(0)\n\ts_barrier" ::: "memory")
    const f16* Qw = QX + ((size_t)pm * 256 + wid * 32 + r32) * D + hh * 256 + hi * 8;
    h8 qr[16];
#pragma unroll
    for (int d0 = 0; d0 < 16; ++d0) qr[d0] = *(const h8*)(Qw + d0 * 16);
    XA_DMA_K(0, 0); XA_DMA_K(1, XSLOT); XA_DMA_V(0, 2 * XSLOT); XA_DMA_V(1, 3 * XSLOT);
    f32x16 p[4][2];
    const lcp kp0 = (lcp)lds + hi * 1024 + r32 * 16;
#define XA_QK(t, slotoff) do { \
        _Pragma("unroll") for (int r_ = 0; r_ < 16; ++r_) { p[t][0][r_] = 0.f; p[t][1][r_] = 0.f; } \
        _Pragma("unroll") for (int d0 = 0; d0 < 16; ++d0) { const h8 b0_ = *(const LAS h8*)(kp0 + (slotoff) + d0 * 2048), b1_ = *(const LAS h8*)(kp0 + (slotoff) + d0 * 2048 + 512); \
            p[t][0] = __builtin_amdgcn_mfma_f32_32x32x16_f16(b0_, qr[d0], p[t][0], 0, 0, 0); p[t][1] = __builtin_amdgcn_mfma_f32_32x32x16_f16(b1_, qr[d0], p[t][1], 0, 0, 0); } } while (0)
    XA_BAR(12);
    XA_QK(0, 0);
    XA_BAR(8);
    XA_DMA_K(2, 0);
    XA_QK(1, XSLOT);
    XA_BAR(0);
    XA_DMA_K(3, XSLOT);
    XA_QK(2, 0);
    XA_BAR(0);
    XA_DMA_V(2, 0);
    XA_QK(3, XSLOT);
    float mx = p[0][0][0];
#pragma unroll
    for (int t = 0; t < 4; ++t)
#pragma unroll
        for (int q = 0; q < 2; ++q)
#pragma unroll
            for (int r = 0; r < 16; ++r) mx = fmaxf(mx, p[t][q][r]);
    mx = fmaxf(mx, __shfl_xor(mx, 32));
    float lsum = 0.f; h8 pa[4][4];
#pragma unroll
    for (int t = 0; t < 4; ++t) {
#pragma unroll
        for (int q = 0; q < 2; ++q)
#pragma unroll
            for (int r = 0; r < 16; ++r) { const float e = __builtin_amdgcn_exp2f(p[t][q][r] - mx); p[t][q][r] = e; lsum += e; }
#pragma unroll
        for (int j = 0; j < 8; ++j) { pa[t][0][j] = (f16)p[t][0][j]; pa[t][1][j] = (f16)p[t][0][8 + j]; pa[t][2][j] = (f16)p[t][1][j]; pa[t][3][j] = (f16)p[t][1][8 + j]; } }
    lsum += __shfl_xor(lsum, 32);
    XA_BAR(4);
    XA_DMA_V(3, XSLOT);
    f32x16 o[8];
#pragma unroll
    for (int db = 0; db < 8; ++db)
#pragma unroll
        for (int r = 0; r < 16; ++r) o[db][r] = 0.f;
    const lcp vp0 = (lcp)lds + ((lane >> 4) & 1) * 32 + (lane & 3) * 8 + (4 * hi + ((lane & 15) >> 2)) * 64;
#define XA_PV(t, slotoff) do { _Pragma("unroll") for (int db = 0; db < 8; ++db) { h8 vf_[4]; \
        _Pragma("unroll") for (int ks = 0; ks < 4; ++ks) vf_[ks] = att::vtr2(vp0 + (slotoff) + db * 4096 + ks * 1024); \
        _Pragma("unroll") for (int ks = 0; ks < 4; ++ks) o[db] = __builtin_amdgcn_mfma_f32_32x32x16_f16(pa[t][ks], vf_[ks], o[db], 0, 0, 0); } } while (0)
    XA_PV(0, 2 * XSLOT); XA_PV(1, 3 * XSLOT);
    XA_BAR(0);
    XA_PV(2, 0); XA_PV(3, XSLOT);
    XA_BAR(0);
    LAS float* wsf = (LAS float*)(lds + L_WSF) + wid * 64;
    if (hi == 0) wsf[r32] = lsum;
    int hi4 = 4 * hi; asm volatile("" : "+v"(hi4));
    LAS float* wl = wsf + hi4;
    LAS f16* stg = (LAS f16*)(lds + wid * 16384) + hi4 * 256 + r32;
#pragma unroll
    for (int r = 0; r < 16; ++r) { const int kc = (r & 3) + 8 * (r >> 2); const float rl = 1.0f / wl[kc];
#pragma unroll
        for (int db = 0; db < 8; ++db) stg[kc * 256 + db * 32] = (f16)(o[db][r] * rl); }
    { const LAS f16* sr = (const LAS f16*)(lds + wid * 16384) + (lane >> 5) * 256 + (lane & 31) * 8; f16* og = OC + ((size_t)pm * 256 + wid * 32 + (lane >> 5)) * D + hh * 256 + (lane & 31) * 8;
#pragma unroll
      for (int i = 0; i < 16; ++i) { const u32x4 v = *(const LAS u32x4*)(sr + i * 512); *(u32x4*)(og + (size_t)i * 2 * D) = v; } }
    XA_BAR(0);
#undef XA_DMA_K
#undef XA_DMA_V
#undef XA_BAR
#undef XA_QK
#undef XA_PV
}
__device__ __forceinline__ void xattn_phase(const Ctx& c, int l) {
    const int v = (c.G % 8 == 0) ? (c.bid % 8) * (c.G / 8) + c.bid / 8 : c.bid;
    for (int tr = 2 * v; tr < 512; tr += 2 * c.G) { xattn_unit(c, l, tr >> 2, tr & 3); xattn_unit(c, l, (tr + 1) >> 2, (tr + 1) & 3); }
}
}


constexpr int CW_LF = 12288;
namespace lru {
typedef _Float16 h8 __attribute__((ext_vector_type(8)));
constexpr int XS = 264;
constexpr int L_XC = 0, L_GL = 64 * XS * 2, L_RP = 2 * 64 * XS * 2, L_RS = L_RP + 64 * 8 * 4, L_HIN = L_RS + 64 * 4, L_END = L_HIN + 256 * 4;
__device__ __forceinline__ float sigm(float x) { return __builtin_amdgcn_rcpf(1.0f + __expf(-x)); }
template <int PASS>
__device__ __forceinline__ void lru_unit(const Ctx& c, int l, int b, int ck) {
    const f16* Z = wsp<f16>(c, WS_Z); float* ENDS = wsp<float>(c, WS_LRUENDS);
    unsigned* flags = (unsigned*)(c.ws + WS_CTL) + CW_LF; const unsigned epoch = (unsigned)l + 1u;
    int lane = c.lane; asm volatile("" : "+v"(lane));
    const int tid = c.wid * 64 + lane, fr = lane & 15, fq = lane >> 4, hd = c.wid >> 1, half = c.wid & 1;
    LAS f16* XC = (LAS f16*)(c.lds + L_XC); LAS f16* GL = (LAS f16*)(c.lds + L_GL);
    LAS float* RP = (LAS float*)(c.lds + L_RP); LAS float* RS = (LAS float*)(c.lds + L_RS); LAS float* HIN = (LAS float*)(c.lds + L_HIN);
    const size_t n0 = (size_t)b * SEQ + ck * 64;
    const float* cw = c.in[17] + l * 4 * 256; const float* cb = c.in[18] + l * 256;
    h8 wa[2][2], wx[2][2];
    { const f16* wat = wsp<f16>(c, WS_WLA_T) + (size_t)(l * 4 + hd) * 4096; const f16* wxt = wsp<f16>(c, WS_WLX_T) + (size_t)(l * 4 + hd) * 4096;
#pragma unroll
      for (int ks = 0; ks < 2; ++ks)
#pragma unroll
          for (int n = 0; n < 2; ++n) { wa[ks][n] = *(const h8*)(wat + (half * 32 + 16 * n + fr) * 64 + 32 * ks + 8 * fq); wx[ks][n] = *(const h8*)(wxt + (half * 32 + 16 * n + fr) * 64 + 32 * ks + 8 * fq); } }
    { const int cg = tid & 31, t0 = (tid >> 5) * 4;
      f32x4 w0[4], w1[4];
#pragma unroll
      for (int j = 0; j < 4; ++j) { w0[j] = *(const f32x4*)(cw + j * 256 + 8 * cg); w1[j] = *(const f32x4*)(cw + j * 256 + 8 * cg + 4); }
      const f32x4 b0 = *(const f32x4*)(cb + 8 * cg), b1 = *(const f32x4*)(cb + 8 * cg + 4);
      h8 xr[7];
#pragma unroll
      for (int q = 0; q < 7; ++q) { const int tt = ck * 64 + t0 - 3 + q;
          if (tt >= 0) xr[q] = *(const h8*)(Z + (n0 + t0 - 3 + q) * DIN + ZXL + 8 * cg);
          else {
#pragma unroll
              for (int e = 0; e < 8; ++e) xr[q][e] = (f16)0.f; } }
      if (PASS >= 1) {
#pragma unroll
          for (int q = 0; q < 4; ++q) *(LAS h8*)(GL + (t0 + q) * XS + 8 * cg) = *(const h8*)(Z + (n0 + t0 + q) * DIN + ZGL + 8 * cg); }
#pragma unroll
      for (int q = 0; q < 4; ++q) { float a8[8];
#pragma unroll
          for (int e = 0; e < 4; ++e) { a8[e] = b0[e]; a8[4 + e] = b1[e]; }
#pragma unroll
          for (int j = 0; j < 4; ++j)
#pragma unroll
              for (int e = 0; e < 4; ++e) { a8[e] += w0[j][e] * (float)xr[q + j][e]; a8[4 + e] += w1[j][e] * (float)xr[q + j][4 + e]; }
          h8 o;
#pragma unroll
          for (int e = 0; e < 8; ++e) o[e] = (f16)a8[e];
          *(LAS h8*)(XC + (t0 + q) * XS + 8 * cg) = o; } }
    if (PASS == 1 && tid < 256) {
        const float* ep = ENDS + ((size_t)b * 32) * 512 + tid; float hin = 0.f;
#pragma unroll 8
        for (int cc = 0; cc < ck; ++cc) hin = ep[cc * 512] * hin + ep[cc * 512 + 256];
        HIN[tid] = hin;
    }
    __syncthreads();
    f32x4 ra[4][2], ia[4][2];
#pragma unroll
    for (int m = 0; m < 4; ++m)
#pragma unroll
        for (int n = 0; n < 2; ++n) { ra[m][n] = (f32x4){0.f, 0.f, 0.f, 0.f}; ia[m][n] = (f32x4){0.f, 0.f, 0.f, 0.f}; }
    {
#pragma unroll
      for (int ks = 0; ks < 2; ++ks) { h8 af[4];
#pragma unroll
          for (int m = 0; m < 4; ++m) af[m] = *(const LAS h8*)(XC + (16 * m + fr) * XS + hd * 64 + 32 * ks + 8 * fq);
#pragma unroll
          for (int m = 0; m < 4; ++m)
#pragma unroll
              for (int n = 0; n < 2; ++n) { ra[m][n] = __builtin_amdgcn_mfma_f32_16x16x32_f16(af[m], wa[ks][n], ra[m][n], 0, 0, 0); ia[m][n] = __builtin_amdgcn_mfma_f32_16x16x32_f16(af[m], wx[ks][n], ia[m][n], 0, 0, 0); } } }
    const int ch0 = hd * 64 + half * 32 + fr;
#pragma unroll
    for (int n = 0; n < 2; ++n) { const int chn = ch0 + 16 * n;
        const float lm = c.in[23][l * 256 + chn], sp8 = 8.0f * (fmaxf(-lm, 0.f) + log1pf(__expf(-fabsf(lm)))), ba = c.in[20][l * 256 + chn], bx = c.in[22][l * 256 + chn];
#pragma unroll
        for (int m = 0; m < 4; ++m) { float p = 1.f, hh = 0.f;
#pragma unroll
            for (int e = 0; e < 4; ++e) { const float r = sigm(ra[m][n][e] + ba), ig = sigm(ia[m][n][e] + bx), la = -sp8 * r, a = __expf(la), x2 = 2.0f * la;
                const float em_s = -x2 * (1.0f + x2 * (0.5f + x2 * (0.16666667f + x2 * (0.041666668f + x2 * (0.0083333338f + x2 * 0.0013888889f)))));
                const float em = x2 > -0.5f ? em_s : 1.0f - a * a;
                const float bt = sqrtf(em) * (ig * (float)XC[(16 * m + 4 * fq + e) * XS + chn]);
                p *= a; hh = a * hh + bt; ra[m][n][e] = p; ia[m][n][e] = hh; } } }
    float xp[4][2], xh[4][2], tp[4][2], th[4][2];
#pragma unroll
    for (int m = 0; m < 4; ++m)
#pragma unroll
        for (int n = 0; n < 2; ++n) { const float PT = ra[m][n][3], HT = ia[m][n][3]; float cp = 1.f, chh = 0.f;
#pragma unroll
            for (int k = 0; k < 3; ++k) { const float pk = __shfl(PT, fr + 16 * k), hk = __shfl(HT, fr + 16 * k); if (fq > k) { chh = pk * chh + hk; cp *= pk; } }
            xp[m][n] = cp; xh[m][n] = chh; const float ip = cp * PT, ih = PT * chh + HT; tp[m][n] = __shfl(ip, fr + 48); th[m][n] = __shfl(ih, fr + 48); }
    if (PASS == 0) {
        if (fq == 0) {
#pragma unroll
            for (int n = 0; n < 2; ++n) { float CP = 1.f, CH = 0.f;
#pragma unroll
                for (int m = 0; m < 4; ++m) { CH = tp[m][n] * CH + th[m][n]; CP *= tp[m][n]; }
                float* ep = ENDS + ((size_t)b * 32 + ck) * 512 + ch0 + 16 * n; ep[0] = CP; ep[256] = CH; } }
        __syncthreads();
    } else {
        if (PASS == 2) {
            if (fq == 0) {
#pragma unroll
                for (int n = 0; n < 2; ++n) { float CP = 1.f, CH = 0.f;
#pragma unroll
                    for (int m = 0; m < 4; ++m) { CH = tp[m][n] * CH + th[m][n]; CP *= tp[m][n]; }
                    float* ep = ENDS + ((size_t)b * 32 + ck) * 512 + ch0 + 16 * n;
                    __hip_atomic_store(ep, CP, __ATOMIC_RELAXED, __HIP_MEMORY_SCOPE_AGENT); __hip_atomic_store(ep + 256, CH, __ATOMIC_RELAXED, __HIP_MEMORY_SCOPE_AGENT); } }
            asm volatile("s_waitcnt vmcnt(0)" ::: "memory");
            __syncthreads();
            if (tid == 0) __hip_atomic_store(flags + b * 32 + ck, epoch, __ATOMIC_RELAXED, __HIP_MEMORY_SCOPE_AGENT);
            if (c.wid == 0) { unsigned spins = 0;
                for (;;) { const unsigned v = (lane < ck) ? __hip_atomic_load(flags + b * 32 + (lane & 31), __ATOMIC_RELAXED, __HIP_MEMORY_SCOPE_AGENT) : epoch;
                    if (__all(v >= epoch)) break; __builtin_amdgcn_s_sleep(2); if (++spins > (1u << 22)) break; } }
            __syncthreads();
            if (tid < 256) { const float* ep = ENDS + ((size_t)b * 32) * 512 + tid; float hin = 0.f;
#pragma unroll 8
                for (int cc = 0; cc < ck; ++cc) { const float P = __hip_atomic_load(ep + cc * 512, __ATOMIC_RELAXED, __HIP_MEMORY_SCOPE_AGENT), Hh = __hip_atomic_load(ep + cc * 512 + 256, __ATOMIC_RELAXED, __HIP_MEMORY_SCOPE_AGENT); hin = P * hin + Hh; }
                HIN[tid] = hin; }
            __syncthreads();
        }
        float ssq[4][4];
#pragma unroll
        for (int m = 0; m < 4; ++m)
#pragma unroll
            for (int e = 0; e < 4; ++e) ssq[m][e] = 0.f;
#pragma unroll
        for (int n = 0; n < 2; ++n) { const int chn = ch0 + 16 * n; float hs = HIN[chn];
#pragma unroll
            for (int m = 0; m < 4; ++m) { const float hseg = xp[m][n] * hs + xh[m][n];
#pragma unroll
                for (int e = 0; e < 4; ++e) { const float hv = ra[m][n][e] * hseg + ia[m][n][e]; const float g = (float)GL[(16 * m + 4 * fq + e) * XS + chn];
                    const float u2 = 1.5957691216f * (g + 0.044715f * g * g * g), ov = hv * g * sigm(u2); ia[m][n][e] = ov; ssq[m][e] += ov * ov; }
                hs = tp[m][n] * hs + th[m][n]; } }
#pragma unroll
        for (int m = 0; m < 4; ++m)
#pragma unroll
            for (int e = 0; e < 4; ++e) { float v = ssq[m][e]; v += __shfl_xor(v, 1); v += __shfl_xor(v, 2); v += __shfl_xor(v, 4); v += __shfl_xor(v, 8); if (fr == 0) RP[(16 * m + 4 * fq + e) * 8 + c.wid] = v; }
        __syncthreads();
        if (tid < 64) { float s = 0.f;
#pragma unroll
            for (int w = 0; w < 8; ++w) s += RP[tid * 8 + w];
            RS[tid] = 1.0f / sqrtf(s * (1.0f / 256.0f) + 1e-6f); }
        __syncthreads();
#pragma unroll
        for (int m = 0; m < 4; ++m)
#pragma unroll
            for (int e = 0; e < 4; ++e) { const int t = 16 * m + 4 * fq + e; const float rs = RS[t];
#pragma unroll
                for (int n = 0; n < 2; ++n) XC[t * XS + ch0 + 16 * n] = (f16)(ia[m][n][e] * rs); }
        __syncthreads();
        f16* Y = wsp<f16>(c, WS_Y);
        for (int it = tid; it < 2048; it += 512) { const int t = it >> 5, cg = it & 31; *(h8*)(Y + (n0 + t) * D + 768 + 8 * cg) = *(const LAS h8*)(XC + t * XS + 8 * cg); }
        __syncthreads();
    }
}
template <int PASS> __device__ __forceinline__ void lru_phase(const Ctx& c, int l) {
    for (int u = c.bid; u < 512; u += c.G) lru_unit<PASS>(c, l, u >> 5, u & 31);
}
}

namespace s5 {
typedef _Float16 h8 __attribute__((ext_vector_type(8)));
__device__ __forceinline__ void tables1(const Ctx& c) {
    float* AP = wsp<float>(c, WS_S5AP); float* BB = wsp<float>(c, WS_S5BB);
    for (int it = c.bid * 512 + c.tid; it < DEPTH * 16 * 64; it += c.G * 512) {
        const int p = it & 63, lg = it >> 6;
        const float dt = expf(c.in[14][lg]), are = c.in[7][it], aim = c.in[8][it];
        const float mag = expf(dt * are), abr = mag * cosf(dt * aim), abi = mag * sinf(dt * aim);
        const float den = are * are + aim * aim, nr = abr - 1.0f, ni = abi, fre = (nr * are + ni * aim) / den, fim = (ni * are - nr * aim) / den;
        float pr = 1.0f, pi = 0.0f;
        for (int tau = 0; tau <= 32; ++tau) { AP[((size_t)lg * 33 + tau) * 128 + p] = pr; AP[((size_t)lg * 33 + tau) * 128 + 64 + p] = pi; const float nr2 = pr * abr - pi * abi, ni2 = pr * abi + pi * abr; pr = nr2; pi = ni2; }
        for (int h = 0; h < 16; ++h) { const float br = c.in[9][(size_t)it * 16 + h], bi = c.in[10][(size_t)it * 16 + h];
            BB[((size_t)lg * 64 + p) * 32 + h] = fre * br - fim * bi; BB[((size_t)lg * 64 + p) * 32 + 16 + h] = fre * bi + fim * br; }
    }
}
__device__ __forceinline__ void tables2(const Ctx& c) {
    const float* AP = wsp<float>(c, WS_S5AP); const float* BB = wsp<float>(c, WS_S5BB); float* KK = wsp<float>(c, WS_S5KK);
    f16* WE = wsp<f16>(c, WS_S5WEND); f16* T = wsp<f16>(c, WS_S5T);
    const size_t gt = (size_t)c.bid * 512 + c.tid, GT = (size_t)c.G * 512;
    for (size_t it = gt; it < (size_t)DEPTH * 16 * 32 * 256; it += GT) {
        const int h = (int)(it & 15), hp = (int)((it >> 4) & 15), tau = (int)((it >> 8) & 31), lg = (int)(it >> 13);
        const float* cr = c.in[11] + ((size_t)lg * 16 + hp) * 64; const float* ci = c.in[12] + ((size_t)lg * 16 + hp) * 64;
        const float* ap = AP + ((size_t)lg * 33 + tau) * 128; const float* bb = BB + (size_t)lg * 64 * 32 + h;
        float s = 0.f;
        for (int p = 0; p < 64; ++p) { const float er = cr[p] * ap[p] - ci[p] * ap[64 + p], ei = cr[p] * ap[64 + p] + ci[p] * ap[p]; s += er * bb[p * 32] - ei * bb[p * 32 + 16]; }
        KK[it] = s / expf(c.in[14][lg]);
    }
    for (size_t it = gt; it < (size_t)DEPTH * 16 * 128 * 512; it += GT) {
        const int kk = (int)(it & 511), pp = (int)((it >> 9) & 127), lg = (int)(it >> 16), p = pp & 63, s = kk >> 4, h = kk & 15;
        const float* ap = AP + ((size_t)lg * 33 + (31 - s)) * 128; const float* bb = BB + ((size_t)lg * 64 + p) * 32 + h;
        const float ar = ap[p], ai = ap[64 + p], br = bb[0], bi = bb[16];
        WE[it] = (f16)(((pp < 64) ? (ar * br - ai * bi) : (ar * bi + ai * br)) / expf(c.in[14][lg]));
    }
    for (size_t it = gt; it < (size_t)DEPTH * 16 * 512 * 128; it += GT) {
        const int pp = (int)(it & 127), row = (int)((it >> 7) & 511), lg = (int)(it >> 16), p = pp & 63, t = row >> 4, hp = row & 15;
        const float cr = c.in[11][((size_t)lg * 16 + hp) * 64 + p], ci = c.in[12][((size_t)lg * 16 + hp) * 64 + p];
        const float* ap = AP + ((size_t)lg * 33 + (t + 1)) * 128; const float ar = ap[p], ai = ap[64 + p];
        T[((size_t)lg * 512 + row) * 640 + 512 + pp] = (f16)((pp < 64) ? (cr * ar - ci * ai) : -(cr * ai + ci * ar));
    }
}
__device__ __forceinline__ void tables3(const Ctx& c) {
    const float* KK = wsp<float>(c, WS_S5KK); f16* T = wsp<f16>(c, WS_S5T);
    for (size_t it = (size_t)c.bid * 512 + c.tid; it < (size_t)DEPTH * 16 * 512 * 64; it += (size_t)c.G * 512) {
        const int k8 = (int)(it & 63), row = (int)((it >> 6) & 511), lg = (int)(it >> 15), s = k8 >> 1, h0 = (k8 & 1) * 8, t = row >> 4, hp = row & 15;
        h8 o;
        if (s <= t) { const float* kp = KK + (((size_t)lg * 32 + (t - s)) * 16 + hp) * 16 + h0; const f32x4 a = *(const f32x4*)kp, b = *(const f32x4*)(kp + 4);
#pragma unroll
            for (int e = 0; e < 4; ++e) { o[e] = (f16)a[e]; o[4 + e] = (f16)b[e]; } }
        else {
#pragma unroll
            for (int e = 0; e < 8; ++e) o[e] = (f16)0.f; }
        *(h8*)(T + ((size_t)lg * 512 + row) * 640 + 8 * k8) = o;
    }
}
__device__ __forceinline__ void carry_phase(const Ctx& c, int l) {
    f16* UG = wsp<f16>(c, WS_UG); const f16* WE = wsp<f16>(c, WS_S5WEND) + (size_t)l * 16 * 128 * 512; const float* AP = wsp<float>(c, WS_S5AP);
    int lane = c.lane; asm volatile("" : "+v"(lane));
    const int fr = lane & 15, fq = lane >> 4, tid = c.wid * 64 + lane;
    constexpr int AS = 520;
    LAS f16* AL = (LAS f16*)c.lds;
    LAS float* XL = (LAS float*)(c.lds + 67584);
    for (int u = c.bid; u < 256; u += c.G) { const int g = u >> 4, b = u & 15;
        const f16* arow = UG + ((size_t)g * 1024 + b * 64) * 640; const f16* wrow = WE + ((size_t)g * 128 + c.wid * 16 + fr) * 512;
#pragma unroll
        for (int i = 0; i < 8; ++i) { const int idx = tid + i * 512, r = idx >> 6, cg = idx & 63; *(LAS h8*)(AL + r * AS + 8 * cg) = *(const h8*)(arow + (size_t)r * 640 + 8 * cg); }
        h8 bf[16];
#pragma unroll
        for (int ks = 0; ks < 16; ++ks) bf[ks] = *(const h8*)(wrow + 32 * ks + 8 * fq);
        __syncthreads();
        f32x4 acc[4];
#pragma unroll
        for (int m = 0; m < 4; ++m) acc[m] = (f32x4){0.f, 0.f, 0.f, 0.f};
#pragma unroll
        for (int ks = 0; ks < 16; ++ks) {
#pragma unroll
            for (int m = 0; m < 4; ++m) { const h8 af = *(const LAS h8*)(AL + (16 * m + fr) * AS + 32 * ks + 8 * fq); acc[m] = __builtin_amdgcn_mfma_f32_16x16x32_f16(af, bf[ks], acc[m], 0, 0, 0); } }
#pragma unroll
        for (int m = 0; m < 4; ++m)
#pragma unroll
            for (int e = 0; e < 4; ++e) XL[(16 * m + 4 * fq + e) * 128 + c.wid * 16 + fr] = acc[m][e];
        __syncthreads();
        if (tid < 64) { const float* ap = AP + ((size_t)(l * 16 + g) * 33 + 32) * 128; const float ar = ap[tid], ai = ap[64 + tid]; float xr = 0.f, xi = 0.f;
            f16* xo = UG + ((size_t)g * 1024 + b * 64) * 640 + 512 + tid;
            for (int cc = 0; cc < 64; ++cc) { xo[(size_t)cc * 640] = (f16)xr; xo[(size_t)cc * 640 + 64] = (f16)xi;
                const float lr = XL[cc * 128 + tid], li = XL[cc * 128 + 64 + tid]; const float nr = ar * xr - ai * xi + lr, ni = ar * xi + ai * xr + li; xr = nr; xi = ni; } }
        __syncthreads();
    }
}
}

__device__ __forceinline__ void ph_s5_naive(const Ctx& c, int l) {
    const f16* Z = wsp<f16>(c, WS_Z); f16* YA = wsp<f16>(c, WS_YACT);
    const int gw = c.wid * c.G + c.bid, NGW = c.G * 8, p = c.lane;
    for (int u = gw; u < 256; u += NGW) {
        const int b = u >> 4, g = u & 15;
        const double dt = exp((double)c.in[14][l * 16 + g]);
        const double are = c.in[7][(l * 16 + g) * 64 + p], aim = c.in[8][(l * 16 + g) * 64 + p];
        const double mag = exp(dt * are), abr = mag * cos(dt * aim), abi = mag * sin(dt * aim);
        const double den = are * are + aim * aim, nr = abr - 1.0, ni = abi;
        const double fre = (nr * are + ni * aim) / den, fim = (ni * are - nr * aim) / den;
        float bbr[16], bbi[16], cr[16], ci[16];
#pragma unroll
        for (int h = 0; h < 16; ++h) {
            const double br = c.in[9][((size_t)(l * 16 + g) * 64 + p) * 16 + h], bi = c.in[10][((size_t)(l * 16 + g) * 64 + p) * 16 + h];
            bbr[h] = (float)(fre * br - fim * bi); bbi[h] = (float)(fre * bi + fim * br);
            cr[h] = c.in[11][((size_t)(l * 16 + g) * 16 + h) * 64 + p]; ci[h] = c.in[12][((size_t)(l * 16 + g) * 16 + h) * 64 + p];
        }
        const float ar = (float)abr, ai = (float)abi;
        const float dsk = c.lane < 16 ? c.in[13][l * 256 + g * 16 + c.lane] : 0.f;
        float xr = 0.f, xi = 0.f;
        for (int t = 0; t < SEQ; ++t) {
            const size_t n = (size_t)b * SEQ + t;
            const f16* up = Z + n * DIN + ZU + g * 16; const f16x8 u0 = *(const f16x8*)up, u1 = *(const f16x8*)(up + 8);
            float uu[16];
#pragma unroll
            for (int h = 0; h < 8; ++h) { uu[h] = (float)u0[h]; uu[8 + h] = (float)u1[h]; }
            float br = 0.f, bi = 0.f;
#pragma unroll
            for (int h = 0; h < 16; ++h) { br += bbr[h] * uu[h]; bi += bbi[h] * uu[h]; }
            const float nxr = ar * xr - ai * xi + br, nxi = ar * xi + ai * xr + bi; xr = nxr; xi = nxi;
            float yv = 0.f;
#pragma unroll
            for (int h = 0; h < 16; ++h) { const float s = wave_sum(cr[h] * xr - ci[h] * xi); if (c.lane == h) yv = s; }
            float ul = 0.f;
#pragma unroll
            for (int h = 0; h < 16; ++h) if (c.lane == h) ul = uu[h];
            if (c.lane < 16) YA[n * 256 + g * 16 + c.lane] = (f16)gelu_tanh(yv + dsk * ul);
        }
    }
}
__device__ __forceinline__ void ph_lru_conv(const Ctx& c, int l) {
    const f16* Z = wsp<f16>(c, WS_Z); float* XC = wsp<float>(c, WS_XC);
    const float* cw = c.in[17] + l * 4 * 256; const float* cb = c.in[18] + l * 256;
    for (size_t it = (size_t)c.bid * 512 + c.tid; it < (size_t)NTOK * 256; it += (size_t)c.G * 512) {
        const int ch = (int)(it & 255); const size_t n = it >> 8; const int t = (int)(n & 2047);
        float s = cb[ch];
#pragma unroll
        for (int j = 0; j < 4; ++j) { const int tt = t - 3 + j; if (tt >= 0) s += cw[j * 256 + ch] * (float)Z[(n - 3 + j) * DIN + ZXL + ch]; }
        XC[it] = s;
    }
}
__device__ __forceinline__ void ph_lru_gate(const Ctx& c, int l) {
    const float* XC = wsp<float>(c, WS_XC); float* LA = wsp<float>(c, WS_LA); float* LB = wsp<float>(c, WS_LB);
    const float* wa = c.in[19] + (size_t)l * 4 * 64 * 64; const float* wx = c.in[21] + (size_t)l * 4 * 64 * 64;
    const float* ba = c.in[20] + l * 256; const float* bx = c.in[22] + l * 256; const float* lam = c.in[23] + l * 256;
    for (size_t it = (size_t)c.bid * 512 + c.tid; it < (size_t)NTOK * 256; it += (size_t)c.G * 512) {
        const int ch = (int)(it & 255), hd = ch >> 6, j = ch & 63; const size_t n = it >> 8;
        const float* xp = XC + n * 256 + hd * 64; const float* wap = wa + (size_t)hd * 4096 + j; const float* wxp = wx + (size_t)hd * 4096 + j;
        float sa = ba[ch], sx = bx[ch];
        for (int i = 0; i < 64; ++i) { const float xv = xp[i]; sa += xv * wap[i * 64]; sx += xv * wxp[i * 64]; }
        const float r = sigmoidf_(sa), ig = sigmoidf_(sx);
        const float lm = lam[ch], sp = fmaxf(-lm, 0.f) + log1pf(expf(-fabsf(lm)));
        const float log_a = -8.0f * r * sp;
        LA[it] = expf(log_a); LB[it] = sqrtf(-expm1f(2.0f * log_a)) * (ig * XC[it]);
    }
}
__device__ __forceinline__ void ph_lru_scan(const Ctx& c) {
    const f16* Z = wsp<f16>(c, WS_Z); const float* LA = wsp<float>(c, WS_LA); const float* LB = wsp<float>(c, WS_LB); f16* Y = wsp<f16>(c, WS_Y);
    for (int it = c.bid * 512 + c.tid; it < BATCH * 256; it += c.G * 512) {
        const int ch = it & 255, b = it >> 8; float h = 0.f;
        for (int t = 0; t < SEQ; ++t) { const size_t n = (size_t)b * SEQ + t;
            h = LA[n * 256 + ch] * h + LB[n * 256 + ch];
            Y[n * D + 768 + ch] = (f16)(h * gelu_tanh((float)Z[n * DIN + ZGL + ch])); }
    }
}
__device__ __forceinline__ void ph_norm_attn(const Ctx& c) {
    f16* Y = wsp<f16>(c, WS_Y);
    int r0, r1;
    if (c.bid < 128) { const int w = c.bid * 8 + c.wid; r0 = w * 16; r1 = r0 + 16; } else { const int w = (c.bid - 128) * 8 + c.wid; r0 = 16384 + w * 16; r1 = r0 + 16; }
    if (c.G != 256) { const int w = c.bid * 8 + c.wid, per = (NTOK + c.G * 8 - 1) / (c.G * 8); r0 = w * per; r1 = r0 + per < NTOK ? r0 + per : NTOK; }
    for (int m = r0; m < r1; ++m) { f16* rp = Y + (size_t)m * D + 8 * c.lane; const f16x8 v = *(const f16x8*)rp; float s = 0.f;
#pragma unroll
        for (int i = 0; i < 8; ++i) s += (float)v[i] * (float)v[i];
        const float ra = 1.0f / sqrtf(wave_sum(s) * (1.0f / 512.0f) + 1e-6f); f16x8 o;
#pragma unroll
        for (int i = 0; i < 8; ++i) o[i] = (f16)((float)v[i] * ra);
        *(f16x8*)rp = o; }
}
__device__ __forceinline__ void ph_ln_inplace(const Ctx& c, const float* g, const float* b) {
    f16* H = wsp<f16>(c, WS_H); const int gw = c.wid * c.G + c.bid, NGW = c.G * 8;
    float gg[16], bb[16]; vec_load16(g, c.lane, gg); vec_load16(b, c.lane, bb);
    for (int m = gw * 4; m < NTOK; m += NGW * 4) {
        float v[4][16];
#pragma unroll
        for (int r = 0; r < 4; ++r) row_load16(H + (size_t)(m + r) * D, c.lane, v[r]);
        ln_rows<4>(v, gg, bb);
#pragma unroll
        for (int r = 0; r < 4; ++r) row_store16(H + (size_t)(m + r) * D, c.lane, v[r]);
    }
}
__device__ __forceinline__ void ph_xattn_naive(const Ctx& c, int l) {
    const f16* QX = wsp<f16>(c, WS_QX); const f16* KM = wsp<f16>(c, WS_KM) + (size_t)l * NMEM * D; const f16* VM = wsp<f16>(c, WS_VM) + (size_t)l * NMEM * D;
    f16* OC = wsp<f16>(c, WS_OC);
    LAS float* pl = (LAS float*)c.lds + c.wid * 256;
    const int gw = c.bid * 8 + c.wid, NGW = c.G * 8;
    for (int it = gw; it < NTOK * 4; it += NGW) {
        const int hh = it & 3; const size_t n = (size_t)(it >> 2); const int b = (int)(n >> 11);
        const f16* qp = QX + n * D + hh * 256; const f16* kb = KM + (size_t)b * 256 * D + hh * 256; const f16* vb = VM + (size_t)b * 256 * D + hh * 256;
        float s[4] = {0.f, 0.f, 0.f, 0.f};
        for (int d8 = 0; d8 < 32; ++d8) { const f16x8 qv = *(const f16x8*)(qp + 8 * d8);
#pragma unroll
            for (int kk = 0; kk < 4; ++kk) { const f16x8 kv = *(const f16x8*)(kb + (size_t)(c.lane + 64 * kk) * D + 8 * d8);
#pragma unroll
                for (int j = 0; j < 8; ++j) s[kk] += (float)qv[j] * (float)kv[j]; } }
        const float mx = wave_max(fmaxf(fmaxf(s[0], s[1]), fmaxf(s[2], s[3])));
        float ps = 0.f;
#pragma unroll
        for (int kk = 0; kk < 4; ++kk) { s[kk] = exp2f(s[kk] - mx); ps += s[kk]; }
        const float rl = 1.0f / wave_sum(ps);
#pragma unroll
        for (int kk = 0; kk < 4; ++kk) pl[c.lane + 64 * kk] = s[kk] * rl;
        asm volatile("s_waitcnt lgkmcnt(0)" ::: "memory");
        float o[4] = {0.f, 0.f, 0.f, 0.f};
        for (int key = 0; key < 256; ++key) { const float p = pl[key]; const f16x4 vv = *(const f16x4*)(vb + (size_t)key * D + 4 * c.lane);
#pragma unroll
            for (int j = 0; j < 4; ++j) o[j] += p * (float)vv[j]; }
        f16x4 ov;
#pragma unroll
        for (int j = 0; j < 4; ++j) ov[j] = (f16)o[j];
        *(f16x4*)(OC + n * D + hh * 256 + 4 * c.lane) = ov;
        asm volatile("s_waitcnt lgkmcnt(0)" ::: "memory");
    }
}
__device__ __forceinline__ void ph_ln2_route(const Ctx& c, int l) {
    typedef _Float16 h8 __attribute__((ext_vector_type(8)));
    f16* H = wsp<f16>(c, WS_H); int* TE = wsp<int>(c, WS_TOKE); float* TW = wsp<float>(c, WS_TOKW); int* HIST = wsp<int>(c, WS_HIST);
    const float* wrg = c.in[32] + (size_t)l * D * 4; const float* brg = c.in[33] + l * 4; const float* wre = c.in[34] + (size_t)l * D * 16; const float* bre = c.in[35] + l * 16;
    constexpr int WS_ = 1032;
    LAS f16* WR = (LAS f16*)c.lds;
    LAS float* LG = (LAS float*)(c.lds + 66560) + c.wid * 512;
    LAS int* hl = (LAS int*)(c.lds + 66560 + 16384);
    int lane = c.lane; asm volatile("" : "+v"(lane));
    const int fr = lane & 15, fq = lane >> 4;
    for (int k = c.tid; k < D; k += 512) { const f32x4 g4 = *(const f32x4*)(wrg + (size_t)k * 4);
        const f32x4 e0 = *(const f32x4*)(wre + (size_t)k * 16), e1 = *(const f32x4*)(wre + (size_t)k * 16 + 4), e2 = *(const f32x4*)(wre + (size_t)k * 16 + 8), e3 = *(const f32x4*)(wre + (size_t)k * 16 + 12);
#pragma unroll
        for (int o = 0; o < 4; ++o) { WR[o * WS_ + k] = (f16)g4[o]; WR[(4 + o) * WS_ + k] = (f16)e0[o]; WR[(8 + o) * WS_ + k] = (f16)e1[o]; WR[(12 + o) * WS_ + k] = (f16)e2[o]; WR[(16 + o) * WS_ + k] = (f16)e3[o]; }
#pragma unroll
        for (int o = 20; o < 32; ++o) WR[o * WS_ + k] = (f16)0.f; }
    if (c.tid < 16) hl[c.tid] = 0;
    float gg[16], bb[16]; vec_load16(c.in[30] + l * D, lane, gg); vec_load16(c.in[31] + l * D, lane, bb);
    __syncthreads();
    for (int blk = c.bid; blk < NTOK / 128; blk += c.G) {
        const int m0 = blk * 128 + c.wid * 16;
#pragma unroll 1
        for (int r = 0; r < 16; r += 4) { float v[4][16];
#pragma unroll
            for (int q = 0; q < 4; ++q) row_load16(H + (size_t)(m0 + r + q) * D, lane, v[q]);
            ln_rows<4>(v, gg, bb);
#pragma unroll
            for (int q = 0; q < 4; ++q) row_store16(H + (size_t)(m0 + r + q) * D, lane, v[q]); }
        asm volatile("s_waitcnt vmcnt(0)" ::: "memory");
        f32x4 acc[2] = {(f32x4){0.f, 0.f, 0.f, 0.f}, (f32x4){0.f, 0.f, 0.f, 0.f}};
        const f16* arow = H + (size_t)(m0 + fr) * D + 8 * fq;
#pragma unroll 8
        for (int ks = 0; ks < 32; ++ks) { const h8 af = *(const h8*)(arow + 32 * ks);
            const h8 b0 = *(const LAS h8*)(WR + fr * WS_ + 32 * ks + 8 * fq), b1 = *(const LAS h8*)(WR + (16 + fr) * WS_ + 32 * ks + 8 * fq);
            acc[0] = __builtin_amdgcn_mfma_f32_16x16x32_f16(af, b0, acc[0], 0, 0, 0); acc[1] = __builtin_amdgcn_mfma_f32_16x16x32_f16(af, b1, acc[1], 0, 0, 0); }
#pragma unroll
        for (int e = 0; e < 4; ++e) { LG[(4 * fq + e) * 32 + fr] = acc[0][e]; LG[(4 * fq + e) * 32 + 16 + fr] = acc[1][e]; }
        asm volatile("s_waitcnt lgkmcnt(0)" ::: "memory");
        if (lane < 16) { const int m = m0 + lane; float lg[20];
#pragma unroll
            for (int q = 0; q < 5; ++q) { const f32x4 t4 = *(const LAS f32x4*)(LG + lane * 32 + 4 * q); lg[4 * q] = t4[0]; lg[4 * q + 1] = t4[1]; lg[4 * q + 2] = t4[2]; lg[4 * q + 3] = t4[3]; }
            float gl[4];
#pragma unroll
            for (int o = 0; o < 4; ++o) gl[o] = lg[o] + brg[o];
            int gi = 0; float gmax = gl[0];
#pragma unroll
            for (int o = 1; o < 4; ++o) if (gl[o] > gmax) { gmax = gl[o]; gi = o; }
            float gs = 0.f;
#pragma unroll
            for (int o = 0; o < 4; ++o) gs += expf(gl[o] - gmax);
            const float gw_ = 1.0f / gs;
            float el[4];
#pragma unroll
            for (int o = 0; o < 4; ++o) { float x = 0.f;
#pragma unroll
                for (int g = 0; g < 4; ++g) if (g == gi) x = lg[4 + 4 * g + o] + bre[4 * g + o];
                el[o] = x; }
            int i1 = 0; float v1 = el[0];
#pragma unroll
            for (int o = 1; o < 4; ++o) if (el[o] > v1) { v1 = el[o]; i1 = o; }
            int i2 = -1; float v2 = 0.f;
#pragma unroll
            for (int o = 0; o < 4; ++o) if (o != i1 && (i2 < 0 || el[o] > v2)) { i2 = o; v2 = el[o]; }
            const float p2 = expf(v2 - v1), w1 = gw_ / (1.0f + p2), w2 = gw_ * p2 / (1.0f + p2);
            const int e1 = gi * 4 + i1, e2 = gi * 4 + i2;
            TE[2 * m] = e1; TE[2 * m + 1] = e2; TW[2 * m] = w1; TW[2 * m + 1] = w2;
            atomicAdd((int*)(hl + e1), 1); atomicAdd((int*)(hl + e2), 1);
        }
        __syncthreads();
        if (c.tid < 16) { HIST[blk * 16 + c.tid] = hl[c.tid]; hl[c.tid] = 0; }
        __syncthreads();
    }
}
__device__ __forceinline__ void ph_lists(const Ctx& c) {
    const int* TE = wsp<int>(c, WS_TOKE); const float* TW = wsp<float>(c, WS_TOKW); const int* HIST = wsp<int>(c, WS_HIST);
    int* RT = wsp<int>(c, WS_ROWTOK); float* RW = wsp<float>(c, WS_ROWW); int* TX = wsp<int>(c, WS_TILEEXP); int* RSRC = wsp<int>(c, WS_ROWSRC);
    LAS int* sh = (LAS int*)c.lds;
    for (int blk = c.bid; blk < NTOK / 128; blk += c.G) {
        { const int e = c.tid & 15, part = c.tid >> 4; int cnt = 0, before = 0;
          for (int i = 0; i < 8; ++i) { const int b2 = part * 8 + i; const int hv = HIST[b2 * 16 + e]; cnt += hv; if (b2 < blk) before += hv; }
          sh[512 + part * 16 + e] = cnt; sh[1024 + part * 16 + e] = before; }
        int my_e = -1, my_rank = 0; float my_w = 0.f;
        if (c.tid < 256) { my_e = TE[blk * 256 + c.tid]; my_w = TW[blk * 256 + c.tid]; }
        if (c.wid < 4) {
            const unsigned long long lt = (c.lane == 0) ? 0ull : (~0ull >> (64 - c.lane));
#pragma unroll
            for (int ee = 0; ee < 16; ++ee) { const unsigned long long m = __ballot(my_e == ee); if (my_e == ee) my_rank = __popcll(m & lt); if (c.lane == 0) sh[64 + c.wid * 16 + ee] = __popcll(m); }
        }
        __syncthreads();
        if (c.tid < 16) { int cnt = 0, before = 0; for (int p = 0; p < 32; ++p) { cnt += sh[512 + p * 16 + c.tid]; before += sh[1024 + p * 16 + c.tid]; } sh[c.tid] = cnt; sh[32 + c.tid] = before; }
        __syncthreads();
        if (c.tid < 16) { int off = 0; for (int e = 0; e < 16; ++e) { if (e == c.tid) break; off += (sh[e] + 255) & ~255; } sh[16 + c.tid] = off; }
        __syncthreads();
        if (c.tid < 256) { int pos = sh[16 + my_e] + sh[32 + my_e] + my_rank;
            for (int w = 0; w < 4; ++w) if (w < c.wid) pos += sh[64 + w * 16 + my_e];
            RT[pos] = blk * 256 + c.tid; RW[pos] = my_w; RSRC[pos] = blk * 128 + (c.tid >> 1); }
        if (blk < 16 && c.tid >= 256) { const int e = blk, cnt = sh[e], pad = ((cnt + 255) & ~255) - cnt, i = c.tid - 256; if (i < pad) { RT[sh[16 + e] + cnt + i] = -1; RW[sh[16 + e] + cnt + i] = 0.f; RSRC[sh[16 + e] + cnt + i] = 0; } }
        if (blk == 0 && c.tid == 0) { int nt = 0; for (int e = 0; e < 16; ++e) { const int k = (sh[e] + 255) >> 8; for (int i = 0; i < k; ++i) TX[1 + nt + i] = e; nt += k; } TX[0] = nt; }
        __syncthreads();
    }
}
__device__ __forceinline__ void ph_final(const Ctx& c, int l) {
    f16* H = wsp<f16>(c, WS_H); const f16* YS = wsp<f16>(c, WS_YS); const int gw = c.wid * c.G + c.bid, NGW = c.G * 8;
    float gg[16], bb[16]; vec_load16(c.in[39] + l * D, c.lane, gg); vec_load16(c.in[40] + l * D, c.lane, bb);
    for (int m = gw * 2; m < NTOK; m += NGW * 2) {
        float v[2][16];
#pragma unroll
        for (int r = 0; r < 2; ++r) { float a[16], b[16]; row_load16_nt(H + (size_t)(m + r) * D, c.lane, v[r]); row_load16_nt(YS + (size_t)(2 * (m + r)) * D, c.lane, a); row_load16_nt(YS + (size_t)(2 * (m + r) + 1) * D, c.lane, b);
#pragma unroll
            for (int i = 0; i < 16; ++i) v[r][i] = ALPHA * v[r][i] + (a[i] + b[i]); }
        ln_rows<2>(v, gg, bb);
#pragma unroll
        for (int r = 0; r < 2; ++r) {
            if (l == DEPTH - 1) { float* o = c.out + (size_t)(m + r) * D;
                __builtin_nontemporal_store((f32x4){v[r][0], v[r][1], v[r][2], v[r][3]}, (f32x4*)(o + 8 * c.lane)); __builtin_nontemporal_store((f32x4){v[r][4], v[r][5], v[r][6], v[r][7]}, (f32x4*)(o + 8 * c.lane + 4));
                __builtin_nontemporal_store((f32x4){v[r][8], v[r][9], v[r][10], v[r][11]}, (f32x4*)(o + 512 + 8 * c.lane)); __builtin_nontemporal_store((f32x4){v[r][12], v[r][13], v[r][14], v[r][15]}, (f32x4*)(o + 512 + 8 * c.lane + 4));
            } else row_store16(H + (size_t)(m + r) * D, c.lane, v[r]); }
    }
}

constexpr int CW_Q = 8192;
__device__ __forceinline__ void b2_queue(const Ctx& c, int l, unsigned* ctr, volatile LAS unsigned* slot) {
    for (;;) {
        if (c.tid == 0) slot[0] = __hip_atomic_fetch_add(ctr, 1u, __ATOMIC_RELAXED, __HIP_MEMORY_SCOPE_AGENT);
        __syncthreads();
        const int idx = (int)slot[0];
        __syncthreads();
        if (idx >= 1536) break;
        if (idx < 16 * att::ATT_NBIG) { const int cb = att::ATT_ORDER[idx >> 4]; att::attn_unit(c, idx & 15, cb >> 3, cb & 7); }
        else if (idx < 16 * att::ATT_NBIG + 512) { const int u = idx - 16 * att::ATT_NBIG; lru::lru_unit<2>(c, l, u >> 5, u & 31); }
        else { const int k = idx - 512; const int cb = att::ATT_ORDER[k >> 4]; att::attn_unit(c, k & 15, cb >> 3, cb & 7); }
    }
}

constexpr int PH_PRO = 0, PH_L0 = 1, PL = 12, NPHASE = PH_L0 + DEPTH * PL;
enum { L_WIN = 0, L_B1, L_B2, L_GLU, L_WOUT, L_WQ, L_WO, L_LN2R, L_LISTS, L_MOE1, L_MOE2, L_FIN };

struct Args { const float* in[41]; float* out; unsigned char* ws; int ph_lo, ph_hi; };

__global__ void __launch_bounds__(512, 2) fwd_kernel(Args args) {
    extern __shared__ __attribute__((aligned(16))) unsigned char lds_raw[];
    Ctx c0;
    c0.in = args.in;
    c0.out = args.out; c0.ws = args.ws; c0.lds = (LAS unsigned char*)lds_raw;
    c0.tid = threadIdx.x; c0.lane = c0.tid & 63; c0.wid = __builtin_amdgcn_readfirstlane(c0.tid >> 6); c0.G = gridDim.x; c0.bid = blockIdx.x;
    volatile LAS unsigned* MISC = (volatile LAS unsigned*)(c0.lds + MISC_OFF);
    if (c0.tid < 32) MISC[c0.tid] = 0u;
    __syncthreads();
    XcdBarrier bar; bar.bar = (unsigned*)(c0.ws + WS_CTL) + CW_BAR; bar.x = 0; bar.st = nullptr;
    const int lo = args.ph_lo, hi = args.ph_hi;
    const bool multi = (hi - lo) > 1;
    if (multi) bar = xcd_barrier_post((unsigned*)(c0.ws + WS_CTL) + CW_BAR, MISC + 8);
#define IN(k) (lo <= (k) && (k) < hi)
#define SEAM(k) do { if (IN(k) && IN((k) + 1)) xcd_barrier(bar); } while (0)
#define GEMM(EPI, SCHED, g, S, E) pg8::gemm_phase<EPI, SCHED, true, true>(c.lds, g, S, E, c.tid)

    if (IN(PH_PRO)) { const Ctx c = fresh(c0); s5::tables1(c); ph_conv(c); ph_ln0(c); } SEAM(PH_PRO);
#define LAYER_BODY(l) do {         const int P0 = PH_L0 + l * PL; \
        if (IN(P0 + L_WIN)) for (int rep_ = 0; rep_ < REPS(L_WIN); ++rep_) { if (rep_) __syncthreads(); const Ctx c = fresh(c0); \
            if (l == 0) { s5::tables2(c); ph_fold_vectors(c); } \
            if (c.bid >= 128) { LAS float* scr = (LAS float*)(c.lds + c.wid * 16384);       \
                for (int it = (c.bid - 128) * 8 + c.wid; it < MOE_CONV_ITEMS; it += 128 * 8) conv_moe_item(c, l, it, scr); } \
            __syncthreads(); \
            pg8::Gemm g{(const f16*)c.ws, (const f16*)c.ws, D, D, D}; pg8::WinKvOrder S; S.so.init(NTOK, DIN, c.G, c.bid); S.lay = l; \
            pg8::EWinKv E{pg8::EStoreWin{wsp<f16>(c, WS_Z), wsp<f16>(c, WS_UG)}, pg8::EStoreKV2{wsp<f16>(c, WS_KM), wsp<f16>(c, WS_VM)}}; GEMM(pg8::EWinKv, pg8::WinKvOrder, g, S, E); } \
        SEAM(P0 + L_WIN); \
        if (IN(P0 + L_B1)) for (int rep_ = 0; rep_ < REPS(L_B1); ++rep_) { if (rep_) __syncthreads(); const Ctx c = fresh(c0); if (l == 0) s5::tables3(c); ph_kmean(c); s5::carry_phase(c, l); } \
        SEAM(P0 + L_B1); \
        if (IN(P0 + L_B2)) for (int rep_ = 0; rep_ < REPS(L_B2); ++rep_) { if (rep_) __syncthreads(); const Ctx c = fresh(c0); \
            { pg8::Gemm g{wsp<f16>(c, WS_UG), wsp<f16>(c, WS_S5T) + (size_t)l * 16 * 512 * 640, 640, 640, 640}; pg8::S5Order S{c.G, c.bid}; \
              pg8::ES5 E{wsp<f16>(c, WS_UG), wsp<f16>(c, WS_YACT), c.in[13] + l * 256, c.in[14] + l * 16}; GEMM(pg8::ES5, pg8::S5Order, g, S, E); } \
            __syncthreads(); \
            b2_queue(c, l, (unsigned*)(c.ws + WS_CTL) + CW_Q + 64 * (l * 4 + rep_), MISC + 16); } \
        SEAM(P0 + L_B2); \
        if (IN(P0 + L_GLU)) for (int rep_ = 0; rep_ < REPS(L_GLU); ++rep_) { if (rep_) __syncthreads(); const Ctx c = fresh(c0); \
            pg8::Gemm g{wsp<f16>(c, WS_YACT), wsp<f16>(c, WS_WGLU_T) + (size_t)l * 256 * 256, 256, 256, 256}; pg8::StaticOrder S; S.init(NTOK, 256, c.G, c.bid); \
            pg8::EGlu E{wsp<f16>(c, WS_YACT), c.in[16] + l * 256, wsp<f16>(c, WS_Y), (LAS float*)(c.lds + 132096)}; GEMM(pg8::EGlu, pg8::StaticOrder, g, S, E); \
            __syncthreads(); \
            { pg8::Gemm g2{(const f16*)c.ws, (const f16*)c.ws, 256, D, D}; pg8::PreOrder S2{c.G, c.bid, l}; pg8::EStorePre E2{wsp<f16>(c, WS_MT)}; GEMM(pg8::EStorePre, pg8::PreOrder, g2, S2, E2); } \
            ph_norm_attn(c); } \
        SEAM(P0 + L_GLU); \
        if (IN(P0 + L_WOUT)) { const Ctx c = fresh(c0); \
            ph_fold_x(c, l); __syncthreads(); \
            pg8::Gemm g{wsp<f16>(c, WS_Y), wsp<f16>(c, WS_WOUT_T) + (size_t)l * D * D, D, D, D}; pg8::StaticOrder S; S.init(NTOK, D, c.G, c.bid); \
            pg8::EResidStats E{wsp<f16>(c, WS_H), wsp<float>(c, WS_STATS1), (LAS float*)(c.lds + 132096)}; GEMM(pg8::EResidStats, pg8::StaticOrder, g, S, E); } \
        SEAM(P0 + L_WOUT); \
        if (IN(P0 + L_WQ)) { const Ctx c = fresh(c0); \
            pg8::Gemm g{wsp<f16>(c, WS_H), (const f16*)c.ws, D, D, D}; pg8::BatchBOrder S; S.so.init(NTOK, D, c.G, c.bid); S.bbase = (unsigned)WS_MT; \
            pg8::ESoftmaxLN E{wsp<f16>(c, WS_P), (LAS float*)(c.lds + 132096), wsp<float>(c, WS_STATS1), wsp<float>(c, WS_S1X), wsp<float>(c, WS_S2X)}; GEMM(pg8::ESoftmaxLN, pg8::BatchBOrder, g, S, E); } \
        SEAM(P0 + L_WQ); \
        if (IN(P0 + L_WO)) { const Ctx c = fresh(c0); \
            pg8::Gemm g{wsp<f16>(c, WS_P), (const f16*)c.ws, D, D, D}; pg8::BatchBOrder S; S.so.init(NTOK, D, c.G, c.bid); S.bbase = (unsigned)WS_NT; \
            pg8::EResidLN E{wsp<f16>(c, WS_H), wsp<float>(c, WS_STATS1), c.in[24] + l * D, c.in[25] + l * D}; GEMM(pg8::EResidLN, pg8::BatchBOrder, g, S, E); } \
        SEAM(P0 + L_WO); \
        if (IN(P0 + L_LN2R)) for (int rep_ = 0; rep_ < REPS(L_LN2R); ++rep_) { if (rep_) __syncthreads(); const Ctx c = fresh(c0); ph_ln2_route(c, l); } \
        SEAM(P0 + L_LN2R); \
        if (IN(P0 + L_LISTS)) for (int rep_ = 0; rep_ < REPS(L_LISTS); ++rep_) { if (rep_) __syncthreads(); const Ctx c = fresh(c0); ph_lists(c); } \
        SEAM(P0 + L_LISTS); \
        if (IN(P0 + L_MOE1)) for (int rep_ = 0; rep_ < REPS(L_MOE1); ++rep_) { if (rep_) __syncthreads(); const Ctx c = fresh(c0); \
            pg8::Gemm g{wsp<f16>(c, WS_H), wsp<f16>(c, WS_WGU_T), D, D, D, wsp<int>(c, WS_ROWSRC)}; pg8::MoeOrder S; S.init(wsp<int>(c, WS_TILEEXP), 2, c.G, c.bid); \
            pg8::ESiluMul E{wsp<f16>(c, WS_HE)}; pg8::gemm_phase<pg8::ESiluMul, pg8::MoeOrder, true, true, true>(c.lds, g, S, E, c.tid); } \
        SEAM(P0 + L_MOE1); \
        if (IN(P0 + L_MOE2)) for (int rep_ = 0; rep_ < REPS(L_MOE2); ++rep_) { if (rep_) __syncthreads(); const Ctx c = fresh(c0); \
            pg8::Gemm g{wsp<f16>(c, WS_HE), wsp<f16>(c, WS_WD_T), DEXP, DEXP, DEXP}; pg8::MoeOrder S; S.init(wsp<int>(c, WS_TILEEXP), 4, c.G, c.bid); \
            pg8::EScatter E{wsp<int>(c, WS_ROWTOK), wsp<float>(c, WS_ROWW), wsp<f16>(c, WS_YS)}; GEMM(pg8::EScatter, pg8::MoeOrder, g, S, E); } \
        SEAM(P0 + L_MOE2); \
        if (IN(P0 + L_FIN)) for (int rep_ = 0; rep_ < REPS(L_FIN); ++rep_) { if (rep_) __syncthreads(); const Ctx c = fresh(c0); ph_final(c, l); } \
        if (l + 1 < DEPTH) SEAM(P0 + L_FIN); \
     } while (0)
    LAYER_BODY(0);
    LAYER_BODY(1);
#undef LAYER_BODY
#undef IN
#undef SEAM
#undef GEMM
}

extern "C" void kernel_launch(void* const* d_in, const int* in_sizes, int n_in, void* d_out, int out_size, void* d_ws, size_t ws_size, hipStream_t stream) {
    static int grid = 0;
    if (grid == 0) {
        if (n_in != 41 || out_size != NTOK * D || ws_size < WS_END) { fprintf(stderr, "kernel_launch: unexpected problem (n_in %d out %d ws %zu)\n", n_in, out_size, ws_size); grid = -1; return; }
        if (hipFuncSetAttribute((const void*)fwd_kernel, hipFuncAttributeMaxDynamicSharedMemorySize, LDS_BYTES) != hipSuccess) { fprintf(stderr, "kernel_launch: hipFuncSetAttribute failed\n"); grid = -1; return; }
        int dev = 0, cus = 0, per_cu = 0;
        hipGetDevice(&dev); hipDeviceGetAttribute(&cus, hipDeviceAttributeMultiprocessorCount, dev);
        hipOccupancyMaxActiveBlocksPerMultiprocessor(&per_cu, (const void*)fwd_kernel, 512, LDS_BYTES);
        (void)hipGetLastError();
        if (per_cu < 1) fprintf(stderr, "kernel_launch: occupancy query says %d\n", per_cu);
        grid = cus > 256 ? 256 : cus;
        if (grid != 256) fprintf(stderr, "kernel_launch: grid %d != 256\n", grid);
    }
    if (grid < 0) return;
    hipMemsetAsync((char*)d_ws + WS_CTL, 0, CTL_ZERO_BYTES, stream);
    Args a{};
    for (int i = 0; i < 41; ++i) a.in[i] = (const float*)d_in[i];
    a.out = (float*)d_out; a.ws = (unsigned char*)d_ws;
#if MK_ONE_LAUNCH
    a.ph_lo = 0; a.ph_hi = NPHASE;
    hipLaunchKernelGGL(fwd_kernel, dim3(grid), dim3(512), LDS_BYTES, stream, a);
#else
    for (int p = 0; p < NPHASE; ++p) { a.ph_lo = p; a.ph_hi = p + 1; hipLaunchKernelGGL(fwd_kernel, dim3(grid), dim3(512), LDS_BYTES, stream, a); }
#endif
}
```

```cpp
#include <hip/hip_runtime.h>
#include <cstdio>
#include <cstdint>

#ifndef MK_ONE_LAUNCH
#define MK_ONE_LAUNCH 1
#endif
#ifndef PROBE_REP
#define PROBE_REP -1
#endif
#ifndef PROBE_N
#define PROBE_N 2
#endif
#define REPS(k) (((k) == PROBE_REP) ? (PROBE_N + 1) : 1)

typedef _Float16 f16;
typedef _Float16 f16x8 __attribute__((ext_vector_type(8)));
typedef _Float16 f16x4 __attribute__((ext_vector_type(4)));
typedef float f32x4 __attribute__((ext_vector_type(4)));
#define LAS __attribute__((address_space(3)))
#define GAS __attribute__((address_space(1)))
typedef GAS unsigned gu32;

constexpr int BATCH = 16, SEQ = 2048, NTOK = BATCH * SEQ, D = 1024, DIN = 2304, DEPTH = 2;
constexpr int MEMLEN = 256, NMEM = BATCH * MEMLEN;
constexpr int ZQ = 0, ZK = 512, ZV = 1024, ZU = 1536, ZXL = 1792, ZGL = 2048;
constexpr int NEXP = 16, DEXP = 256;
constexpr float ALPHA = 1.4142135623730951f;
constexpr float LOG2E = 1.4426950408889634f;
constexpr float QSCALE = 0.125f * LOG2E;
constexpr float XQSCALE = 0.0625f * LOG2E;
constexpr int MOE_MAXROWS = 2 * NTOK + NEXP * 256;

constexpr size_t MiB = 1u << 20;
constexpr size_t WS_CTL = 0, CTL_ZERO_BYTES = 64 * 1024;
constexpr size_t WS_KMEAN = 1 * MiB;
constexpr size_t WS_TOKE = 2 * MiB;
constexpr size_t WS_TOKW = 3 * MiB;
constexpr size_t WS_HIST = 4 * MiB;
constexpr size_t WS_ROWTOK = 5 * MiB;
constexpr size_t WS_ROWW = 6 * MiB;
constexpr size_t WS_TILEEXP = 7 * MiB;
constexpr size_t WS_ROWSRC = 9 * MiB;
constexpr size_t WS_S1Q = 10 * MiB, WS_S2Q = 10 * MiB + 64 * 1024;
constexpr size_t WS_STATS1 = 11 * MiB;
constexpr size_t WS_LRUENDS = 8 * MiB;
constexpr size_t WS_MEM16 = 16 * MiB;
constexpr size_t WS_KM = 24 * MiB;
constexpr size_t WS_VM = 40 * MiB;
constexpr size_t WS_H = 56 * MiB;
constexpr size_t WS_WREG = 120 * MiB;
constexpr size_t WS_S5AP = 120 * MiB, WS_S5BB = 121 * MiB, WS_S5KK = 122 * MiB, WS_S5WEND = 124 * MiB, WS_S5T = 128 * MiB, WS_UG = 152 * MiB;
constexpr size_t WS_XC = 120 * MiB;
constexpr size_t WS_LA = 152 * MiB;
constexpr size_t WS_LB = 184 * MiB;
constexpr size_t WS_ARENA = 280 * MiB;
constexpr size_t WS_Z = WS_ARENA;
constexpr size_t WS_Y = WS_ARENA + 144 * MiB;
constexpr size_t WS_YACT = WS_ARENA + 208 * MiB;
constexpr size_t WS_QX = WS_ARENA;
constexpr size_t WS_P = WS_ARENA + 64 * MiB;
constexpr size_t WS_OC = WS_ARENA + 128 * MiB;
constexpr size_t WS_YS = WS_ARENA;
constexpr size_t WS_XG = WS_ARENA;
constexpr size_t WS_HE = WS_ARENA + 136 * MiB;
constexpr size_t WS_END = 512 * MiB;
static_assert(WS_HE + (size_t)MOE_MAXROWS * 256 * 2 <= WS_END && WS_YACT + (size_t)NTOK * 256 * 2 <= WS_END, "ws map");

constexpr size_t WS_W = 216 * MiB;
constexpr size_t WS_WQN = WS_W + 56 * MiB;
constexpr size_t WS_MT = WS_ARENA, WS_NT = WS_ARENA + 32 * MiB;
constexpr size_t WS_S1X = 10 * MiB + 128 * 1024, WS_S2X = 10 * MiB + 256 * 1024;
static_assert(WS_WQN + 4 * MiB <= WS_ARENA, "wqn");
constexpr size_t WS_WIN_T = WS_W, WS_WOUT_T = WS_W + 9 * MiB, WS_WQ_T = WS_W + 13 * MiB, WS_WKV_T = WS_W + 17 * MiB, WS_WO_T = WS_W + 25 * MiB, WS_WGLU_T = WS_W + 29 * MiB, WS_WLA_T = WS_W + 29 * MiB + 512 * 1024, WS_WLX_T = WS_W + 29 * MiB + 768 * 1024, WS_WGU_T = WS_W + 30 * MiB, WS_WD_T = WS_W + 46 * MiB;
static_assert(WS_WD_T + (size_t)NEXP * D * DEXP * 2 <= WS_ARENA, "weights region");
constexpr int CW_BAR = 4096;

constexpr int LDS_BYTES = 147456;
constexpr int MISC_OFF = 131072 + 320;

#define XB_TMO      128
#define XB_XCNT(j)  (256  + 64 * (j))
#define XB_XSUB(j)  (1280 + 64 * (j))
#define XB_XGEN(j)  (2304 + 64 * (j))
#define XB_TOP      3328
#define XB_TOPGEN   3392
#define XCD_BAR_WORDS 3456
#define XB_SPIN_CAP (1u << 18)

__device__ __forceinline__ unsigned xb_ld(unsigned* p)              { return __hip_atomic_load(p, __ATOMIC_RELAXED, __HIP_MEMORY_SCOPE_AGENT); }
__device__ __forceinline__ unsigned xb_add(unsigned* p, unsigned v) { return __hip_atomic_fetch_add(p, v, __ATOMIC_RELAXED, __HIP_MEMORY_SCOPE_AGENT); }
__device__ __forceinline__ unsigned xb_xcc_id() { return (unsigned)__builtin_amdgcn_s_getreg((3 << 11) | 20) & 0xFu; }
#define XB_SPIN(cond, bar) do { unsigned _sp = 0; while (cond) { __builtin_amdgcn_s_sleep(1); \
    if ((++_sp & 255u) == 0u) { if (xb_ld(&(bar)[XB_TMO])) break; if (_sp > XB_SPIN_CAP) { atomicAdd(&(bar)[XB_TMO], 1u); break; } } } } while (0)

struct XcdBarrier { unsigned* bar; unsigned x; volatile LAS unsigned* st; };

__device__ __forceinline__ XcdBarrier xcd_barrier_post(unsigned* bar, volatile LAS unsigned* st) {
    XcdBarrier b; b.bar = bar; b.x = xb_xcc_id(); b.st = st;
    if (threadIdx.x == 0) (void)xb_add(&bar[XB_XCNT(b.x)], 1u);
    return b;
}
__device__ __forceinline__ void xcd_barrier_complete(unsigned* bar, unsigned x, unsigned& nloc, unsigned& nx) {
    const unsigned G = gridDim.x * gridDim.y * gridDim.z;
    unsigned sum, cnt, mine, sp = 0u;
    for (;;) {
        sum = 0u; cnt = 0u; mine = 0u;
#pragma unroll
        for (unsigned j = 0; j < 16; ++j) { const unsigned c = xb_ld(&bar[XB_XCNT(j)]); sum += c; cnt += (c > 0u) ? 1u : 0u; mine = (j == x) ? c : mine; }
        if (sum == G) break;
        __builtin_amdgcn_s_sleep(1);
        if ((++sp & 255u) == 0u) { if (xb_ld(&bar[XB_TMO])) break; if (sp > XB_SPIN_CAP) { atomicAdd(&bar[XB_TMO], 1u); break; } }
    }
    nloc = mine > 0u ? mine : 1u; nx = cnt > 0u ? cnt : 1u;
}
__device__ __forceinline__ void xcd_barrier(const XcdBarrier& b) {
    asm volatile("s_waitcnt vmcnt(0)" ::: "memory");
    __syncthreads();
    if (threadIdx.x == 0) {
        unsigned* bar = b.bar;
        __builtin_amdgcn_s_waitcnt(0);
        unsigned nloc = b.st[0], nx = b.st[1];
        if (nloc == 0u) { xcd_barrier_complete(bar, b.x, nloc, nx); b.st[0] = nloc; b.st[1] = nx; }
        const unsigned old = xb_add(&bar[XB_XSUB(b.x)], 1u);
        const unsigned gen = old / nloc;
        if (old + 1u == (gen + 1u) * nloc) {
            __builtin_amdgcn_fence(__ATOMIC_RELEASE, "agent");
            asm volatile("s_waitcnt vmcnt(0)" ::: "memory");
            const unsigned og = xb_add(&bar[XB_TOP], 1u);
            const unsigned tg = og / nx;
            if (og + 1u == (tg + 1u) * nx) xb_add(&bar[XB_TOPGEN], 1u);
            else XB_SPIN(xb_ld(&bar[XB_TOPGEN]) == tg, bar);
            __builtin_amdgcn_fence(__ATOMIC_ACQUIRE, "agent");
            xb_add(&bar[XB_XGEN(b.x)], 1u);
            asm volatile("s_waitcnt vmcnt(0)" ::: "memory");
        } else {
            XB_SPIN(xb_ld(&bar[XB_XGEN(b.x)]) == gen, bar);
            __builtin_amdgcn_fence(__ATOMIC_ACQUIRE, "agent");
            asm volatile("s_waitcnt vmcnt(0)" ::: "memory");
        }
    }
    __syncthreads();
}

__device__ __forceinline__ float wave_sum(float v) {
#pragma unroll
    for (int o = 1; o < 64; o <<= 1) v += __shfl_xor(v, o);
    return v;
}
__device__ __forceinline__ float wave_max(float v) {
#pragma unroll
    for (int o = 1; o < 64; o <<= 1) v = fmaxf(v, __shfl_xor(v, o));
    return v;
}
__device__ __forceinline__ float gelu_tanh(float x) {
    const float u = 0.7978845608028654f * (x + 0.044715f * x * x * x);
    return 0.5f * x * (1.0f + tanhf(u));
}
__device__ __forceinline__ float sigmoidf_(float x) { return 1.0f / (1.0f + expf(-x)); }

struct Ctx {
    const float* const* in;
    float* out;
    unsigned char* ws;
    LAS unsigned char* lds;
    int tid, lane, wid, G, bid;
};
template <class T> __device__ __forceinline__ T* wsp(const Ctx& c, size_t off) { return (T*)(c.ws + off); }
__device__ __forceinline__ Ctx fresh(const Ctx& c0) { Ctx c = c0; asm volatile("" : "+v"(c.tid)); c.lane = c.tid & 63; unsigned long long z = 0ull; asm volatile("" : "+s"(z)); c.ws = c.ws + z;
    asm volatile("" : "+s"(c.bid), "+s"(c.G), "+s"(c.wid)); return c; }

__device__ __forceinline__ void row_load16(const f16* row, int lane, float (&v)[16]) {
    const f16x8 a = *(const f16x8*)(row + 8 * lane), b = *(const f16x8*)(row + 512 + 8 * lane);
#pragma unroll
    for (int i = 0; i < 8; ++i) { v[i] = (float)a[i]; v[8 + i] = (float)b[i]; }
}
__device__ __forceinline__ void row_store16(f16* row, int lane, const float (&v)[16]) {
    f16x8 a, b;
#pragma unroll
    for (int i = 0; i < 8; ++i) { a[i] = (f16)v[i]; b[i] = (f16)v[8 + i]; }
    *(f16x8*)(row + 8 * lane) = a; *(f16x8*)(row + 512 + 8 * lane) = b;
}
__device__ __forceinline__ void vec_load16(const float* p, int lane, float (&v)[16]) {
    const f32x4 a0 = *(const f32x4*)(p + 8 * lane), a1 = *(const f32x4*)(p + 8 * lane + 4), b0 = *(const f32x4*)(p + 512 + 8 * lane), b1 = *(const f32x4*)(p + 512 + 8 * lane + 4);
#pragma unroll
    for (int i = 0; i < 4; ++i) { v[i] = a0[i]; v[4 + i] = a1[i]; v[8 + i] = b0[i]; v[12 + i] = b1[i]; }
}
__device__ __forceinline__ void row_load16_nt(const f16* row, int lane, float (&v)[16]) {
    const f16x8 a = __builtin_nontemporal_load((const f16x8*)(row + 8 * lane)), b = __builtin_nontemporal_load((const f16x8*)(row + 512 + 8 * lane));
#pragma unroll
    for (int i = 0; i < 8; ++i) { v[i] = (float)a[i]; v[8 + i] = (float)b[i]; }
}
__device__ __forceinline__ void vec_load16_nt(const float* p, int lane, float (&v)[16]) {
    const f32x4 a0 = __builtin_nontemporal_load((const f32x4*)(p + 8 * lane)), a1 = __builtin_nontemporal_load((const f32x4*)(p + 8 * lane + 4)), b0 = __builtin_nontemporal_load((const f32x4*)(p + 512 + 8 * lane)), b1 = __builtin_nontemporal_load((const f32x4*)(p + 512 + 8 * lane + 4));
#pragma unroll
    for (int i = 0; i < 4; ++i) { v[i] = a0[i]; v[4 + i] = a1[i]; v[8 + i] = b0[i]; v[12 + i] = b1[i]; }
}
__device__ __forceinline__ void ln_row(float (&v)[16], const float* g, const float* b, int lane) {
    float s = 0.f;
#pragma unroll
    for (int i = 0; i < 16; ++i) s += v[i];
    const float mu = wave_sum(s) * (1.0f / 1024.0f);
    float q = 0.f;
#pragma unroll
    for (int i = 0; i < 16; ++i) { v[i] -= mu; q += v[i] * v[i]; }
    const float rstd = 1.0f / sqrtf(wave_sum(q) * (1.0f / 1024.0f) + 1e-5f);
    float gg[16], bb[16]; vec_load16(g, lane, gg); vec_load16(b, lane, bb);
#pragma unroll
    for (int i = 0; i < 16; ++i) v[i] = v[i] * rstd * gg[i] + bb[i];
}

namespace pg8 {
#define PG8_LAS __attribute__((address_space(3)))
typedef _Float16 bf16_t;
typedef _Float16 bf16x8 __attribute__((ext_vector_type(8)));
typedef float f32x4 __attribute__((ext_vector_type(4)));
typedef unsigned u32x4 __attribute__((ext_vector_type(4)));
constexpr int BM = 256, BK = 64, HALF = 128, HTB = HALF * BK * 2  , STAGE_BYTES = 8 * HTB, NXCD = 8, WGM = 8;

__host__ __device__ __forceinline__ int lds_byte(int r, int c) { const int st = (r >> 4) * 2 + (c >> 5), rr = r & 15, cc = c & 31, ob = rr * 64 + cc * 2; return st * 1024 + (ob ^ (((ob >> 9) & 1) << 5)); }
__host__ __device__ __forceinline__ void stage_rc(int b, int& R, int& C) { const int st = b / 1024, sb = b % 1024, swz = sb ^ (((sb >> 9) & 1) << 5); R = (st >> 1) * 16 + swz / 64; C = (st & 1) * 32 + (swz % 64) / 2; }
__host__ __device__ __forceinline__ int perm32(int rho) { const int n = rho >> 4, i = rho & 15; return 8 * (i >> 2) + 4 * n + (i & 3); }

struct Unit { int pm, pn; unsigned aoff, boff; int tag; int nt; };
struct Gemm { const bf16_t* A; const bf16_t* Bt; int K, lda, ldb; const int* arow = nullptr; };

struct StaticOrder {
    int nM, nN, nwg, G, c;
    __host__ __device__ void init(int M, int N, int G_, int c_) { nM = M / BM; nN = N / BM; nwg = nM * nN; G = G_; c = c_; }
    __host__ __device__ bool next(int i, Unit& u) const {
        const long L = (long)i * G + c; if (L >= nwg) return false;
        int wgid = (int)L; { const int q = nwg / NXCD, r = nwg % NXCD, xcd = wgid % NXCD, off = wgid / NXCD; wgid = (xcd < r ? xcd * (q + 1) : r * (q + 1) + (xcd - r) * q) + off; }
        const int nig = WGM * nN, gid = wgid / nig, fm = gid * WGM, gsz = (nM - fm) < WGM ? (nM - fm) : WGM;
        u.pm = fm + ((wgid % nig) % gsz); u.pn = (wgid % nig) / gsz; u.aoff = 0; u.boff = 0; u.tag = 0; u.nt = 0; return true;
    }
    __device__ __forceinline__ void a_ready(const Unit&) const {}
    __device__ __forceinline__ void done(const Unit&) const {}
};
template <class Epi, class Sched, bool ALIGN_EPI = false, bool SP2 = false, bool GATHER = false>
__device__ __forceinline__ void gemm_phase(PG8_LAS unsigned char* lds, const Gemm g, const Sched& S, const Epi& E, const int tid) {
    const int wid = __builtin_amdgcn_readfirstlane(tid >> 6), lane = tid & 63, wr = wid >> 2, wc = wid & 3, fr = lane & 15, fq = lane >> 4;
    const int ntg = g.K / BK; int nt = ntg;
    unsigned voffA[2], voffB[2];
#pragma unroll
    for (int i = 0; i < 2; ++i) { int R, C; stage_rc(tid * 16 + i * 8192, R, C); const int Rb = Epi::PERM ? ((R & ~31) + perm32(R & 31)) : R;
        voffA[i] = (unsigned)(R * g.lda + C) * 2u; voffB[i] = (unsigned)(Rb * g.ldb + C) * 2u; }
    const unsigned kstep = (unsigned)(BK * 2);
    const unsigned hstepA = (unsigned)HALF * g.lda * 2u, hstepB = (unsigned)HALF * g.ldb * 2u;
    static_assert(!GATHER || SP2, "GATHER is written for the SP2 loop only");
    const unsigned tstepA = GATHER ? 0u : 2u * hstepA, tstepB = 2u * hstepB;
    const unsigned ldsw = (unsigned)wid * 1024u;
    const int aoff = lds_byte(wr * 64 + fr, fq * 8), boff = lds_byte(wc * 32 + fr, fq * 8);
#define PG8_SA(b, h) (((b) * 2 + (h)) * HTB)
#define PG8_SB(b, h) ((4 + (b) * 2 + (h)) * HTB)
#define PG8_STAGE(bufoff, gbase, voff) do { _Pragma("unroll") for (int _i = 0; _i < 2; ++_i) \
        __builtin_amdgcn_global_load_lds((const unsigned*)((const char*)(gbase) + (voff)[_i]), (PG8_LAS unsigned*)(lds + (bufoff) + ldsw + _i * 8192), 16, 0, 0); } while (0)
#define PG8_STAGE_A(b, h, gbase, usenext) do { if constexpr (GATHER) { if (usenext) PG8_STAGE(PG8_SA(b, h), gbase, (h) ? nv1 : nv0); else PG8_STAGE(PG8_SA(b, h), gbase, (h) ? vo1 : vo0); } \
        else PG8_STAGE(PG8_SA(b, h), (gbase) + ((h) ? hstepA : 0u), voffA); } while (0)
#define PG8_LOADVO(u, o0, o1) do { _Pragma("unroll") for (int _i = 0; _i < 2; ++_i) { int R_, C_; stage_rc(tid * 16 + _i * 8192, R_, C_); \
        o0[_i] = (unsigned)g.arow[(u).pm * BM + R_] * (unsigned)(g.lda * 2) + (unsigned)C_ * 2u; o1[_i] = (unsigned)g.arow[(u).pm * BM + HALF + R_] * (unsigned)(g.lda * 2) + (unsigned)C_ * 2u; } } while (0)
    unsigned vo0[2] = {0u, 0u}, vo1[2] = {0u, 0u}, nv0[2] = {0u, 0u}, nv1[2] = {0u, 0u};
#define PG8_LDA(dst, b, h) do { _Pragma("unroll") for (int m = 0; m < 4; ++m) _Pragma("unroll") for (int k = 0; k < 2; ++k) dst[m][k] = *(const PG8_LAS bf16x8*)(lds + PG8_SA(b, h) + aoff + m * 2048 + k * 1024); } while (0)
#define PG8_LDB(dst, b, h) do { _Pragma("unroll") for (int n = 0; n < 2; ++n) _Pragma("unroll") for (int k = 0; k < 2; ++k) dst[n][k] = *(const PG8_LAS bf16x8*)(lds + PG8_SB(b, h) + boff + n * 2048 + k * 1024); } while (0)
#define PG8_MMA(ai, bj, At, Bt) do { __builtin_amdgcn_s_setprio(1); _Pragma("unroll") for (int m = 0; m < 4; ++m) _Pragma("unroll") for (int n = 0; n < 2; ++n) _Pragma("unroll") for (int k = 0; k < 2; ++k) \
        acc[ai][bj][m][n] = __builtin_amdgcn_mfma_f32_16x16x32_f16(Bt[n][k], At[m][k], acc[ai][bj][m][n], 0, 0, 0); __builtin_amdgcn_s_setprio(0); } while (0)
#define PG8_WAIT_V(n) asm volatile("s_waitcnt vmcnt(" #n ")" ::: "memory")
#define PG8_WAIT_L(n) asm volatile("s_waitcnt lgkmcnt(" #n ")" ::: "memory")
#define PG8_BAR __builtin_amdgcn_s_barrier()
#define PG8_SCHED __builtin_amdgcn_sched_barrier(0)
    Unit cur, nxt; int ui = 0;
    if (!S.next(0, cur)) return;
    nt = cur.nt ? cur.nt : ntg;
    f32x4 acc[2][2][4][2];
#pragma unroll
    for (int a = 0; a < 2; ++a)
#pragma unroll
        for (int b = 0; b < 2; ++b)
#pragma unroll
            for (int m = 0; m < 4; ++m)
#pragma unroll
                for (int n = 0; n < 2; ++n) acc[a][b][m][n] = (f32x4){0.f, 0.f, 0.f, 0.f};
    bf16x8 At[4][2], B0[2][2], B1[2][2];
    const char* cA = (const char*)g.A + (size_t)cur.pm * tstepA + cur.aoff; const char* cB = (const char*)g.Bt + (size_t)cur.pn * tstepB + cur.boff;
    S.a_ready(cur);
    if constexpr (SP2) {
        if constexpr (GATHER) PG8_LOADVO(cur, vo0, vo1);
        PG8_STAGE(PG8_SB(0, 0), cB, voffB); PG8_STAGE(PG8_SB(0, 1), cB + hstepB, voffB); PG8_STAGE_A(0, 0, cA, false); PG8_STAGE_A(0, 1, cA, false);
        if (wr == 1) PG8_BAR;
        PG8_WAIT_V(2); PG8_BAR;
        PG8_STAGE(PG8_SB(1, 0), cB + kstep, voffB); PG8_STAGE_A(1, 0, cA + kstep, false); PG8_STAGE(PG8_SB(1, 1), cB + hstepB + kstep, voffB);
        PG8_WAIT_V(6); PG8_BAR;
    } else {
        PG8_STAGE(PG8_SB(0, 0), cB, voffB); PG8_STAGE(PG8_SA(0, 0), cA, voffA); PG8_STAGE(PG8_SB(0, 1), cB + hstepB, voffB); PG8_STAGE(PG8_SA(0, 1), cA + hstepA, voffA);
        if (wr == 1) PG8_BAR;
        PG8_WAIT_V(4); PG8_BAR;
        PG8_STAGE(PG8_SB(1, 0), cB + kstep, voffB); PG8_STAGE(PG8_SA(1, 0), cA + kstep, voffA); PG8_STAGE(PG8_SB(1, 1), cB + hstepB + kstep, voffB);
        PG8_WAIT_V(6); PG8_BAR;
    }
    for (;;) {
        const bool has_next = S.next(ui + 1, nxt);
        if constexpr (GATHER) { if (has_next) PG8_LOADVO(nxt, nv0, nv1); else { nv0[0] = vo0[0]; nv0[1] = vo0[1]; nv1[0] = vo1[0]; nv1[1] = vo1[1]; } }
        const char* nA = has_next ? (const char*)g.A + (size_t)nxt.pm * tstepA + nxt.aoff : cA; const char* nB = has_next ? (const char*)g.Bt + (size_t)nxt.pn * tstepB + nxt.boff : cB;
#pragma nounroll
        for (int t = 0; t < nt; t += 2) {
            const bool last = (t == nt - 2);
            const char* a1 = cA + (size_t)(t + 1) * kstep;
            const char* a2 = last ? nA : cA + (size_t)(t + 2) * kstep; const char* b2 = last ? nB : cB + (size_t)(t + 2) * kstep;
            const char* a3 = a2 + kstep; const char* b3 = b2 + kstep;
            if (last && has_next) S.a_ready(nxt);
            if constexpr (SP2) {
            PG8_LDB(B0, 0, 0); PG8_LDB(B1, 0, 1); PG8_SCHED; PG8_LDA(At, 0, 0); PG8_STAGE_A(1, 1, a1, false);
            PG8_WAIT_V(8); PG8_WAIT_L(0); PG8_BAR; PG8_MMA(0, 0, At, B0); PG8_MMA(0, 1, At, B1); PG8_BAR; PG8_SCHED;
            PG8_LDA(At, 0, 1); PG8_STAGE(PG8_SB(0, 0), b2, voffB); PG8_STAGE(PG8_SB(0, 1), b2 + hstepB, voffB); PG8_STAGE_A(0, 0, a2, last);
            PG8_WAIT_V(8); PG8_WAIT_L(0); PG8_BAR; PG8_MMA(1, 0, At, B0); PG8_MMA(1, 1, At, B1); PG8_BAR; PG8_SCHED;
            PG8_LDB(B0, 1, 0); PG8_LDB(B1, 1, 1); PG8_SCHED; PG8_LDA(At, 1, 0); PG8_STAGE_A(0, 1, a2, last);
            PG8_WAIT_V(8); PG8_WAIT_L(0); PG8_BAR; PG8_MMA(0, 0, At, B0); PG8_MMA(0, 1, At, B1); PG8_BAR; PG8_SCHED;
            PG8_LDA(At, 1, 1); PG8_STAGE(PG8_SB(1, 0), b3, voffB); PG8_STAGE(PG8_SB(1, 1), b3 + hstepB, voffB); PG8_STAGE_A(1, 0, a3, last);
            PG8_WAIT_V(8); PG8_WAIT_L(0); PG8_BAR; PG8_MMA(1, 0, At, B0); PG8_MMA(1, 1, At, B1); PG8_BAR; PG8_SCHED;
            } else {
            PG8_LDB(B0, 0, 0); PG8_SCHED; PG8_LDA(At, 0, 0); PG8_STAGE(PG8_SA(1, 1), a1 + hstepA, voffA);
            PG8_WAIT_L(8); PG8_BAR; PG8_WAIT_L(0); PG8_MMA(0, 0, At, B0); PG8_BAR; PG8_SCHED;
            PG8_LDB(B1, 0, 1); PG8_STAGE(PG8_SB(0, 0), b2, voffB);
            PG8_BAR; PG8_WAIT_L(0); PG8_MMA(0, 1, At, B1); PG8_BAR;
            PG8_LDA(At, 0, 1); PG8_STAGE(PG8_SA(0, 0), a2, voffA);
            PG8_BAR; PG8_WAIT_L(0); PG8_MMA(1, 0, At, B0); PG8_BAR; PG8_SCHED;
            PG8_STAGE(PG8_SB(0, 1), b2 + hstepB, voffB);
            PG8_WAIT_V(6); PG8_BAR; PG8_MMA(1, 1, At, B1); PG8_BAR;
            PG8_LDB(B0, 1, 0); PG8_SCHED; PG8_LDA(At, 1, 0); PG8_STAGE(PG8_SA(0, 1), a2 + hstepA, voffA);
            PG8_WAIT_L(8); PG8_BAR; PG8_WAIT_L(0); PG8_MMA(0, 0, At, B0); PG8_BAR; PG8_SCHED;
            PG8_LDB(B1, 1, 1); PG8_STAGE(PG8_SB(1, 0), b3, voffB);
            PG8_BAR; PG8_WAIT_L(0); PG8_MMA(0, 1, At, B1); PG8_BAR;
            PG8_LDA(At, 1, 1); PG8_STAGE(PG8_SA(1, 0), a3, voffA);
            PG8_BAR; PG8_WAIT_L(0); PG8_MMA(1, 0, At, B0); PG8_BAR; PG8_SCHED;
            PG8_STAGE(PG8_SB(1, 1), b3 + hstepB, voffB);
            PG8_WAIT_V(6); PG8_BAR; PG8_MMA(1, 1, At, B1); PG8_BAR;
            }
        }
        if constexpr (ALIGN_EPI) { if (wr == 0) PG8_BAR; }
        if constexpr (!Epi::AFTER_DRAIN) { E(acc, cur, wr, wc, fr, fq); S.done(cur); }
        if (!has_next) break;
#pragma unroll
        for (int a = 0; a < 2; ++a)
#pragma unroll
            for (int b = 0; b < 2; ++b)
#pragma unroll
                for (int m = 0; m < 4; ++m)
#pragma unroll
                    for (int n = 0; n < 2; ++n) acc[a][b][m][n] = (f32x4){0.f, 0.f, 0.f, 0.f};
        cur = nxt; cA = nA; cB = nB; ++ui; nt = cur.nt ? cur.nt : ntg;
        if constexpr (GATHER) { vo0[0] = nv0[0]; vo0[1] = nv0[1]; vo1[0] = nv1[0]; vo1[1] = nv1[1]; }
        if constexpr (ALIGN_EPI) { if (wr == 1) PG8_BAR; }
    }
    PG8_WAIT_V(0);
    if constexpr (!ALIGN_EPI) { if (wr == 0) PG8_BAR; }
    PG8_BAR;
    if constexpr (Epi::AFTER_DRAIN) { E.fused(acc, cur, wr, wc, fr, fq, lds, wid, lane); S.done(cur); }
#undef PG8_SA
#undef PG8_SB
#undef PG8_STAGE
#undef PG8_STAGE_A
#undef PG8_LOADVO
#undef PG8_LDA
#undef PG8_LDB
#undef PG8_MMA
#undef PG8_WAIT_V
#undef PG8_WAIT_L
#undef PG8_BAR
#undef PG8_SCHED
}
}
namespace pg8 {
#define PG8_EPI_ROWS(...) \
    _Pragma("unroll") for (int ai = 0; ai < 2; ++ai) _Pragma("unroll") for (int m = 0; m < 4; ++m) { const int rt = ai * HALF + wr * 64 + m * 16 + fr; __VA_ARGS__ }
__device__ __forceinline__ bf16x8 pack8(const f32x4 a, const f32x4 b) { bf16x8 o; o[0] = (bf16_t)a[0]; o[1] = (bf16_t)a[1]; o[2] = (bf16_t)a[2]; o[3] = (bf16_t)a[3]; o[4] = (bf16_t)b[0]; o[5] = (bf16_t)b[1]; o[6] = (bf16_t)b[2]; o[7] = (bf16_t)b[3]; return o; }
struct EStore { static constexpr bool PERM = true, AFTER_DRAIN = false; bf16_t* C; int ldc;
    __device__ __forceinline__ void operator()(const f32x4 (&acc)[2][2][4][2], const Unit& u, int wr, int wc, int fr, int fq) const {
        PG8_EPI_ROWS( bf16_t* rp = C + (size_t)(u.pm * BM + rt) * ldc + u.pn * BM + wc * 32 + 8 * fq;
            _Pragma("unroll") for (int bj = 0; bj < 2; ++bj) *(bf16x8*)(rp + bj * HALF) = pack8(acc[ai][bj][m][0], acc[ai][bj][m][1]); ) } };
struct EStoreKV { static constexpr bool PERM = true, AFTER_DRAIN = false; bf16_t* KM; bf16_t* VM;
    __device__ __forceinline__ void operator()(const f32x4 (&acc)[2][2][4][2], const Unit& u, int wr, int wc, int fr, int fq) const {
        const int mat = u.pn >> 2, j = u.pn & 3; bf16_t* C = KM + (size_t)(mat & 1) * ((WS_VM - WS_KM) / 2) + (size_t)(mat >> 1) * NMEM * D;
        PG8_EPI_ROWS( bf16_t* rp = C + (size_t)(u.pm * BM + rt) * D + j * BM + wc * 32 + 8 * fq;
            _Pragma("unroll") for (int bj = 0; bj < 2; ++bj) *(bf16x8*)(rp + bj * HALF) = pack8(acc[ai][bj][m][0], acc[ai][bj][m][1]); ) } };
struct EResid { static constexpr bool PERM = true, AFTER_DRAIN = false; bf16_t* H;
    __device__ __forceinline__ void operator()(const f32x4 (&acc)[2][2][4][2], const Unit& u, int wr, int wc, int fr, int fq) const {
        PG8_EPI_ROWS( bf16_t* rp = H + (size_t)(u.pm * BM + rt) * D + u.pn * BM + wc * 32 + 8 * fq;
            _Pragma("unroll") for (int bj = 0; bj < 2; ++bj) { const bf16x8 h = *(const bf16x8*)(rp + bj * HALF); f32x4 a = acc[ai][bj][m][0], b = acc[ai][bj][m][1];
                _Pragma("unroll") for (int e = 0; e < 4; ++e) { a[e] += ALPHA * (float)h[e]; b[e] += ALPHA * (float)h[4 + e]; }
                *(bf16x8*)(rp + bj * HALF) = pack8(a, b); } ) } };
struct EResidStats { static constexpr bool PERM = true, AFTER_DRAIN = false; bf16_t* H; float* ST; PG8_LAS float* X;
    __device__ __forceinline__ void operator()(f32x4 (&acc)[2][2][4][2], const Unit& u, int wr, int wc, int fr_, int fq) const {
        int fr = fr_; asm volatile("" : "+v"(fr));
        bf16x8 hv[2][4][2];
        PG8_EPI_ROWS( const bf16_t* rp = H + (size_t)(u.pm * BM + rt) * D + u.pn * BM + wc * 32 + 8 * fq;
            _Pragma("unroll") for (int bj = 0; bj < 2; ++bj) hv[ai][m][bj] = *(const bf16x8*)(rp + bj * HALF); )
        PG8_EPI_ROWS( bf16_t* rp = H + (size_t)(u.pm * BM + rt) * D + u.pn * BM + wc * 32 + 8 * fq; float sm = 0.f, sq = 0.f;
            _Pragma("unroll") for (int bj = 0; bj < 2; ++bj) { const bf16x8 h = hv[ai][m][bj]; f32x4 a = acc[ai][bj][m][0], b = acc[ai][bj][m][1];
                _Pragma("unroll") for (int e = 0; e < 4; ++e) { a[e] += ALPHA * (float)h[e]; b[e] += ALPHA * (float)h[4 + e]; sm += a[e] + b[e]; sq += a[e] * a[e] + b[e] * b[e]; }
                *(bf16x8*)(rp + bj * HALF) = pack8(a, b); }
            sm += __shfl_xor(sm, 16); sm += __shfl_xor(sm, 32); sq += __shfl_xor(sq, 16); sq += __shfl_xor(sq, 32);
            if (fq == 0) { X[(rt * 4 + wc) * 2] = sm; X[(rt * 4 + wc) * 2 + 1] = sq; } )
        asm volatile("s_waitcnt lgkmcnt(0)\n\ts_barrier" ::: "memory");
        { const int t = wr * 0 + (int)(threadIdx.x);
          if (t < 256) { const f32x4 p0 = *(const PG8_LAS f32x4*)(X + t * 8), p1 = *(const PG8_LAS f32x4*)(X + t * 8 + 4);
              float* o = ST + ((size_t)(u.pm * BM + t) * 4 + u.pn) * 2; o[0] = (p0[0] + p0[2]) + (p1[0] + p1[2]); o[1] = (p0[1] + p0[3]) + (p1[1] + p1[3]); } }
    } };
__device__ __forceinline__ void ln_stats4(const float* ST, size_t row, float& mu, float& rstd) {
    const f32x4 p0 = *(const f32x4*)(ST + row * 8), p1 = *(const f32x4*)(ST + row * 8 + 4);
    const float S = (p0[0] + p0[2]) + (p1[0] + p1[2]), Q = (p0[1] + p0[3]) + (p1[1] + p1[3]); mu = S * (1.0f / 1024.0f);
    const float var = fmaxf(Q * (1.0f / 1024.0f) - mu * mu, 0.f); rstd = 1.0f / sqrtf(var + 1e-5f); }
struct EStoreLN { static constexpr bool PERM = true, AFTER_DRAIN = false; bf16_t* C; int ldc; const float* ST; const float* s1; const float* s2;
    __device__ __forceinline__ void operator()(const f32x4 (&acc)[2][2][4][2], const Unit& u, int wr, int wc, int fr, int fq) const {
        const int c0 = u.pn * BM + wc * 32 + 8 * fq;
        f32x4 s1v[2][2], s2v[2][2]; float rsv[2][4], mrv[2][4];
        _Pragma("unroll") for (int bj = 0; bj < 2; ++bj) { const int col = c0 + bj * HALF; s1v[bj][0] = *(const f32x4*)(s1 + col); s1v[bj][1] = *(const f32x4*)(s1 + col + 4); s2v[bj][0] = *(const f32x4*)(s2 + col); s2v[bj][1] = *(const f32x4*)(s2 + col + 4); }
        PG8_EPI_ROWS( const size_t row = (size_t)(u.pm * BM + rt); float mu, rs; ln_stats4(ST, row, mu, rs); rsv[ai][m] = rs; mrv[ai][m] = -mu * rs; )
        PG8_EPI_ROWS( const size_t row = (size_t)(u.pm * BM + rt); const float rs = rsv[ai][m], mr = mrv[ai][m];
            _Pragma("unroll") for (int bj = 0; bj < 2; ++bj) { const int col = c0 + bj * HALF;
                f32x4 a = acc[ai][bj][m][0], b = acc[ai][bj][m][1];
                _Pragma("unroll") for (int e = 0; e < 4; ++e) { a[e] = rs * a[e] + (mr * s1v[bj][0][e] + s2v[bj][0][e]); b[e] = rs * b[e] + (mr * s1v[bj][1][e] + s2v[bj][1][e]); }
                *(bf16x8*)(C + row * ldc + col) = pack8(a, b); } ) } };
struct EResidLN { static constexpr bool PERM = true, AFTER_DRAIN = false; bf16_t* H; const float* ST; const float* g; const float* b;
    __device__ __forceinline__ void operator()(const f32x4 (&acc)[2][2][4][2], const Unit& u, int wr, int wc, int fr, int fq) const {
        const int c0 = u.pn * BM + wc * 32 + 8 * fq;
        float muv[2][4], rsv[2][4];
        PG8_EPI_ROWS( const size_t row = (size_t)(u.pm * BM + rt); float mu, rs; ln_stats4(ST, row, mu, rs); muv[ai][m] = mu; rsv[ai][m] = rs * ALPHA; )
        _Pragma("unroll") for (int bj = 0; bj < 2; ++bj) { const int col = c0 + bj * HALF; bf16x8 hv[2][4];
            const f32x4 g0 = *(const f32x4*)(g + col), g1 = *(const f32x4*)(g + col + 4), b0 = *(const f32x4*)(b + col), b1 = *(const f32x4*)(b + col + 4);
            PG8_EPI_ROWS( hv[ai][m] = *(const bf16x8*)(H + (size_t)(u.pm * BM + rt) * D + col); )
            PG8_EPI_ROWS( const float mu = muv[ai][m], rs = rsv[ai][m]; const bf16x8 h = hv[ai][m]; f32x4 a = acc[ai][bj][m][0], bq = acc[ai][bj][m][1];
                _Pragma("unroll") for (int e = 0; e < 4; ++e) { a[e] += ((float)h[e] - mu) * rs * g0[e] + ALPHA * b0[e]; bq[e] += ((float)h[4 + e] - mu) * rs * g1[e] + ALPHA * b1[e]; }
                *(bf16x8*)(H + (size_t)(u.pm * BM + rt) * D + col) = pack8(a, bq); ) } } };
struct EGlu { static constexpr bool PERM = true, AFTER_DRAIN = false; const bf16_t* yact; const float* bg; bf16_t* Y; PG8_LAS float* X;
    __device__ __forceinline__ void operator()(f32x4 (&acc)[2][2][4][2], const Unit& u, int wr, int wc, int fr_, int fq) const {
        int fr = fr_; asm volatile("" : "+v"(fr));
        bf16x8 yv[2][4][2]; f32x4 bv[2][2];
        _Pragma("unroll") for (int bj = 0; bj < 2; ++bj) { const int col = bj * HALF + wc * 32 + 8 * fq; bv[bj][0] = *(const f32x4*)(bg + col); bv[bj][1] = *(const f32x4*)(bg + col + 4); }
        PG8_EPI_ROWS( const size_t row = (size_t)(u.pm * BM + rt);
            _Pragma("unroll") for (int bj = 0; bj < 2; ++bj) yv[ai][m][bj] = *(const bf16x8*)(yact + row * 256 + bj * HALF + wc * 32 + 8 * fq); )
        PG8_EPI_ROWS( float ss = 0.f;
            _Pragma("unroll") for (int bj = 0; bj < 2; ++bj) { const bf16x8 y = yv[ai][m][bj];
                f32x4 a = acc[ai][bj][m][0] + bv[bj][0], b = acc[ai][bj][m][1] + bv[bj][1];
                _Pragma("unroll") for (int e = 0; e < 4; ++e) { a[e] = (float)y[e] * __builtin_amdgcn_rcpf(1.0f + __expf(-a[e])); b[e] = (float)y[4 + e] * __builtin_amdgcn_rcpf(1.0f + __expf(-b[e])); ss += a[e] * a[e] + b[e] * b[e]; }
                acc[ai][bj][m][0] = a; acc[ai][bj][m][1] = b; }
            ss += __shfl_xor(ss, 16); ss += __shfl_xor(ss, 32); if (fq == 0) X[rt * 4 + wc] = ss; )
        asm volatile("s_waitcnt lgkmcnt(0)\n\ts_barrier" ::: "memory");
        PG8_EPI_ROWS( const size_t row = (size_t)(u.pm * BM + rt); const f32x4 sv = *(const PG8_LAS f32x4*)(X + rt * 4);
            const float rs = 1.0f / sqrtf(((sv[0] + sv[1]) + (sv[2] + sv[3])) * (1.0f / 256.0f) + 1e-6f);
            _Pragma("unroll") for (int bj = 0; bj < 2; ++bj) *(bf16x8*)(Y + row * D + 512 + bj * HALF + wc * 32 + 8 * fq) = pack8(acc[ai][bj][m][0] * rs, acc[ai][bj][m][1] * rs); ) } };
struct ESiluMul { static constexpr bool PERM = true, AFTER_DRAIN = false; bf16_t* HE;
    __device__ __forceinline__ void operator()(const f32x4 (&acc)[2][2][4][2], const Unit& u, int wr, int wc, int fr, int fq) const {
        const int jb = u.pn & 1;
        PG8_EPI_ROWS( f32x4 a = acc[ai][0][m][0], b = acc[ai][0][m][1]; const f32x4 ua = acc[ai][1][m][0], ub = acc[ai][1][m][1];
            _Pragma("unroll") for (int e = 0; e < 4; ++e) { a[e] = a[e] * __builtin_amdgcn_rcpf(1.0f + __expf(-a[e])) * ua[e]; b[e] = b[e] * __builtin_amdgcn_rcpf(1.0f + __expf(-b[e])) * ub[e]; }
            *(bf16x8*)(HE + (size_t)(u.pm * BM + rt) * DEXP + jb * HALF + wc * 32 + 8 * fq) = pack8(a, b); ) } };
struct EScatter { static constexpr bool PERM = true, AFTER_DRAIN = false; const int* rowtok; const float* roww; bf16_t* YS;
    __device__ __forceinline__ void operator()(const f32x4 (&acc)[2][2][4][2], const Unit& u, int wr, int wc, int fr, int fq) const {
        const int j = u.pn & 3; int rv[2][4]; float wv[2][4];
        PG8_EPI_ROWS( const int lr = u.pm * BM + rt; rv[ai][m] = rowtok[lr]; wv[ai][m] = roww[lr]; )
        PG8_EPI_ROWS( const int r = rv[ai][m]; const float w = wv[ai][m];
            if (r >= 0) { bf16_t* rp = YS + (size_t)r * D + j * BM + wc * 32 + 8 * fq;
                _Pragma("unroll") for (int bj = 0; bj < 2; ++bj) *(bf16x8*)(rp + bj * HALF) = pack8(acc[ai][bj][m][0] * w, acc[ai][bj][m][1] * w); } ) } };
struct MoeOrder { const int* tx; int NJ, G, c, nwg;
    __device__ __forceinline__ void init(const int* tx_, int NJ_, int G_, int c_) { tx = tx_; NJ = NJ_; G = G_; c = c_; nwg = __builtin_amdgcn_readfirstlane(tx_[0]) * NJ_; }
    __device__ __forceinline__ bool next(int i, Unit& u) const {
        const long L = (long)i * G + c; if (L >= nwg) return false;
        int wgid = (int)L; { const int q = nwg / NXCD, r = nwg % NXCD, xcd = wgid % NXCD, off = wgid / NXCD; wgid = (xcd < r ? xcd * (q + 1) : r * (q + 1) + (xcd - r) * q) + off; }
        u.pm = wgid / NJ; u.pn = __builtin_amdgcn_readfirstlane(tx[1 + u.pm]) * NJ + (wgid % NJ); u.aoff = 0; u.boff = 0; u.tag = 0; u.nt = 0; return true; }
    __device__ __forceinline__ void a_ready(const Unit&) const {}
    __device__ __forceinline__ void done(const Unit&) const {}
};
struct EStoreWin { static constexpr bool PERM = true, AFTER_DRAIN = false; bf16_t* Z; bf16_t* UG;
    __device__ __forceinline__ void operator()(const f32x4 (&acc)[2][2][4][2], const Unit& u, int wr, int wc, int fr, int fq) const {
        if (u.pn != 6) {
            const __amdgpu_buffer_rsrc_t rs = __builtin_amdgcn_make_buffer_rsrc((void*)Z, (short)0, (int)0x7ffffff0, 0x00020000);
            PG8_EPI_ROWS( const int off = ((u.pm * BM + rt) * DIN + u.pn * BM + wc * 32 + 8 * fq) * 2;
                _Pragma("unroll") for (int bj = 0; bj < 2; ++bj) __builtin_amdgcn_raw_buffer_store_b128(__builtin_bit_cast(u32x4, pack8(acc[ai][bj][m][0], acc[ai][bj][m][1])), rs, off + bj * HALF * 2, 0, 16); )
        } else {
            PG8_EPI_ROWS( const int n = u.pm * BM + rt; const size_t R = (size_t)(n >> 11) * 64 + ((n & 2047) >> 5); const int s = n & 31;
                _Pragma("unroll") for (int bj = 0; bj < 2; ++bj) { const int col = bj * HALF + wc * 32 + 8 * fq;
                    *(bf16x8*)(UG + ((size_t)(col >> 4) * 1024 + R) * 640 + s * 16 + (col & 15)) = pack8(acc[ai][bj][m][0], acc[ai][bj][m][1]); } )
        } } };
struct ES5 { static constexpr bool PERM = true, AFTER_DRAIN = false; const bf16_t* UG; bf16_t* YA; const float* dsk; const float* logdt;
    __device__ __forceinline__ void operator()(const f32x4 (&acc)[2][2][4][2], const Unit& u, int wr, int wc, int fr, int fq) const {
        const int g = u.tag; const float sg = __expf(logdt[g]);
        const int h0 = (8 * fq) & 15; const f32x4 d0 = *(const f32x4*)(dsk + g * 16 + h0), d1 = *(const f32x4*)(dsk + g * 16 + h0 + 4);
        bf16x8 uvv[2][4][2];
        PG8_EPI_ROWS( const int Rg = (u.pm & 3) * BM + rt;
            _Pragma("unroll") for (int bj = 0; bj < 2; ++bj) { const int col = (u.pn & 1) * BM + bj * HALF + wc * 32 + 8 * fq; uvv[ai][m][bj] = *(const bf16x8*)(UG + ((size_t)g * 1024 + Rg) * 640 + col); } )
        PG8_EPI_ROWS( const int Rg = (u.pm & 3) * BM + rt; const size_t tok0 = (size_t)(Rg >> 6) * SEQ + (Rg & 63) * 32;
            _Pragma("unroll") for (int bj = 0; bj < 2; ++bj) { const int col = (u.pn & 1) * BM + bj * HALF + wc * 32 + 8 * fq, t = col >> 4;
                const bf16x8 uv = uvv[ai][m][bj];
                f32x4 a = acc[ai][bj][m][0], b = acc[ai][bj][m][1];
                _Pragma("unroll") for (int e = 0; e < 4; ++e) { float x = sg * a[e] + d0[e] * (float)uv[e]; a[e] = x * __builtin_amdgcn_rcpf(1.0f + __expf(-1.5957691216f * (x + 0.044715f * x * x * x)));
                    x = sg * b[e] + d1[e] * (float)uv[4 + e]; b[e] = x * __builtin_amdgcn_rcpf(1.0f + __expf(-1.5957691216f * (x + 0.044715f * x * x * x))); }
                *(bf16x8*)(YA + (tok0 + t) * 256 + g * 16 + h0) = pack8(a, b); } ) } };
struct S5Order { int G, c;
    __device__ __forceinline__ bool next(int i, Unit& u) const {
        const int L = i * G + c; if (L >= 128) return false; const int g = L >> 3;
        u.pm = g * 4 + ((L >> 1) & 3); u.pn = g * 2 + (L & 1); u.aoff = 0; u.boff = 0; u.tag = g; u.nt = 0; return true; }
    __device__ __forceinline__ void a_ready(const Unit&) const {}
    __device__ __forceinline__ void done(const Unit&) const {}
};
__device__ __forceinline__ int xcd_remap(int wgid, int nwg) { const int q = nwg / NXCD, r = nwg % NXCD, xcd = wgid % NXCD, off = wgid / NXCD; return (xcd < r ? xcd * (q + 1) : r * (q + 1) + (xcd - r) * q) + off; }
struct KvOrder { int G, c;
    __device__ __forceinline__ bool next(int i, Unit& u) const {
        const int L = i * G + c; if (L >= 256) return false;
        const int l = L >> 7, isv = (L >> 6) & 1, r = L & 63; u.tag = l * 2 + isv; u.nt = 0;
        if (!isv) { u.pm = r >> 2; u.pn = r & 3; u.aoff = (unsigned)WS_MEM16; u.boff = (unsigned)(WS_WKV_T + (size_t)(2 * l) * D * D * 2); }
        else      { u.pm = r & 3; u.pn = r >> 2; u.aoff = (unsigned)(WS_WKV_T + (size_t)(2 * l + 1) * D * D * 2); u.boff = (unsigned)WS_MEM16; }
        return true; }
    __device__ __forceinline__ void a_ready(const Unit&) const {}
    __device__ __forceinline__ void done(const Unit&) const {}
};
struct EStoreKV2 { static constexpr bool PERM = true, AFTER_DRAIN = false; bf16_t* KM; bf16_t* VT;
    __device__ __forceinline__ void operator()(const f32x4 (&acc)[2][2][4][2], const Unit& u, int wr, int wc, int fr, int fq) const {
        const int l = u.tag >> 1, isv = u.tag & 1;
        bf16_t* C = KM + (size_t)isv * ((WS_VM - WS_KM) / 2) + (size_t)l * NMEM * D;
        PG8_EPI_ROWS( bf16_t* rp = C + (size_t)(u.pm * BM + rt) * D + u.pn * BM + wc * 32 + 8 * fq;
            _Pragma("unroll") for (int bj = 0; bj < 2; ++bj) *(bf16x8*)(rp + bj * HALF) = pack8(acc[ai][bj][m][0], acc[ai][bj][m][1]); ) } };
struct XsOrder { int G, c;
    __device__ __forceinline__ bool next(int i, Unit& u) const {
        const int L = i * G + c; if (L >= 512) return false; const int w = xcd_remap(L, 512);
        u.pm = w >> 2; u.tag = w & 3; u.pn = u.pm >> 3; u.aoff = u.tag * 512; u.boff = u.tag * 512; u.nt = 0; return true; }
    __device__ __forceinline__ void a_ready(const Unit&) const {}
    __device__ __forceinline__ void done(const Unit&) const {}
};
struct XoOrder { int G, c;
    __device__ __forceinline__ bool next(int i, Unit& u) const {
        const int L = i * G + c; if (L >= 512) return false; const int w = xcd_remap(L, 512);
        u.pm = w >> 2; u.tag = w & 3; u.pn = u.tag; u.aoff = u.tag * 512; u.boff = (u.pm >> 3) * 512; u.nt = 0; return true; }
    __device__ __forceinline__ void a_ready(const Unit&) const {}
    __device__ __forceinline__ void done(const Unit&) const {}
};
struct ESoftmaxP { static constexpr bool PERM = true, AFTER_DRAIN = false; bf16_t* P; PG8_LAS float* X;
    __device__ __forceinline__ void operator()(f32x4 (&acc)[2][2][4][2], const Unit& u, int wr, int wc, int fr_, int fq) const {
        int fr = fr_; asm volatile("" : "+v"(fr));
        PG8_EPI_ROWS( float v = -3.0e38f;
            _Pragma("unroll") for (int bj = 0; bj < 2; ++bj) _Pragma("unroll") for (int n = 0; n < 2; ++n) _Pragma("unroll") for (int e = 0; e < 4; ++e) v = fmaxf(v, acc[ai][bj][m][n][e]);
            v = fmaxf(v, __shfl_xor(v, 16)); v = fmaxf(v, __shfl_xor(v, 32)); if (fq == 0) X[rt * 4 + wc] = v; )
        asm volatile("s_waitcnt lgkmcnt(0)\n\ts_barrier" ::: "memory");
        PG8_EPI_ROWS( const f32x4 mv = *(const PG8_LAS f32x4*)(X + rt * 4); const float mx = fmaxf(fmaxf(mv[0], mv[1]), fmaxf(mv[2], mv[3])); float sm = 0.f;
            _Pragma("unroll") for (int bj = 0; bj < 2; ++bj) _Pragma("unroll") for (int n = 0; n < 2; ++n) _Pragma("unroll") for (int e = 0; e < 4; ++e) { const float p = __builtin_amdgcn_exp2f(acc[ai][bj][m][n][e] - mx); acc[ai][bj][m][n][e] = p; sm += p; }
            sm += __shfl_xor(sm, 16); sm += __shfl_xor(sm, 32); if (fq == 0) X[1024 + rt * 4 + wc] = sm; )
        asm volatile("s_waitcnt lgkmcnt(0)\n\ts_barrier" ::: "memory");
        PG8_EPI_ROWS( const f32x4 sv = *(const PG8_LAS f32x4*)(X + 1024 + rt * 4); const float inv = 1.0f / ((sv[0] + sv[1]) + (sv[2] + sv[3]));
            bf16_t* rp = P + (size_t)(u.pm * BM + rt) * D + u.tag * BM + wc * 32 + 8 * fq;
            _Pragma("unroll") for (int bj = 0; bj < 2; ++bj) *(bf16x8*)(rp + bj * HALF) = pack8(acc[ai][bj][m][0] * inv, acc[ai][bj][m][1] * inv); )
    } };
struct ChainOrder { int G, c, l;
    __device__ __forceinline__ bool next(int i, Unit& u) const {
        if (i >= 4 || c >= 256) return false;
        const int v = (G % 8 == 0) ? (c % 8) * (G / 8) + c / 8 : c, tr = 2 * v + (i & 1), ty = 1 + (i >> 1), hh = tr & 3; u.pm = tr >> 2; const int b = u.pm >> 3; u.tag = ty | (hh << 2); u.nt = 4;
        if (ty == 1) { u.pn = b; u.aoff = (unsigned)(WS_QX + hh * 512); u.boff = (unsigned)(WS_KM + (size_t)l * NMEM * D * 2 + hh * 512); }
        else         { u.pn = hh; u.aoff = (unsigned)(WS_P + hh * 512); u.boff = (unsigned)(WS_VM + (size_t)l * NMEM * D * 2 + ((size_t)(b >> 2) * D * D + (b & 3) * 256) * 2); }
        return true; }
    __device__ __forceinline__ void a_ready(const Unit&) const {}
    __device__ __forceinline__ void done(const Unit&) const {}
};
struct EChain { static constexpr bool PERM = true, AFTER_DRAIN = false; ESoftmaxP e1; EStore e2;
    __device__ __forceinline__ void operator()(f32x4 (&acc)[2][2][4][2], const Unit& u, int wr, int wc, int fr, int fq) const {
        const int ty = u.tag & 3; Unit v = u; v.tag = u.tag >> 2;
        if (ty == 1) e1(acc, v, wr, wc, fr, fq); else e2(acc, v, wr, wc, fr, fq); } };
struct WinKvOrder { StaticOrder so; int lay;
    __device__ __forceinline__ bool next(int i, Unit& u) const {
        if (so.next(i, u)) { u.aoff = (unsigned)WS_H; u.boff = (unsigned)(WS_WIN_T + (size_t)lay * DIN * D * 2); u.tag = 0; return true; }
        const int L = i * so.G + so.c - so.nwg; if (L < 0 || L >= 128) return false;
        const int isv = L >> 6, r = L & 63, l = lay; u.tag = 1 | ((l * 2 + isv) << 1); u.nt = 0;
        if (!isv) { u.pm = r >> 2; u.pn = r & 3; u.aoff = (unsigned)WS_MEM16; u.boff = (unsigned)(WS_WKV_T + (size_t)(2 * l) * D * D * 2); }
        else      { u.pm = r >> 2; u.pn = r & 3; u.aoff = (unsigned)WS_MEM16; u.boff = (unsigned)(WS_WKV_T + (size_t)(2 * l + 1) * D * D * 2); }
        return true; }
    __device__ __forceinline__ void a_ready(const Unit&) const {}
    __device__ __forceinline__ void done(const Unit&) const {}
};
struct EWinKv { static constexpr bool PERM = true, AFTER_DRAIN = false; EStoreWin e0; EStoreKV2 e1;
    __device__ __forceinline__ void operator()(const f32x4 (&acc)[2][2][4][2], const Unit& u, int wr, int wc, int fr, int fq) const {
        if ((u.tag & 1) == 0) e0(acc, u, wr, wc, fr, fq); else { Unit v = u; v.tag = u.tag >> 1; e1(acc, v, wr, wc, fr, fq); } } };
struct PreOrder { int G, c, l;
    __device__ __forceinline__ bool next(int i, Unit& u) const {
        int L;
        if (G == 256) { if (c < 128) { if (i > 0) return false; L = c; } else { if (i >= 3) return false; L = 128 + (c - 128) * 3 + i; } }
        else { L = i * G + c; if (L >= 512) return false; }
        const int kind = L >> 8, r = L & 255, b = r >> 4, hh = (r >> 2) & 3, q = r & 3; u.nt = 4; u.tag = kind | (b << 1) | (hh << 5);
        if (!kind) { u.pm = b; u.pn = q; u.aoff = (unsigned)(WS_KM + (size_t)l * NMEM * D * 2 + hh * 512); u.boff = (unsigned)(WS_WQN + (size_t)l * D * D * 2 + hh * 512); }
        else       { u.pm = q; u.pn = b; u.aoff = (unsigned)(WS_WO_T + (size_t)l * D * D * 2 + hh * 512); u.boff = (unsigned)(WS_VM + (size_t)l * NMEM * D * 2 + hh * 512); }
        return true; }
    __device__ __forceinline__ void a_ready(const Unit&) const {}
    __device__ __forceinline__ void done(const Unit&) const {}
};
struct EStorePre { static constexpr bool PERM = true, AFTER_DRAIN = false; bf16_t* MT;
    __device__ __forceinline__ void operator()(const f32x4 (&acc)[2][2][4][2], const Unit& u, int wr, int wc, int fr, int fq) const {
        const int kind = u.tag & 1, b = (u.tag >> 1) & 15, hh = u.tag >> 5;
        bf16_t* C = MT + ((size_t)kind * 16 + b) * D * D; const int rowbase = kind ? u.pm * BM : hh * BM, col0 = (kind ? hh * BM : u.pn * BM) + wc * 32 + 8 * fq;
        PG8_EPI_ROWS( bf16_t* rp = C + (size_t)(rowbase + rt) * D + col0;
            _Pragma("unroll") for (int bj = 0; bj < 2; ++bj) *(bf16x8*)(rp + bj * HALF) = pack8(acc[ai][bj][m][0], acc[ai][bj][m][1]); ) } };
struct BatchBOrder { StaticOrder so; unsigned bbase;
    __device__ __forceinline__ bool next(int i, Unit& u) const { if (!so.next(i, u)) return false; u.boff = bbase + (unsigned)(u.pm >> 3) * (unsigned)(D * D * 2); return true; }
    __device__ __forceinline__ void a_ready(const Unit&) const {}
    __device__ __forceinline__ void done(const Unit&) const {}
};
struct ESoftmaxLN { static constexpr bool PERM = true, AFTER_DRAIN = false; bf16_t* P; PG8_LAS float* X; const float* ST; const float* s1x; const float* s2x;
    __device__ __forceinline__ void operator()(f32x4 (&acc)[2][2][4][2], const Unit& u, int wr, int wc, int fr_, int fq) const {
        int fr = fr_; asm volatile("" : "+v"(fr));
        { const int c0 = (u.pm >> 3) * D + u.pn * BM + wc * 32 + 8 * fq;
          f32x4 s1v[2][2], s2v[2][2]; float rsv[2][4], mrv[2][4];
          _Pragma("unroll") for (int bj = 0; bj < 2; ++bj) { const int col = c0 + bj * HALF; s1v[bj][0] = *(const f32x4*)(s1x + col); s1v[bj][1] = *(const f32x4*)(s1x + col + 4); s2v[bj][0] = *(const f32x4*)(s2x + col); s2v[bj][1] = *(const f32x4*)(s2x + col + 4); }
          PG8_EPI_ROWS( const size_t row = (size_t)(u.pm * BM + rt); float mu, rs; ln_stats4(ST, row, mu, rs); rsv[ai][m] = rs; mrv[ai][m] = -mu * rs; )
          PG8_EPI_ROWS( const float rs = rsv[ai][m], mr = mrv[ai][m];
              _Pragma("unroll") for (int bj = 0; bj < 2; ++bj) _Pragma("unroll") for (int n = 0; n < 2; ++n) _Pragma("unroll") for (int e = 0; e < 4; ++e) acc[ai][bj][m][n][e] = rs * acc[ai][bj][m][n][e] + (mr * s1v[bj][n][e] + s2v[bj][n][e]); ) }
        PG8_EPI_ROWS( float v = -3.0e38f;
            _Pragma("unroll") for (int bj = 0; bj < 2; ++bj) _Pragma("unroll") for (int n = 0; n < 2; ++n) _Pragma("unroll") for (int e = 0; e < 4; ++e) v = fmaxf(v, acc[ai][bj][m][n][e]);
            v = fmaxf(v, __shfl_xor(v, 16)); v = fmaxf(v, __shfl_xor(v, 32)); if (fq == 0) X[rt * 4 + wc] = v; )
        asm volatile("s_waitcnt lgkmcnt(0)\n\ts_barrier" ::: "memory");
        PG8_EPI_ROWS( const f32x4 mv = *(const PG8_LAS f32x4*)(X + rt * 4); const float mx = fmaxf(fmaxf(mv[0], mv[1]), fmaxf(mv[2], mv[3])); float sm = 0.f;
            _Pragma("unroll") for (int bj = 0; bj < 2; ++bj) _Pragma("unroll") for (int n = 0; n < 2; ++n) _Pragma("unroll") for (int e = 0; e < 4; ++e) { const float p = __builtin_amdgcn_exp2f(acc[ai][bj][m][n][e] - mx); acc[ai][bj][m][n][e] = p; sm += p; }
            sm += __shfl_xor(sm, 16); sm += __shfl_xor(sm, 32); if (fq == 0) X[1024 + rt * 4 + wc] = sm; )
        asm volatile("s_waitcnt lgkmcnt(0)\n\ts_barrier" ::: "memory");
        PG8_EPI_ROWS( const f32x4 sv = *(const PG8_LAS f32x4*)(X + 1024 + rt * 4); const float inv = 1.0f / ((sv[0] + sv[1]) + (sv[2] + sv[3]));
            bf16_t* rp = P + (size_t)(u.pm * BM + rt) * D + u.pn * BM + wc * 32 + 8 * fq;
            _Pragma("unroll") for (int bj = 0; bj < 2; ++bj) *(bf16x8*)(rp + bj * HALF) = pack8(acc[ai][bj][m][0] * inv, acc[ai][bj][m][1] * inv); )
    } };
}

__device__ __forceinline__ void tr_item(const float* W, int ldw, int k0, int n0s, f16* WT, int ldt, int n0d, float cs, const float* ks, LAS float* scr, int lane) {
#pragma unroll
    for (int i = 0; i < 8; ++i) { const int kk = 8 * i + (lane >> 3), nq = (lane & 7) * 4;
        f32x4 v = __builtin_nontemporal_load((const f32x4*)(W + (size_t)(k0 + kk) * ldw + n0s + nq)); const float sc = ks ? cs * ks[k0 + kk] : cs;
        scr[kk * 33 + nq] = v[0] * sc; scr[kk * 33 + nq + 1] = v[1] * sc; scr[kk * 33 + nq + 2] = v[2] * sc; scr[kk * 33 + nq + 3] = v[3] * sc; }
    asm volatile("s_waitcnt lgkmcnt(0)" ::: "memory");
    const int cc = lane & 7;
#pragma unroll
    for (int j = 0; j < 4; ++j) { const int n = (lane >> 3) + 8 * j; const LAS float* sp = scr + (8 * cc) * 33 + n; f16x8 o;
#pragma unroll
        for (int e = 0; e < 8; ++e) o[e] = (f16)sp[e * 33];
        *(f16x8*)(WT + (size_t)(n0d + n) * ldt + k0 + 8 * cc) = o; }
    asm volatile("s_waitcnt lgkmcnt(0)" ::: "memory");
}
__device__ __forceinline__ void tr_matrix_item(const float* W, int K, int N, f16* WT, int it, float cs, int ncs, const float* ks, LAS float* scr, int lane) {
    const int nblk = N / 32, kb = it / nblk, nb = it % nblk;
    tr_item(W, N, 64 * kb, 32 * nb, WT, K, 32 * nb, (32 * nb < ncs) ? cs : 1.0f, ks, scr, lane);
}
constexpr int MOE_CONV_ITEMS = NEXP * (16 * 16 + 4 * 32);
__device__ __forceinline__ void conv_moe_item(const Ctx& c, int l, int it, LAS float* scr) {
    const int e = it / 384, r = it % 384;
    if (r < 256) { const int kb = r >> 4, nb = r & 15;
        const int j0 = (nb >> 3) * 128 + (nb & 3) * 32; const float* W = (((nb >> 2) & 1) ? c.in[37] : c.in[36]) + ((size_t)l * NEXP + e) * D * DEXP;
        tr_item(W, DEXP, 64 * kb, j0, wsp<f16>(c, WS_WGU_T) + (size_t)e * 512 * D, D, 32 * nb, 1.0f, nullptr, scr, c.lane);
    } else { const int r2 = r - 256, kb = r2 >> 5, nb = r2 & 31;
        tr_item(c.in[38] + ((size_t)l * NEXP + e) * DEXP * D, D, 64 * kb, 32 * nb, wsp<f16>(c, WS_WD_T) + (size_t)e * D * DEXP, DEXP, 32 * nb, 1.0f, nullptr, scr, c.lane); }
}
__device__ __forceinline__ void ph_fold_vectors(const Ctx& c) {
    float* S1 = wsp<float>(c, WS_S1Q); float* S2 = wsp<float>(c, WS_S2Q);
    for (int it = c.wid * c.G + c.bid; it < DEPTH * D; it += c.G * 8) { const int l = it >> 10, n = it & 1023;
        const f16* wt = wsp<f16>(c, WS_WQ_T) + ((size_t)l * D + n) * D; const f16x8 a = *(const f16x8*)(wt + 8 * c.lane), b = *(const f16x8*)(wt + 512 + 8 * c.lane);
        float s1 = 0.f;
#pragma unroll
        for (int i = 0; i < 8; ++i) s1 += (float)a[i] + (float)b[i];
        const float* w = c.in[26] + (size_t)l * D * D + n; const float* bb = c.in[25] + l * D; float s2 = 0.f;
#pragma unroll 4
        for (int j = 0; j < 16; ++j) { const int k = c.lane + 64 * j; s2 += bb[k] * w[(size_t)k * D]; }
        s1 = wave_sum(s1); s2 = wave_sum(s2) * XQSCALE;
        if (c.lane == 0) { S1[it] = s1; S2[it] = s2; } }
}
__device__ __forceinline__ void ph_conv(const Ctx& c) {
    LAS float* scr = (LAS float*)(c.lds + c.wid * 16384);
    const int gw = c.wid * c.G + c.bid, NGW = c.G * 8;
    constexpr int I_IN = 16 * 72, I_SQ = 16 * 32, I_GLU = 4 * 8, I_LRU = 16, PER_L = I_IN + 5 * I_SQ + I_GLU + I_LRU;
    for (int it0 = gw; it0 < DEPTH * PER_L; it0 += NGW) {
        const int l = it0 / PER_L; int it = it0 % PER_L;
        if (it < I_IN) { tr_matrix_item(c.in[4] + (size_t)l * D * DIN, D, DIN, wsp<f16>(c, WS_WIN_T) + (size_t)l * DIN * D, it, QSCALE, 512, nullptr, scr, c.lane); continue; } it -= I_IN;
        if (it < I_SQ) { tr_matrix_item(c.in[6] + (size_t)l * D * D, D, D, wsp<f16>(c, WS_WOUT_T) + (size_t)l * D * D, it, 1.f, 0, c.in[5] + l * D, scr, c.lane); continue; } it -= I_SQ;
        if (it < I_SQ) { tr_matrix_item(c.in[26] + (size_t)l * D * D, D, D, wsp<f16>(c, WS_WQ_T) + (size_t)l * D * D, it, XQSCALE, D, c.in[24] + l * D, scr, c.lane); continue; } it -= I_SQ;
        if (it < I_SQ) { tr_matrix_item(c.in[27] + (size_t)l * D * D, D, D, wsp<f16>(c, WS_WKV_T) + (size_t)(2 * l) * D * D, it, 1.f, 0, nullptr, scr, c.lane); continue; } it -= I_SQ;
        if (it < I_SQ) { tr_matrix_item(c.in[28] + (size_t)l * D * D, D, D, wsp<f16>(c, WS_WKV_T) + (size_t)(2 * l + 1) * D * D, it, 1.f, 0, nullptr, scr, c.lane); continue; } it -= I_SQ;
        if (it < I_SQ) { tr_matrix_item(c.in[29] + (size_t)l * D * D, D, D, wsp<f16>(c, WS_WO_T) + (size_t)l * D * D, it, 1.f, 0, nullptr, scr, c.lane); continue; } it -= I_SQ;
        if (it < I_GLU) { tr_matrix_item(c.in[15] + (size_t)l * 256 * 256, 256, 256, wsp<f16>(c, WS_WGLU_T) + (size_t)l * 256 * 256, it, 1.f, 0, nullptr, scr, c.lane); continue; } it -= I_GLU;
        { const int which = it >> 3, hd = (it >> 1) & 3, sub = it & 1;
          tr_matrix_item(c.in[which ? 21 : 19] + (size_t)(l * 4 + hd) * 4096, 64, 64, wsp<f16>(c, which ? WS_WLX_T : WS_WLA_T) + (size_t)(l * 4 + hd) * 4096, sub, 1.f, 0, nullptr, scr, c.lane); }
    }
    for (int it = gw; it < DEPTH * D; it += NGW) { float v[16]; vec_load16_nt(c.in[26] + (size_t)it * D, c.lane, v); const float sc = XQSCALE * c.in[24][it];
#pragma unroll
        for (int i = 0; i < 16; ++i) v[i] *= sc;
        row_store16(wsp<f16>(c, WS_WQN) + (size_t)it * D, c.lane, v); }
}
__device__ __forceinline__ void ph_fold_x(const Ctx& c, int l) {
    const f16* MT = wsp<f16>(c, WS_MT); const f16* KM = wsp<f16>(c, WS_KM) + (size_t)l * NMEM * D; const float* S2 = wsp<float>(c, WS_S2Q) + l * D;
    float* S1X = wsp<float>(c, WS_S1X); float* S2X = wsp<float>(c, WS_S2X);
    for (int it = c.wid * c.G + c.bid; it < BATCH * D; it += c.G * 8) { const int b = it >> 10, n = it & 1023, hh = n >> 8, key = n & 255;
        float v[16]; row_load16(MT + (size_t)it * D, c.lane, v); float s1 = 0.f;
#pragma unroll
        for (int i = 0; i < 16; ++i) s1 += v[i];
        const f16x4 kv = *(const f16x4*)(KM + ((size_t)b * 256 + key) * D + hh * 256 + 4 * c.lane); const f32x4 sv = *(const f32x4*)(S2 + hh * 256 + 4 * c.lane);
        float s2 = (float)kv[0] * sv[0] + (float)kv[1] * sv[1] + (float)kv[2] * sv[2] + (float)kv[3] * sv[3];
        s1 = wave_sum(s1); s2 = wave_sum(s2);
        if (c.lane == 0) { S1X[it] = s1; S2X[it] = s2; } }
}

template <int R> __device__ __forceinline__ void ln_rows(float (&v)[R][16], const float (&gg)[16], const float (&bb)[16]) {
    float s[R];
#pragma unroll
    for (int r = 0; r < R; ++r) { s[r] = 0.f;
#pragma unroll
        for (int i = 0; i < 16; ++i) s[r] += v[r][i]; }
#pragma unroll
    for (int o = 1; o < 64; o <<= 1)
#pragma unroll
        for (int r = 0; r < R; ++r) s[r] += __shfl_xor(s[r], o);
    float q[R];
#pragma unroll
    for (int r = 0; r < R; ++r) { const float mu = s[r] * (1.0f / 1024.0f); q[r] = 0.f;
#pragma unroll
        for (int i = 0; i < 16; ++i) { v[r][i] -= mu; q[r] += v[r][i] * v[r][i]; } }
#pragma unroll
    for (int o = 1; o < 64; o <<= 1)
#pragma unroll
        for (int r = 0; r < R; ++r) q[r] += __shfl_xor(q[r], o);
#pragma unroll
    for (int r = 0; r < R; ++r) { const float rstd = 1.0f / sqrtf(q[r] * (1.0f / 1024.0f) + 1e-5f);
#pragma unroll
        for (int i = 0; i < 16; ++i) v[r][i] = v[r][i] * rstd * gg[i] + bb[i]; }
}
struct AF16 {
    const f16* A; int lda; const int* rowtok; const float* ks;
    __device__ __forceinline__ void load4(int m, int k, float (&v)[4]) const {
        int r = m; if (rowtok) { const int t = rowtok[m]; r = (t < 0 ? 0 : t) >> 1; }
        const f16x4 a = *(const f16x4*)(A + (size_t)r * lda + k);
#pragma unroll
        for (int j = 0; j < 4; ++j) v[j] = (float)a[j];
        if (ks) {
#pragma unroll
            for (int j = 0; j < 4; ++j) v[j] *= ks[k + j];
        }
    }
};
struct BF32 {
    const float* B; int ldb; const int* tile_exp; size_t estride;
    __device__ __forceinline__ const float* base(int m0) const { return tile_exp ? B + (size_t)tile_exp[1 + (m0 >> 8)] * estride : B; }
};
template <class EF>
__device__ __forceinline__ void sgemm_phase(const Ctx& c, int M, int Nc, int K, const AF16 af, const BF32 bf, const EF ef) {
    LAS float* As = (LAS float*)c.lds;
    LAS float* Bs = As + 16 * 132;
    const int tid = c.tid, tx = tid & 15, ty = tid >> 4;
    const int tilesN = Nc / 64, ntiles = (M / 128) * tilesN;
    for (int u = c.bid; u < ntiles; u += c.G) {
        const int m0 = (u / tilesN) * 128, n0 = (u % tilesN) * 64;
        const float* Bb = bf.base(m0);
        float acc[4][4];
#pragma unroll
        for (int i = 0; i < 4; ++i)
#pragma unroll
            for (int j = 0; j < 4; ++j) acc[i][j] = 0.f;
        for (int k0 = 0; k0 < K; k0 += 16) {
            { const int m = tid & 127, kq = (tid >> 7) * 4; float v[4]; af.load4(m0 + m, k0 + kq, v);
#pragma unroll
              for (int j = 0; j < 4; ++j) As[(kq + j) * 132 + m] = v[j]; }
            { const int kk = tid >> 5, n = (tid & 31) * 2; const float* bp = Bb + (size_t)(k0 + kk) * bf.ldb + n0 + n;
              Bs[kk * 68 + n] = bp[0]; Bs[kk * 68 + n + 1] = bp[1]; }
            __syncthreads();
#pragma unroll
            for (int kk = 0; kk < 16; ++kk) {
                const f32x4 a = *(const LAS f32x4*)(As + kk * 132 + 4 * ty), b = *(const LAS f32x4*)(Bs + kk * 68 + 4 * tx);
#pragma unroll
                for (int i = 0; i < 4; ++i)
#pragma unroll
                    for (int j = 0; j < 4; ++j) acc[i][j] += a[i] * b[j];
            }
            __syncthreads();
        }
#pragma unroll
        for (int i = 0; i < 4; ++i) ef(m0 + 4 * ty + i, n0 + 4 * tx, acc[i]);
    }
}
struct EpiStoreF16 { f16* C; int ldc; float scale; int nscale;
    __device__ __forceinline__ void operator()(int m, int n, const float (&a)[4]) const {
        const float s = n < nscale ? scale : 1.0f; f16x4 o;
#pragma unroll
        for (int j = 0; j < 4; ++j) o[j] = (f16)(a[j] * s);
        *(f16x4*)(C + (size_t)m * ldc + n) = o; } };
struct EpiResid { f16* H;
    __device__ __forceinline__ void operator()(int m, int n, const float (&a)[4]) const {
        f16x4* p = (f16x4*)(H + (size_t)m * D + n); f16x4 o = *p;
#pragma unroll
        for (int j = 0; j < 4; ++j) o[j] = (f16)(ALPHA * (float)o[j] + a[j]);
        *p = o; } };
struct EpiGlu { const f16* yact; const float* bg; f16* Y;
    __device__ __forceinline__ void operator()(int m, int n, const float (&a)[4]) const {
        const f16x4 y = *(const f16x4*)(yact + (size_t)m * 256 + n); f16x4 o;
#pragma unroll
        for (int j = 0; j < 4; ++j) o[j] = (f16)((float)y[j] * sigmoidf_(a[j] + bg[n + j]));
        *(f16x4*)(Y + (size_t)m * D + 512 + n) = o; } };
struct EpiSiluMul { const f16* hg; f16* he;
    __device__ __forceinline__ void operator()(int m, int n, const float (&a)[4]) const {
        const f16x4 g = *(const f16x4*)(hg + (size_t)m * 256 + n); f16x4 o;
#pragma unroll
        for (int j = 0; j < 4; ++j) { const float gv = (float)g[j]; o[j] = (f16)(gv * sigmoidf_(gv) * a[j]); }
        *(f16x4*)(he + (size_t)m * 256 + n) = o; } };
struct EpiScatter { const int* rowtok; const float* roww; f16* ys;
    __device__ __forceinline__ void operator()(int m, int n, const float (&a)[4]) const {
        const int r = rowtok[m]; if (r < 0) return; const float w = roww[m]; f16x4 o;
#pragma unroll
        for (int j = 0; j < 4; ++j) o[j] = (f16)(w * a[j]);
        *(f16x4*)(ys + (size_t)r * D + n) = o; } };

__device__ __forceinline__ void ph_ln0(const Ctx& c) {
    const int gw = c.wid * c.G + c.bid, NGW = c.G * 8;
    f16* H = wsp<f16>(c, WS_H);
    float gg[16], bb[16]; vec_load16(c.in[2], c.lane, gg); vec_load16(c.in[3], c.lane, bb);
    for (int m = gw * 4; m < NTOK; m += NGW * 4) {
        float v[4][16];
#pragma unroll
        for (int r = 0; r < 4; ++r) vec_load16_nt(c.in[0] + (size_t)(m + r) * D, c.lane, v[r]);
        ln_rows<4>(v, gg, bb);
#pragma unroll
        for (int r = 0; r < 4; ++r) row_store16(H + (size_t)(m + r) * D, c.lane, v[r]);
    }
    f16* M16 = wsp<f16>(c, WS_MEM16);
    for (int m = gw; m < NMEM; m += NGW) { float v[16]; vec_load16_nt(c.in[1] + (size_t)m * D, c.lane, v); row_store16(M16 + (size_t)m * D, c.lane, v); }
}
constexpr size_t WS_KMAX = WS_KMEAN + 512 * 1024;
__device__ __forceinline__ void ph_kmean(const Ctx& c) {
    const f16* Z = wsp<f16>(c, WS_Z); float* KMN = wsp<float>(c, WS_KMEAN); float* KMX = wsp<float>(c, WS_KMAX);
    LAS float* part = (LAS float*)c.lds;
    LAS float* pmx = part + 8 * 512;
    for (int it = c.bid; it < 128; it += c.G) {
        const f16* p = Z + ((size_t)it * 256 + c.wid * 32) * DIN + ZK + 8 * c.lane;
        float cs[8]; float mx = 0.f;
#pragma unroll
        for (int e = 0; e < 8; ++e) cs[e] = 0.f;
#pragma unroll 4
        for (int r = 0; r < 32; ++r) { const f16x8 v = *(const f16x8*)(p + (size_t)r * DIN); float q = 0.f;
#pragma unroll
            for (int e = 0; e < 8; ++e) { const float x = (float)v[e]; cs[e] += x; q += x * x; }
            q += __shfl_xor(q, 1); q += __shfl_xor(q, 2); q += __shfl_xor(q, 4); mx = fmaxf(mx, q); }
#pragma unroll
        for (int e = 0; e < 8; ++e) part[c.wid * 512 + 8 * c.lane + e] = cs[e];
        if ((c.lane & 7) == 0) pmx[c.wid * 8 + (c.lane >> 3)] = mx;
        __syncthreads();
        { float s = 0.f;
#pragma unroll
          for (int w = 0; w < 8; ++w) s += part[w * 512 + c.tid];
          KMN[it * 512 + c.tid] = s * (1.0f / 256.0f); }
        if (c.tid < 8) { float m = 0.f;
#pragma unroll
            for (int w = 0; w < 8; ++w) m = fmaxf(m, pmx[w * 8 + c.tid]);
            KMX[it * 8 + c.tid] = sqrtf(m); }
        __syncthreads();
    }
}
__device__ __forceinline__ void ph_attn_naive(const Ctx& c) {
    const f16* Z = wsp<f16>(c, WS_Z); const float* KMN = wsp<float>(c, WS_KMEAN); f16* Y = wsp<f16>(c, WS_Y);
    for (int item = c.bid * 512 + c.tid; item < NTOK * 8; item += c.G * 512) {
        const int t = item & 2047, h = (item >> 11) & 7, b = item >> 14, own = t >> 8;
        const size_t n = (size_t)b * SEQ + t;
        float q[64];
        { const f16* qp = Z + n * DIN + ZQ + h * 64;
#pragma unroll
          for (int d8 = 0; d8 < 8; ++d8) { const f16x8 v = *(const f16x8*)(qp + 8 * d8);
#pragma unroll
              for (int j = 0; j < 8; ++j) q[8 * d8 + j] = (float)v[j]; } }
        unsigned allowed = 0u;
        { float gate[8];
#pragma unroll
          for (int nb = 0; nb < 8; ++nb) { float s = 0.f; if (nb < own) { const float* kp = KMN + ((size_t)(b * 8 + nb)) * 512 + h * 64;
#pragma unroll
                  for (int d = 0; d < 64; ++d) s += q[d] * kp[d]; } gate[nb] = s; }
#pragma unroll
          for (int nb = 0; nb < 8; ++nb) { int rank = 0;
#pragma unroll
              for (int o = 0; o < 8; ++o) if (o < own && o != nb && (gate[o] > gate[nb] || (gate[o] == gate[nb] && o < nb))) ++rank;
              if (nb < own && rank < 3) allowed |= 1u << nb; } }
        const float slope2 = exp2f(-(float)(h + 1)) * LOG2E;
        float m = -1e30f, l = 0.f, o[64];
#pragma unroll
        for (int d = 0; d < 64; ++d) o[d] = 0.f;
        for (int step = 0; step <= own; ++step) {
            const int blk = step == 0 ? own : step - 1;
            const bool ok = (blk == own) || ((allowed >> blk) & 1u);
            const int jend = (blk == own) ? (t & 255) : 255;
            if (!ok) continue;
            for (int jj = 0; jj <= jend; ++jj) {
                const int j = blk * 256 + jj; const f16* kp = Z + ((size_t)b * SEQ + j) * DIN + ZK + h * 64;
                float s = 0.f;
#pragma unroll
                for (int d8 = 0; d8 < 8; ++d8) { const f16x8 v = *(const f16x8*)(kp + 8 * d8);
#pragma unroll
                    for (int jx = 0; jx < 8; ++jx) s += q[8 * d8 + jx] * (float)v[jx]; }
                s -= slope2 * (float)(t - j);
                const float mn = fmaxf(m, s), al = exp2f(m - mn), p = exp2f(s - mn);
                l = l * al + p; m = mn;
                const f16* vp = kp + (ZV - ZK);
#pragma unroll
                for (int d8 = 0; d8 < 8; ++d8) { const f16x8 v = *(const f16x8*)(vp + 8 * d8);
#pragma unroll
                    for (int jx = 0; jx < 8; ++jx) o[8 * d8 + jx] = o[8 * d8 + jx] * al + p * (float)v[jx]; }
            }
        }
        const float rl = 1.0f / l; f16* yp = Y + n * D + h * 64;
#pragma unroll
        for (int d8 = 0; d8 < 8; ++d8) { f16x8 v;
#pragma unroll
            for (int jx = 0; jx < 8; ++jx) v[jx] = (f16)(o[8 * d8 + jx] * rl);
            *(f16x8*)(yp + 8 * d8) = v; }
    }
}
namespace att {
typedef _Float16 h8 __attribute__((ext_vector_type(8)));
typedef float f32x16 __attribute__((ext_vector_type(16)));
typedef short v4i16 __attribute__((ext_vector_type(4)));
typedef unsigned u32x4 __attribute__((ext_vector_type(4)));
typedef const LAS char* lcp;
constexpr int SLOTB = 8192, LDS_K = 0, LDS_V = 2 * SLOTB, LDS_WS = 4 * SLOTB, LDS_OST = LDS_WS + 8 * 256, LDS_TOTAL = LDS_OST + 8 * 4096;
constexpr float THRL = 8.0f;
__device__ __forceinline__ int crow(int r, int hi) { return (r & 3) + 8 * (r >> 2) + 4 * hi; }
__device__ __forceinline__ float max3f(float a, float b, float c) { float r; asm("v_max3_f32 %0, %1, %2, %3" : "=v"(r) : "v"(a), "v"(b), "v"(c)); return r; }
__device__ __forceinline__ h8 vtr2(lcp p) {
    const v4i16 lo = __builtin_amdgcn_ds_read_tr16_b64_v4i16((LAS v4i16*)p), hi = __builtin_amdgcn_ds_read_tr16_b64_v4i16((LAS v4i16*)(p + 512));
    typedef short s8 __attribute__((ext_vector_type(8)));
    const s8 v = {lo[0], lo[1], lo[2], lo[3], hi[0], hi[1], hi[2], hi[3]}; return __builtin_bit_cast(h8, v); }

__device__ __forceinline__ void attn_unit(const Ctx& c, int b, int h, int qb) {
    const f16* Z = wsp<f16>(c, WS_Z); const float* KMN = wsp<float>(c, WS_KMEAN); f16* Y = wsp<f16>(c, WS_Y);
    int lane = c.lane; asm volatile("" : "+v"(lane));
    const int r32 = lane & 31, hi = lane >> 5, wid = c.wid;
    const size_t rowbase = (size_t)b * SEQ; const int q0 = qb * 256;
    const f16* Kh = Z + rowbase * DIN + ZK + h * 64; const f16* Vh = Z + rowbase * DIN + ZV + h * 64;
    const f16* ksrc = Kh + (size_t)lane * DIN + wid * 8;
    const f16* vsrc = Vh + (size_t)(16 * (wid & 3) + (lane >> 2)) * DIN + (wid >> 2) * 32 + (lane & 3) * 8;
    LAS unsigned char* lds = c.lds;
#define ATT_DMA(tile, slot) do { \
        __builtin_amdgcn_global_load_lds((const unsigned*)(ksrc + (size_t)(tile) * 64 * DIN), (LAS unsigned*)(lds + LDS_K + (slot) * SLOTB + wid * 1024), 16, 0, 0); \
        __builtin_amdgcn_global_load_lds((const unsigned*)(vsrc + (size_t)(tile) * 64 * DIN), (LAS unsigned*)(lds + LDS_V + (slot) * SLOTB + wid * 1024), 16, 0, 0); } while (0)
    ATT_DMA(4 * qb, 0);
    const f16* Qw = Z + (rowbase + q0 + wid * 32 + r32) * DIN + ZQ + h * 64 + hi * 8;
    h8 qr[4];
#pragma unroll
    for (int d0 = 0; d0 < 4; ++d0) qr[d0] = *(const h8*)(Qw + d0 * 16);
    unsigned allowed = (1u << qb) - 1u;
    if (qb > 3) {
        float gate[8];
#pragma unroll
        for (int nb = 0; nb < 7; ++nb) { float s = 0.f;
            if (nb < qb) { const float* kp = KMN + (size_t)(b * 8 + nb) * 512 + h * 64 + hi * 8;
#pragma unroll
                for (int d0 = 0; d0 < 4; ++d0) { const f32x4 k0 = *(const f32x4*)(kp + d0 * 16), k1 = *(const f32x4*)(kp + d0 * 16 + 4);
#pragma unroll
                    for (int j = 0; j < 4; ++j) s += (float)qr[d0][j] * k0[j] + (float)qr[d0][4 + j] * k1[j]; }
                s += __shfl_xor(s, 32); }
            gate[nb] = s; }
        gate[7] = 0.f; allowed = 0u;
#pragma unroll
        for (int nb = 0; nb < 7; ++nb) { int rank = 0;
#pragma unroll
            for (int o = 0; o < 7; ++o) if (o < qb && o != nb && (gate[o] > gate[nb] || (gate[o] == gate[nb] && o < nb))) ++rank;
            if (nb < qb && rank < 3) allowed |= 1u << nb; }
    }
    const float slope2 = exp2f(-(float)(h + 1)) * LOG2E;
    float kmx = 0.f;
    { const float* kx = wsp<float>(c, WS_KMAX) + (size_t)b * 64 + h;
#pragma unroll
      for (int nb = 0; nb < 8; ++nb) if (nb <= qb) kmx = fmaxf(kmx, kx[nb * 8]); }
    float qn = 0.f;
#pragma unroll
    for (int d0 = 0; d0 < 4; ++d0)
#pragma unroll
        for (int j = 0; j < 8; ++j) qn += (float)qr[d0][j] * (float)qr[d0][j];
    qn += __shfl_xor(qn, 32);
    const float qmw = __int_as_float(__builtin_amdgcn_readfirstlane(__float_as_int(sqrtf(wave_max(qn)))));
    { LAS float* qx = (LAS float*)(lds + LDS_TOTAL); if (lane == 0) qx[wid] = qmw; }
    const int qrel = wid * 32 + r32;
    float mhat = 0.f, l_reg = 0.f; f32x16 o[2];
#pragma unroll
    for (int r = 0; r < 16; ++r) { o[0][r] = 0.f; o[1][r] = 0.f; }
    LAS float* wsf = (LAS float*)(lds + LDS_WS) + wid * 64; LAS float* wsfh = wsf + 4 * hi;
    const lcp kp0 = (lcp)(lds + LDS_K) + hi * 1024 + r32 * 16;
    const lcp vp0 = (lcp)(lds + LDS_V) + ((lane >> 4) & 1) * 32 + (lane & 3) * 8 + (4 * hi + ((lane & 15) >> 2)) * 64;
    asm volatile("s_waitcnt vmcnt(0)" ::: "memory"); __syncthreads();
    float qmu = 0.f;
    { const LAS float* qx = (const LAS float*)(lds + LDS_TOTAL);
#pragma unroll
      for (int w = 0; w < 8; ++w) qmu = fmaxf(qmu, qx[w]); }
    const float rs2 = 1.0f / slope2;
    int tile_lo = (int)ceilf(((float)(q0 - 63) - (2.0f * qmu * kmx + 30.0f) * rs2) * (1.0f / 64.0f));
    tile_lo = tile_lo < 0 ? 0 : (tile_lo > 4 * qb ? 4 * qb : tile_lo); tile_lo = __builtin_amdgcn_readfirstlane(tile_lo);
    const float bw = 2.0f * qmw * kmx + 30.0f;
    const int NT = 4 + 4 * qb - tile_lo;
    bool started = false;
    for (int s = 0; s < NT; ++s) {
        const int tile = s < 4 ? 4 * qb + s : tile_lo + s - 4, slot = s & 1;
        if (s + 1 < NT) { const int nt_ = (s + 1) < 4 ? 4 * qb + s + 1 : tile_lo + s - 3; ATT_DMA(nt_, slot ^ 1); }
        const bool band = s < 4;
        const bool okrow = band ? true : (((allowed >> (tile >> 2)) & 1u) != 0u);
        const bool inreach = slope2 * (float)(q0 + 32 * wid - 64 * tile - 63) <= bw;
        const bool active = (band ? (64 * s <= 32 * wid + 31) : (__any(okrow) != 0)) && inreach;
        if (active) {
            const float NEG = -INFINITY;
            const float base = okrow ? (slope2 * (float)(64 * tile - (q0 + qrel) + 4 * hi) - mhat) : NEG, base1 = base + 32.0f * slope2;
            f32x16 p0, p1;
#pragma unroll
            for (int r = 0; r < 16; ++r) { const float kc = (float)((r & 3) + 8 * (r >> 2)); p0[r] = __builtin_fmaf(slope2, kc, base); p1[r] = __builtin_fmaf(slope2, kc, base1); }
            { const lcp kb = kp0 + slot * SLOTB; h8 kf[8];
#pragma unroll
              for (int d0 = 0; d0 < 4; ++d0) { kf[2 * d0] = *(const LAS h8*)(kb + d0 * 2048); kf[2 * d0 + 1] = *(const LAS h8*)(kb + d0 * 2048 + 512); }
              asm volatile("" : "+v"(kf[0]), "+v"(kf[1]), "+v"(kf[2]), "+v"(kf[3]), "+v"(kf[4]), "+v"(kf[5]), "+v"(kf[6]), "+v"(kf[7]));
#pragma unroll
              for (int d0 = 0; d0 < 4; ++d0) { p0 = __builtin_amdgcn_mfma_f32_32x32x16_f16(kf[2 * d0], qr[d0], p0, 0, 0, 0); p1 = __builtin_amdgcn_mfma_f32_32x32x16_f16(kf[2 * d0 + 1], qr[d0], p1, 0, 0, 0); } }
            asm volatile("s_nop 15\n\ts_nop 7" : "+v"(p0), "+v"(p1));
            if (band && (64 * s + 63 > 32 * wid)) { const int kb_ = 64 * s + 4 * hi;
#pragma unroll
                for (int r = 0; r < 16; ++r) { const int kv = kb_ + (r & 3) + 8 * (r >> 2); p0[r] = (kv > qrel) ? NEG : p0[r]; p1[r] = (kv + 32 > qrel) ? NEG : p1[r]; } }
            float rm;
            { float ma = max3f(p0[0], p0[1], p1[0]), mb = max3f(p0[2], p0[3], p1[1]); ma = max3f(ma, p1[2], p1[3]);
#pragma unroll
              for (int r = 4; r < 16; r += 4) { ma = max3f(ma, p0[r], p0[r + 1]); mb = max3f(mb, p0[r + 2], p0[r + 3]); ma = max3f(ma, p1[r], p1[r + 1]); mb = max3f(mb, p1[r + 2], p1[r + 3]); }
              rm = max3f(ma, mb, mb); }
            rm = fmaxf(rm, __shfl_xor(rm, 32));
            if (!started || __any(rm > THRL)) {
                const float dl = (!started) ? rm : fmaxf(rm, 0.f);
                mhat += dl;
#pragma unroll
                for (int r = 0; r < 16; ++r) { p0[r] -= dl; p1[r] -= dl; }
                if (started) { const float f = __builtin_amdgcn_exp2f(-dl); l_reg *= f; if (hi == 0) wsf[r32] = f;
#pragma unroll
                    for (int r = 0; r < 16; ++r) { const float fr_ = wsfh[(r & 3) + 8 * (r >> 2)]; o[0][r] *= fr_; o[1][r] *= fr_; } }
            }
            started = true;
            float sacc = 0.f;
#pragma unroll
            for (int r = 0; r < 16; ++r) { p0[r] = __builtin_amdgcn_exp2f(p0[r]); p1[r] = __builtin_amdgcn_exp2f(p1[r]); sacc += p0[r] + p1[r]; }
            l_reg += sacc;
            h8 pa[4];
#pragma unroll
            for (int j = 0; j < 8; ++j) { pa[0][j] = (f16)p0[j]; pa[1][j] = (f16)p0[8 + j]; pa[2][j] = (f16)p1[j]; pa[3][j] = (f16)p1[8 + j]; }
            const lcp vp = vp0 + slot * SLOTB;
#pragma unroll
            for (int d0 = 0; d0 < 2; ++d0) { h8 vf[4];
#pragma unroll
                for (int ks = 0; ks < 4; ++ks) vf[ks] = vtr2(vp + d0 * 4096 + ks * 1024);
#pragma unroll
                for (int ks = 0; ks < 4; ++ks) o[d0] = __builtin_amdgcn_mfma_f32_32x32x16_f16(pa[ks], vf[ks], o[d0], 0, 0, 0); }
        }
        asm volatile("s_waitcnt vmcnt(0)" ::: "memory"); __syncthreads();
    }
    l_reg += __shfl_xor(l_reg, 32);
    if (hi == 0) wsf[32 + r32] = l_reg;
    int hi4 = 4 * hi; asm volatile("" : "+v"(hi4));
    LAS float* wl = wsf + 32 + hi4;
    LAS f16* stg = (LAS f16*)(lds + LDS_OST) + wid * 2048 + hi4 * 64 + r32;
#pragma unroll
    for (int r = 0; r < 16; ++r) { const int kc = (r & 3) + 8 * (r >> 2); const float rl = 1.0f / wl[kc];
        stg[kc * 64] = (f16)(o[0][r] * rl); stg[kc * 64 + 32] = (f16)(o[1][r] * rl); }
    f16* Ow = Y + (rowbase + q0 + wid * 32) * D + h * 64;
    { const LAS f16* sr = (const LAS f16*)(lds + LDS_OST) + wid * 2048 + (lane >> 3) * 64 + (lane & 7) * 8; f16* og = Ow + (size_t)(lane >> 3) * D + (lane & 7) * 8;
#pragma unroll
      for (int i = 0; i < 4; ++i) { const u32x4 v = *(const LAS u32x4*)(sr + i * 512); *(u32x4*)(og + (size_t)i * 8 * D) = v; } }
    __syncthreads();
#undef ATT_DMA
}
__device__ const unsigned char ATT_ORDER[64] = {47,55,63,39,38,46,54,62,37,45,53,61,36,44,52,60,28,29,30,31,27,35,43,51,59,26,34,42,50,58,18,19,20,21,22,23,9,10,11,12,13,14,15,17,25,33,41,49,57,1,2,3,4,5,6,7,0,8,16,24,32,40,48,56};
constexpr int ATT_NBIG = 30;
}
namespace xatt {
typedef _Float16 h8 __attribute__((ext_vector_type(8)));
typedef float f32x16 __attribute__((ext_vector_type(16)));
typedef unsigned u32x4 __attribute__((ext_vector_type(4)));
typedef const LAS char* lcp;
constexpr int XSLOT = 32768, L_WSF = 140288;
__device__ __forceinline__ void xattn_unit(const Ctx& c, int l, int pm, int hh) {
    const f16* QX = wsp<f16>(c, WS_QX); const f16* KM = wsp<f16>(c, WS_KM) + (size_t)l * NMEM * D; const f16* VM = wsp<f16>(c, WS_VM) + (size_t)l * NMEM * D; f16* OC = wsp<f16>(c, WS_OC);
    int lane = c.lane; asm volatile("" : "+v"(lane));
    const int r32 = lane & 31, hi = lane >> 5, wid = c.wid, b = pm >> 3;
    LAS unsigned char* lds = c.lds;
    const f16* kbase = KM + ((size_t)b * 256 + lane) * D + hh * 256;
    const f16* vbase = VM + ((size_t)b * 256 + (lane >> 2)) * D + hh * 256 + (lane & 3) * 8;
#define XA_DMA_K(tile, slotoff) do { _Pragma("unroll") for (int j_ = 0; j_ < 4; ++j_) { const int cc_ = 4 * wid + j_; \
        __builtin_amdgcn_global_load_lds((const unsigned*)(kbase + (size_t)(tile) * 64 * D + cc_ * 8), (LAS unsigned*)(lds + (slotoff) + cc_ * 1024), 16, 0, 0); } } while (0)
#define XA_DMA_V(tile, slotoff) do { _Pragma("unroll") for (int j_ = 0; j_ < 4; ++j_) { const int pi_ = 4 * wid + j_; \
        __builtin_amdgcn_global_load_lds((const unsigned*)(vbase + ((size_t)(tile) * 64 + 16 * (pi_ & 3)) * D + (pi_ >> 2) * 32), (LAS unsigned*)(lds + (slotoff) + pi_ * 1024), 16, 0, 0); } } while (0)
#define XA_BAR(n) asm volatile("s_waitcnt vmcnt(" #n ") lgkmcnt(0)\n\ts_barrier" ::: "memory")
    const f16* Qw = QX + ((size_t)pm * 256 + wid * 32 + r32) * D + hh * 256 + hi * 8;
    h8 qr[16];
#pragma unroll
    for (int d0 = 0; d0 < 16; ++d0) qr[d0] = *(const h8*)(Qw + d0 * 16);
    XA_DMA_K(0, 0); XA_DMA_K(1, XSLOT); XA_DMA_V(0, 2 * XSLOT); XA_DMA_V(1, 3 * XSLOT);
    f32x16 p[4][2];
    const lcp kp0 = (lcp)lds + hi * 1024 + r32 * 16;
#define XA_QK(t, slotoff) do { \
        _Pragma("unroll") for (int r_ = 0; r_ < 16; ++r_) { p[t][0][r_] = 0.f; p[t][1][r_] = 0.f; } \
        _Pragma("unroll") for (int d0 = 0; d0 < 16; ++d0) { const h8 b0_ = *(const LAS h8*)(kp0 + (slotoff) + d0 * 2048), b1_ = *(const LAS h8*)(kp0 + (slotoff) + d0 * 2048 + 512); \
            p[t][0] = __builtin_amdgcn_mfma_f32_32x32x16_f16(b0_, qr[d0], p[t][0], 0, 0, 0); p[t][1] = __builtin_amdgcn_mfma_f32_32x32x16_f16(b1_, qr[d0], p[t][1], 0, 0, 0); } } while (0)
    XA_BAR(12);
    XA_QK(0, 0);
    XA_BAR(8);
    XA_DMA_K(2, 0);
    XA_QK(1, XSLOT);
    XA_BAR(0);
    XA_DMA_K(3, XSLOT);
    XA_QK(2, 0);
    XA_BAR(0);
    XA_DMA_V(2, 0);
    XA_QK(3, XSLOT);
    float mx = p[0][0][0];
#pragma unroll
    for (int t = 0; t < 4; ++t)
#pragma unroll
        for (int q = 0; q < 2; ++q)
#pragma unroll
            for (int r = 0; r < 16; ++r) mx = fmaxf(mx, p[t][q][r]);
    mx = fmaxf(mx, __shfl_xor(mx, 32));
    float lsum = 0.f; h8 pa[4][4];
#pragma unroll
    for (int t = 0; t < 4; ++t) {
#pragma unroll
        for (int q = 0; q < 2; ++q)
#pragma unroll
            for (int r = 0; r < 16; ++r) { const float e = __builtin_amdgcn_exp2f(p[t][q][r] - mx); p[t][q][r] = e; lsum += e; }
#pragma unroll
        for (int j = 0; j < 8; ++j) { pa[t][0][j] = (f16)p[t][0][j]; pa[t][1][j] = (f16)p[t][0][8 + j]; pa[t][2][j] = (f16)p[t][1][j]; pa[t][3][j] = (f16)p[t][1][8 + j]; } }
    lsum += __shfl_xor(lsum, 32);
    XA_BAR(4);
    XA_DMA_V(3, XSLOT);
    f32x16 o[8];
#pragma unroll
    for (int db = 0; db < 8; ++db)
#pragma unroll
        for (int r = 0; r < 16; ++r) o[db][r] = 0.f;
    const lcp vp0 = (lcp)lds + ((lane >> 4) & 1) * 32 + (lane & 3) * 8 + (4 * hi + ((lane & 15) >> 2)) * 64;
#define XA_PV(t, slotoff) do { _Pragma("unroll") for (int db = 0; db < 8; ++db) { h8 vf_[4]; \
        _Pragma("unroll") for (int ks = 0; ks < 4; ++ks) vf_[ks] = att::vtr2(vp0 + (slotoff) + db * 4096 + ks * 1024); \
        _Pragma("unroll") for (int ks = 0; ks < 4; ++ks) o[db] = __builtin_amdgcn_mfma_f32_32x32x16_f16(pa[t][ks], vf_[ks], o[db], 0, 0, 0); } } while (0)
    XA_PV(0, 2 * XSLOT); XA_PV(1, 3 * XSLOT);
    XA_BAR(0);
    XA_PV(2, 0); XA_PV(3, XSLOT);
    XA_BAR(0);
    LAS float* wsf = (LAS float*)(lds + L_WSF) + wid * 64;
    if (hi == 0) wsf[r32] = lsum;
    int hi4 = 4 * hi; asm volatile("" : "+v"(hi4));
    LAS float* wl = wsf + hi4;
    LAS f16* stg = (LAS f16*)(lds + wid * 16384) + hi4 * 256 + r32;
#pragma unroll
    for (int r = 0; r < 16; ++r) { const int kc = (r & 3) + 8 * (r >> 2); const float rl = 1.0f / wl[kc];
#pragma unroll
        for (int db = 0; db < 8; ++db) stg[kc * 256 + db * 32] = (f16)(o[db][r] * rl); }
    { const LAS f16* sr = (const LAS f16*)(lds + wid * 16384) + (lane >> 5) * 256 + (lane & 31) * 8; f16* og = OC + ((size_t)pm * 256 + wid * 32 + (lane >> 5)) * D + hh * 256 + (lane & 31) * 8;
#pragma unroll
      for (int i = 0; i < 16; ++i) { const u32x4 v = *(const LAS u32x4*)(sr + i * 512); *(u32x4*)(og + (size_t)i * 2 * D) = v; } }
    XA_BAR(0);
#undef XA_DMA_K
#undef XA_DMA_V
#undef XA_BAR
#undef XA_QK
#undef XA_PV
}
__device__ __forceinline__ void xattn_phase(const Ctx& c, int l) {
    const int v = (c.G % 8 == 0) ? (c.bid % 8) * (c.G / 8) + c.bid / 8 : c.bid;
    for (int tr = 2 * v; tr < 512; tr += 2 * c.G) { xattn_unit(c, l, tr >> 2, tr & 3); xattn_unit(c, l, (tr + 1) >> 2, (tr + 1) & 3); }
}
}


constexpr int CW_LF = 12288;
namespace lru {
typedef _Float16 h8 __attribute__((ext_vector_type(8)));
constexpr int XS = 264;
constexpr int L_XC = 0, L_GL = 64 * XS * 2, L_RP = 2 * 64 * XS * 2, L_RS = L_RP + 64 * 8 * 4, L_HIN = L_RS + 64 * 4, L_END = L_HIN + 256 * 4;
__device__ __forceinline__ float sigm(float x) { return __builtin_amdgcn_rcpf(1.0f + __expf(-x)); }
template <int PASS>
__device__ __forceinline__ void lru_unit(const Ctx& c, int l, int b, int ck) {
    const f16* Z = wsp<f16>(c, WS_Z); float* ENDS = wsp<float>(c, WS_LRUENDS);
    unsigned* flags = (unsigned*)(c.ws + WS_CTL) + CW_LF; const unsigned epoch = (unsigned)l + 1u;
    int lane = c.lane; asm volatile("" : "+v"(lane));
    const int tid = c.wid * 64 + lane, fr = lane & 15, fq = lane >> 4, hd = c.wid >> 1, half = c.wid & 1;
    LAS f16* XC = (LAS f16*)(c.lds + L_XC); LAS f16* GL = (LAS f16*)(c.lds + L_GL);
    LAS float* RP = (LAS float*)(c.lds + L_RP); LAS float* RS = (LAS float*)(c.lds + L_RS); LAS float* HIN = (LAS float*)(c.lds + L_HIN);
    const size_t n0 = (size_t)b * SEQ + ck * 64;
    const float* cw = c.in[17] + l * 4 * 256; const float* cb = c.in[18] + l * 256;
    h8 wa[2][2], wx[2][2];
    { const f16* wat = wsp<f16>(c, WS_WLA_T) + (size_t)(l * 4 + hd) * 4096; const f16* wxt = wsp<f16>(c, WS_WLX_T) + (size_t)(l * 4 + hd) * 4096;
#pragma unroll
      for (int ks = 0; ks < 2; ++ks)
#pragma unroll
          for (int n = 0; n < 2; ++n) { wa[ks][n] = *(const h8*)(wat + (half * 32 + 16 * n + fr) * 64 + 32 * ks + 8 * fq); wx[ks][n] = *(const h8*)(wxt + (half * 32 + 16 * n + fr) * 64 + 32 * ks + 8 * fq); } }
    { const int cg = tid & 31, t0 = (tid >> 5) * 4;
      f32x4 w0[4], w1[4];
#pragma unroll
      for (int j = 0; j < 4; ++j) { w0[j] = *(const f32x4*)(cw + j * 256 + 8 * cg); w1[j] = *(const f32x4*)(cw + j * 256 + 8 * cg + 4); }
      const f32x4 b0 = *(const f32x4*)(cb + 8 * cg), b1 = *(const f32x4*)(cb + 8 * cg + 4);
      h8 xr[7];
#pragma unroll
      for (int q = 0; q < 7; ++q) { const int tt = ck * 64 + t0 - 3 + q;
          if (tt >= 0) xr[q] = *(const h8*)(Z + (n0 + t0 - 3 + q) * DIN + ZXL + 8 * cg);
          else {
#pragma unroll
              for (int e = 0; e < 8; ++e) xr[q][e] = (f16)0.f; } }
      if (PASS >= 1) {
#pragma unroll
          for (int q = 0; q < 4; ++q) *(LAS h8*)(GL + (t0 + q) * XS + 8 * cg) = *(const h8*)(Z + (n0 + t0 + q) * DIN + ZGL + 8 * cg); }
#pragma unroll
      for (int q = 0; q < 4; ++q) { float a8[8];
#pragma unroll
          for (int e = 0; e < 4; ++e) { a8[e] = b0[e]; a8[4 + e] = b1[e]; }
#pragma unroll
          for (int j = 0; j < 4; ++j)
#pragma unroll
              for (int e = 0; e < 4; ++e) { a8[e] += w0[j][e] * (float)xr[q + j][e]; a8[4 + e] += w1[j][e] * (float)xr[q + j][4 + e]; }
          h8 o;
#pragma unroll
          for (int e = 0; e < 8; ++e) o[e] = (f16)a8[e];
          *(LAS h8*)(XC + (t0 + q) * XS + 8 * cg) = o; } }
    if (PASS == 1 && tid < 256) {
        const float* ep = ENDS + ((size_t)b * 32) * 512 + tid; float hin = 0.f;
#pragma unroll 8
        for (int cc = 0; cc < ck; ++cc) hin = ep[cc * 512] * hin + ep[cc * 512 + 256];
        HIN[tid] = hin;
    }
    __syncthreads();
    f32x4 ra[4][2], ia[4][2];
#pragma unroll
    for (int m = 0; m < 4; ++m)
#pragma unroll
        for (int n = 0; n < 2; ++n) { ra[m][n] = (f32x4){0.f, 0.f, 0.f, 0.f}; ia[m][n] = (f32x4){0.f, 0.f, 0.f, 0.f}; }
    {
#pragma unroll
      for (int ks = 0; ks < 2; ++ks) { h8 af[4];
#pragma unroll
          for (int m = 0; m < 4; ++m) af[m] = *(const LAS h8*)(XC + (16 * m + fr) * XS + hd * 64 + 32 * ks + 8 * fq);
#pragma unroll
          for (int m = 0; m < 4; ++m)
#pragma unroll
              for (int n = 0; n < 2; ++n) { ra[m][n] = __builtin_amdgcn_mfma_f32_16x16x32_f16(af[m], wa[ks][n], ra[m][n], 0, 0, 0); ia[m][n] = __builtin_amdgcn_mfma_f32_16x16x32_f16(af[m], wx[ks][n], ia[m][n], 0, 0, 0); } } }
    const int ch0 = hd * 64 + half * 32 + fr;
#pragma unroll
    for (int n = 0; n < 2; ++n) { const int chn = ch0 + 16 * n;
        const float lm = c.in[23][l * 256 + chn], sp8 = 8.0f * (fmaxf(-lm, 0.f) + log1pf(__expf(-fabsf(lm)))), ba = c.in[20][l * 256 + chn], bx = c.in[22][l * 256 + chn];
#pragma unroll
        for (int m = 0; m < 4; ++m) { float p = 1.f, hh = 0.f;
#pragma unroll
            for (int e = 0; e < 4; ++e) { const float r = sigm(ra[m][n][e] + ba), ig = sigm(ia[m][n][e] + bx), la = -sp8 * r, a = __expf(la), x2 = 2.0f * la;
                const float em_s = -x2 * (1.0f + x2 * (0.5f + x2 * (0.16666667f + x2 * (0.041666668f + x2 * (0.0083333338f + x2 * 0.0013888889f)))));
                const float em = x2 > -0.5f ? em_s : 1.0f - a * a;
                const float bt = sqrtf(em) * (ig * (float)XC[(16 * m + 4 * fq + e) * XS + chn]);
                p *= a; hh = a * hh + bt; ra[m][n][e] = p; ia[m][n][e] = hh; } } }
    float xp[4][2], xh[4][2], tp[4][2], th[4][2];
#pragma unroll
    for (int m = 0; m < 4; ++m)
#pragma unroll
        for (int n = 0; n < 2; ++n) { const float PT = ra[m][n][3], HT = ia[m][n][3]; float cp = 1.f, chh = 0.f;
#pragma unroll
            for (int k = 0; k < 3; ++k) { const float pk = __shfl(PT, fr + 16 * k), hk = __shfl(HT, fr + 16 * k); if (fq > k) { chh = pk * chh + hk; cp *= pk; } }
            xp[m][n] = cp; xh[m][n] = chh; const float ip = cp * PT, ih = PT * chh + HT; tp[m][n] = __shfl(ip, fr + 48); th[m][n] = __shfl(ih, fr + 48); }
    if (PASS == 0) {
        if (fq == 0) {
#pragma unroll
            for (int n = 0; n < 2; ++n) { float CP = 1.f, CH = 0.f;
#pragma unroll
                for (int m = 0; m < 4; ++m) { CH = tp[m][n] * CH + th[m][n]; CP *= tp[m][n]; }
                float* ep = ENDS + ((size_t)b * 32 + ck) * 512 + ch0 + 16 * n; ep[0] = CP; ep[256] = CH; } }
        __syncthreads();
    } else {
        if (PASS == 2) {
            if (fq == 0) {
#pragma unroll
                for (int n = 0; n < 2; ++n) { float CP = 1.f, CH = 0.f;
#pragma unroll
                    for (int m = 0; m < 4; ++m) { CH = tp[m][n] * CH + th[m][n]; CP *= tp[m][n]; }
                    float* ep = ENDS + ((size_t)b * 32 + ck) * 512 + ch0 + 16 * n;
                    __hip_atomic_store(ep, CP, __ATOMIC_RELAXED, __HIP_MEMORY_SCOPE_AGENT); __hip_atomic_store(ep + 256, CH, __ATOMIC_RELAXED, __HIP_MEMORY_SCOPE_AGENT); } }
            asm volatile("s_waitcnt vmcnt(0)" ::: "memory");
            __syncthreads();
            if (tid == 0) __hip_atomic_store(flags + b * 32 + ck, epoch, __ATOMIC_RELAXED, __HIP_MEMORY_SCOPE_AGENT);
            if (c.wid == 0) { unsigned spins = 0;
                for (;;) { const unsigned v = (lane < ck) ? __hip_atomic_load(flags + b * 32 + (lane & 31), __ATOMIC_RELAXED, __HIP_MEMORY_SCOPE_AGENT) : epoch;
                    if (__all(v >= epoch)) break; __builtin_amdgcn_s_sleep(2); if (++spins > (1u << 22)) break; } }
            __syncthreads();
            if (tid < 256) { const float* ep = ENDS + ((size_t)b * 32) * 512 + tid; float hin = 0.f;
#pragma unroll 8
                for (int cc = 0; cc < ck; ++cc) { const float P = __hip_atomic_load(ep + cc * 512, __ATOMIC_RELAXED, __HIP_MEMORY_SCOPE_AGENT), Hh = __hip_atomic_load(ep + cc * 512 + 256, __ATOMIC_RELAXED, __HIP_MEMORY_SCOPE_AGENT); hin = P * hin + Hh; }
                HIN[tid] = hin; }
            __syncthreads();
        }
        float ssq[4][4];
#pragma unroll
        for (int m = 0; m < 4; ++m)
#pragma unroll
            for (int e = 0; e < 4; ++e) ssq[m][e] = 0.f;
#pragma unroll
        for (int n = 0; n < 2; ++n) { const int chn = ch0 + 16 * n; float hs = HIN[chn];
#pragma unroll
            for (int m = 0; m < 4; ++m) { const float hseg = xp[m][n] * hs + xh[m][n];
#pragma unroll
                for (int e = 0; e < 4; ++e) { const float hv = ra[m][n][e] * hseg + ia[m][n][e]; const float g = (float)GL[(16 * m + 4 * fq + e) * XS + chn];
                    const float u2 = 1.5957691216f * (g + 0.044715f * g * g * g), ov = hv * g * sigm(u2); ia[m][n][e] = ov; ssq[m][e] += ov * ov; }
                hs = tp[m][n] * hs + th[m][n]; } }
#pragma unroll
        for (int m = 0; m < 4; ++m)
#pragma unroll
            for (int e = 0; e < 4; ++e) { float v = ssq[m][e]; v += __shfl_xor(v, 1); v += __shfl_xor(v, 2); v += __shfl_xor(v, 4); v += __shfl_xor(v, 8); if (fr == 0) RP[(16 * m + 4 * fq + e) * 8 + c.wid] = v; }
        __syncthreads();
        if (tid < 64) { float s = 0.f;
#pragma unroll
            for (int w = 0; w < 8; ++w) s += RP[tid * 8 + w];
            RS[tid] = 1.0f / sqrtf(s * (1.0f / 256.0f) + 1e-6f); }
        __syncthreads();
#pragma unroll
        for (int m = 0; m < 4; ++m)
#pragma unroll
            for (int e = 0; e < 4; ++e) { const int t = 16 * m + 4 * fq + e; const float rs = RS[t];
#pragma unroll
                for (int n = 0; n < 2; ++n) XC[t * XS + ch0 + 16 * n] = (f16)(ia[m][n][e] * rs); }
        __syncthreads();
        f16* Y = wsp<f16>(c, WS_Y);
        for (int it = tid; it < 2048; it += 512) { const int t = it >> 5, cg = it & 31; *(h8*)(Y + (n0 + t) * D + 768 + 8 * cg) = *(const LAS h8*)(XC + t * XS + 8 * cg); }
        __syncthreads();
    }
}
template <int PASS> __device__ __forceinline__ void lru_phase(const Ctx& c, int l) {
    for (int u = c.bid; u < 512; u += c.G) lru_unit<PASS>(c, l, u >> 5, u & 31);
}
}

namespace s5 {
typedef _Float16 h8 __attribute__((ext_vector_type(8)));
__device__ __forceinline__ void tables1(const Ctx& c) {
    float* AP = wsp<float>(c, WS_S5AP); float* BB = wsp<float>(c, WS_S5BB);
    for (int it = c.bid * 512 + c.tid; it < DEPTH * 16 * 64; it += c.G * 512) {
        const int p = it & 63, lg = it >> 6;
        const float dt = expf(c.in[14][lg]), are = c.in[7][it], aim = c.in[8][it];
        const float mag = expf(dt * are), abr = mag * cosf(dt * aim), abi = mag * sinf(dt * aim);
        const float den = are * are + aim * aim, nr = abr - 1.0f, ni = abi, fre = (nr * are + ni * aim) / den, fim = (ni * are - nr * aim) / den;
        float pr = 1.0f, pi = 0.0f;
        for (int tau = 0; tau <= 32; ++tau) { AP[((size_t)lg * 33 + tau) * 128 + p] = pr; AP[((size_t)lg * 33 + tau) * 128 + 64 + p] = pi; const float nr2 = pr * abr - pi * abi, ni2 = pr * abi + pi * abr; pr = nr2; pi = ni2; }
        { f32x4 br4[4], bi4[4];
#pragma unroll
          for (int q = 0; q < 4; ++q) { br4[q] = *(const f32x4*)(c.in[9] + (size_t)it * 16 + 4 * q); bi4[q] = *(const f32x4*)(c.in[10] + (size_t)it * 16 + 4 * q); }
#pragma unroll
          for (int q = 0; q < 4; ++q) { f32x4 o0, o1;
#pragma unroll
              for (int e = 0; e < 4; ++e) { o0[e] = fre * br4[q][e] - fim * bi4[q][e]; o1[e] = fre * bi4[q][e] + fim * br4[q][e]; }
              *(f32x4*)(BB + ((size_t)lg * 64 + p) * 32 + 4 * q) = o0; *(f32x4*)(BB + ((size_t)lg * 64 + p) * 32 + 16 + 4 * q) = o1; } }
    }
}
__device__ __forceinline__ void tables2(const Ctx& c) {
    const float* AP = wsp<float>(c, WS_S5AP); const float* BB = wsp<float>(c, WS_S5BB); float* KK = wsp<float>(c, WS_S5KK);
    f16* WE = wsp<f16>(c, WS_S5WEND); f16* T = wsp<f16>(c, WS_S5T);
    const size_t gt = (size_t)c.bid * 512 + c.tid, GT = (size_t)c.G * 512;
    for (size_t it = gt; it < (size_t)DEPTH * 16 * 32 * 256; it += GT) {
        const int h = (int)(it & 15), hp = (int)((it >> 4) & 15), tau = (int)((it >> 8) & 31), lg = (int)(it >> 13);
        const float* cr = c.in[11] + ((size_t)lg * 16 + hp) * 64; const float* ci = c.in[12] + ((size_t)lg * 16 + hp) * 64;
        const float* ap = AP + ((size_t)lg * 33 + tau) * 128; const float* bb = BB + (size_t)lg * 64 * 32 + h;
        float s = 0.f;
        for (int p = 0; p < 64; ++p) { const float er = cr[p] * ap[p] - ci[p] * ap[64 + p], ei = cr[p] * ap[64 + p] + ci[p] * ap[p]; s += er * bb[p * 32] - ei * bb[p * 32 + 16]; }
        KK[it] = s / expf(c.in[14][lg]);
    }
    for (size_t it = gt; it < (size_t)DEPTH * 16 * 128 * 512; it += GT) {
        const int kk = (int)(it & 511), pp = (int)((it >> 9) & 127), lg = (int)(it >> 16), p = pp & 63, s = kk >> 4, h = kk & 15;
        const float* ap = AP + ((size_t)lg * 33 + (31 - s)) * 128; const float* bb = BB + ((size_t)lg * 64 + p) * 32 + h;
        const float ar = ap[p], ai = ap[64 + p], br = bb[0], bi = bb[16];
        WE[it] = (f16)(((pp < 64) ? (ar * br - ai * bi) : (ar * bi + ai * br)) / expf(c.in[14][lg]));
    }
    for (size_t it = gt; it < (size_t)DEPTH * 16 * 512 * 128; it += GT) {
        const int pp = (int)(it & 127), row = (int)((it >> 7) & 511), lg = (int)(it >> 16), p = pp & 63, t = row >> 4, hp = row & 15;
        const float cr = c.in[11][((size_t)lg * 16 + hp) * 64 + p], ci = c.in[12][((size_t)lg * 16 + hp) * 64 + p];
        const float* ap = AP + ((size_t)lg * 33 + (t + 1)) * 128; const float ar = ap[p], ai = ap[64 + p];
        T[((size_t)lg * 512 + row) * 640 + 512 + pp] = (f16)((pp < 64) ? (cr * ar - ci * ai) : -(cr * ai + ci * ar));
    }
}
__device__ __forceinline__ void tables3(const Ctx& c) {
    const float* KK = wsp<float>(c, WS_S5KK); f16* T = wsp<f16>(c, WS_S5T);
    for (size_t it = (size_t)c.bid * 512 + c.tid; it < (size_t)DEPTH * 16 * 512 * 64; it += (size_t)c.G * 512) {
        const int k8 = (int)(it & 63), row = (int)((it >> 6) & 511), lg = (int)(it >> 15), s = k8 >> 1, h0 = (k8 & 1) * 8, t = row >> 4, hp = row & 15;
        h8 o;
        if (s <= t) { const float* kp = KK + (((size_t)lg * 32 + (t - s)) * 16 + hp) * 16 + h0; const f32x4 a = *(const f32x4*)kp, b = *(const f32x4*)(kp + 4);
#pragma unroll
            for (int e = 0; e < 4; ++e) { o[e] = (f16)a[e]; o[4 + e] = (f16)b[e]; } }
        else {
#pragma unroll
            for (int e = 0; e < 8; ++e) o[e] = (f16)0.f; }
        *(h8*)(T + ((size_t)lg * 512 + row) * 640 + 8 * k8) = o;
    }
}
__device__ __forceinline__ void carry_phase(const Ctx& c, int l) {
    f16* UG = wsp<f16>(c, WS_UG); const f16* WE = wsp<f16>(c, WS_S5WEND) + (size_t)l * 16 * 128 * 512; const float* AP = wsp<float>(c, WS_S5AP);
    int lane = c.lane; asm volatile("" : "+v"(lane));
    const int fr = lane & 15, fq = lane >> 4, tid = c.wid * 64 + lane;
    constexpr int AS = 520;
    LAS f16* AL = (LAS f16*)c.lds;
    LAS float* XL = (LAS float*)(c.lds + 67584);
    for (int u = c.bid; u < 256; u += c.G) { const int g = u >> 4, b = u & 15;
        const f16* arow = UG + ((size_t)g * 1024 + b * 64) * 640; const f16* wrow = WE + ((size_t)g * 128 + c.wid * 16 + fr) * 512;
#pragma unroll
        for (int i = 0; i < 8; ++i) { const int idx = tid + i * 512, r = idx >> 6, cg = idx & 63; *(LAS h8*)(AL + r * AS + 8 * cg) = *(const h8*)(arow + (size_t)r * 640 + 8 * cg); }
        h8 bf[16];
#pragma unroll
        for (int ks = 0; ks < 16; ++ks) bf[ks] = *(const h8*)(wrow + 32 * ks + 8 * fq);
        __syncthreads();
        f32x4 acc[4];
#pragma unroll
        for (int m = 0; m < 4; ++m) acc[m] = (f32x4){0.f, 0.f, 0.f, 0.f};
#pragma unroll
        for (int ks = 0; ks < 16; ++ks) {
#pragma unroll
            for (int m = 0; m < 4; ++m) { const h8 af = *(const LAS h8*)(AL + (16 * m + fr) * AS + 32 * ks + 8 * fq); acc[m] = __builtin_amdgcn_mfma_f32_16x16x32_f16(af, bf[ks], acc[m], 0, 0, 0); } }
#pragma unroll
        for (int m = 0; m < 4; ++m)
#pragma unroll
            for (int e = 0; e < 4; ++e) XL[(16 * m + 4 * fq + e) * 128 + c.wid * 16 + fr] = acc[m][e];
        __syncthreads();
        if (tid < 64) { const float* ap = AP + ((size_t)(l * 16 + g) * 33 + 32) * 128; const float ar = ap[tid], ai = ap[64 + tid]; float xr = 0.f, xi = 0.f;
            f16* xo = UG + ((size_t)g * 1024 + b * 64) * 640 + 512 + tid;
            for (int cc = 0; cc < 64; ++cc) { xo[(size_t)cc * 640] = (f16)xr; xo[(size_t)cc * 640 + 64] = (f16)xi;
                const float lr = XL[cc * 128 + tid], li = XL[cc * 128 + 64 + tid]; const float nr = ar * xr - ai * xi + lr, ni = ar * xi + ai * xr + li; xr = nr; xi = ni; } }
        __syncthreads();
    }
}
}

__device__ __forceinline__ void ph_s5_naive(const Ctx& c, int l) {
    const f16* Z = wsp<f16>(c, WS_Z); f16* YA = wsp<f16>(c, WS_YACT);
    const int gw = c.wid * c.G + c.bid, NGW = c.G * 8, p = c.lane;
    for (int u = gw; u < 256; u += NGW) {
        const int b = u >> 4, g = u & 15;
        const double dt = exp((double)c.in[14][l * 16 + g]);
        const double are = c.in[7][(l * 16 + g) * 64 + p], aim = c.in[8][(l * 16 + g) * 64 + p];
        const double mag = exp(dt * are), abr = mag * cos(dt * aim), abi = mag * sin(dt * aim);
        const double den = are * are + aim * aim, nr = abr - 1.0, ni = abi;
        const double fre = (nr * are + ni * aim) / den, fim = (ni * are - nr * aim) / den;
        float bbr[16], bbi[16], cr[16], ci[16];
#pragma unroll
        for (int h = 0; h < 16; ++h) {
            const double br = c.in[9][((size_t)(l * 16 + g) * 64 + p) * 16 + h], bi = c.in[10][((size_t)(l * 16 + g) * 64 + p) * 16 + h];
            bbr[h] = (float)(fre * br - fim * bi); bbi[h] = (float)(fre * bi + fim * br);
            cr[h] = c.in[11][((size_t)(l * 16 + g) * 16 + h) * 64 + p]; ci[h] = c.in[12][((size_t)(l * 16 + g) * 16 + h) * 64 + p];
        }
        const float ar = (float)abr, ai = (float)abi;
        const float dsk = c.lane < 16 ? c.in[13][l * 256 + g * 16 + c.lane] : 0.f;
        float xr = 0.f, xi = 0.f;
        for (int t = 0; t < SEQ; ++t) {
            const size_t n = (size_t)b * SEQ + t;
            const f16* up = Z + n * DIN + ZU + g * 16; const f16x8 u0 = *(const f16x8*)up, u1 = *(const f16x8*)(up + 8);
            float uu[16];
#pragma unroll
            for (int h = 0; h < 8; ++h) { uu[h] = (float)u0[h]; uu[8 + h] = (float)u1[h]; }
            float br = 0.f, bi = 0.f;
#pragma unroll
            for (int h = 0; h < 16; ++h) { br += bbr[h] * uu[h]; bi += bbi[h] * uu[h]; }
            const float nxr = ar * xr - ai * xi + br, nxi = ar * xi + ai * xr + bi; xr = nxr; xi = nxi;
            float yv = 0.f;
#pragma unroll
            for (int h = 0; h < 16; ++h) { const float s = wave_sum(cr[h] * xr - ci[h] * xi); if (c.lane == h) yv = s; }
            float ul = 0.f;
#pragma unroll
            for (int h = 0; h < 16; ++h) if (c.lane == h) ul = uu[h];
            if (c.lane < 16) YA[n * 256 + g * 16 + c.lane] = (f16)gelu_tanh(yv + dsk * ul);
        }
    }
}
__device__ __forceinline__ void ph_lru_conv(const Ctx& c, int l) {
    const f16* Z = wsp<f16>(c, WS_Z); float* XC = wsp<float>(c, WS_XC);
    const float* cw = c.in[17] + l * 4 * 256; const float* cb = c.in[18] + l * 256;
    for (size_t it = (size_t)c.bid * 512 + c.tid; it < (size_t)NTOK * 256; it += (size_t)c.G * 512) {
        const int ch = (int)(it & 255); const size_t n = it >> 8; const int t = (int)(n & 2047);
        float s = cb[ch];
#pragma unroll
        for (int j = 0; j < 4; ++j) { const int tt = t - 3 + j; if (tt >= 0) s += cw[j * 256 + ch] * (float)Z[(n - 3 + j) * DIN + ZXL + ch]; }
        XC[it] = s;
    }
}
__device__ __forceinline__ void ph_lru_gate(const Ctx& c, int l) {
    const float* XC = wsp<float>(c, WS_XC); float* LA = wsp<float>(c, WS_LA); float* LB = wsp<float>(c, WS_LB);
    const float* wa = c.in[19] + (size_t)l * 4 * 64 * 64; const float* wx = c.in[21] + (size_t)l * 4 * 64 * 64;
    const float* ba = c.in[20] + l * 256; const float* bx = c.in[22] + l * 256; const float* lam = c.in[23] + l * 256;
    for (size_t it = (size_t)c.bid * 512 + c.tid; it < (size_t)NTOK * 256; it += (size_t)c.G * 512) {
        const int ch = (int)(it & 255), hd = ch >> 6, j = ch & 63; const size_t n = it >> 8;
        const float* xp = XC + n * 256 + hd * 64; const float* wap = wa + (size_t)hd * 4096 + j; const float* wxp = wx + (size_t)hd * 4096 + j;
        float sa = ba[ch], sx = bx[ch];
        for (int i = 0; i < 64; ++i) { const float xv = xp[i]; sa += xv * wap[i * 64]; sx += xv * wxp[i * 64]; }
        const float r = sigmoidf_(sa), ig = sigmoidf_(sx);
        const float lm = lam[ch], sp = fmaxf(-lm, 0.f) + log1pf(expf(-fabsf(lm)));
        const float log_a = -8.0f * r * sp;
        LA[it] = expf(log_a); LB[it] = sqrtf(-expm1f(2.0f * log_a)) * (ig * XC[it]);
    }
}
__device__ __forceinline__ void ph_lru_scan(const Ctx& c) {
    const f16* Z = wsp<f16>(c, WS_Z); const float* LA = wsp<float>(c, WS_LA); const float* LB = wsp<float>(c, WS_LB); f16* Y = wsp<f16>(c, WS_Y);
    for (int it = c.bid * 512 + c.tid; it < BATCH * 256; it += c.G * 512) {
        const int ch = it & 255, b = it >> 8; float h = 0.f;
        for (int t = 0; t < SEQ; ++t) { const size_t n = (size_t)b * SEQ + t;
            h = LA[n * 256 + ch] * h + LB[n * 256 + ch];
            Y[n * D + 768 + ch] = (f16)(h * gelu_tanh((float)Z[n * DIN + ZGL + ch])); }
    }
}
__device__ __forceinline__ void ph_norm_attn(const Ctx& c) {
    f16* Y = wsp<f16>(c, WS_Y);
    int r0, r1;
    if (c.bid < 128) { const int w = c.bid * 8 + c.wid; r0 = w * 32; r1 = r0 + 32; } else { r0 = 0; r1 = 0; }
    if (c.G != 256) { const int w = c.bid * 8 + c.wid, per = (((NTOK + c.G * 8 - 1) / (c.G * 8)) + 3) & ~3; r0 = w * per; r1 = r0 + per < NTOK ? r0 + per : NTOK; if (r0 > NTOK) r0 = NTOK; }
    for (int m = r0; m < r1; m += 4) { f16x8 v[4]; float s[4];
#pragma unroll
        for (int q = 0; q < 4; ++q) v[q] = *(const f16x8*)(Y + (size_t)(m + q) * D + 8 * c.lane);
#pragma unroll
        for (int q = 0; q < 4; ++q) { s[q] = 0.f;
#pragma unroll
            for (int i = 0; i < 8; ++i) s[q] += (float)v[q][i] * (float)v[q][i]; }
#pragma unroll
        for (int o = 1; o < 64; o <<= 1)
#pragma unroll
            for (int q = 0; q < 4; ++q) s[q] += __shfl_xor(s[q], o);
#pragma unroll
        for (int q = 0; q < 4; ++q) { const float ra = 1.0f / sqrtf(s[q] * (1.0f / 512.0f) + 1e-6f); f16x8 o;
#pragma unroll
            for (int i = 0; i < 8; ++i) o[i] = (f16)((float)v[q][i] * ra);
            *(f16x8*)(Y + (size_t)(m + q) * D + 8 * c.lane) = o; } }
}
__device__ __forceinline__ void ph_ln_inplace(const Ctx& c, const float* g, const float* b) {
    f16* H = wsp<f16>(c, WS_H); const int gw = c.wid * c.G + c.bid, NGW = c.G * 8;
    float gg[16], bb[16]; vec_load16(g, c.lane, gg); vec_load16(b, c.lane, bb);
    for (int m = gw * 4; m < NTOK; m += NGW * 4) {
        float v[4][16];
#pragma unroll
        for (int r = 0; r < 4; ++r) row_load16(H + (size_t)(m + r) * D, c.lane, v[r]);
        ln_rows<4>(v, gg, bb);
#pragma unroll
        for (int r = 0; r < 4; ++r) row_store16(H + (size_t)(m + r) * D, c.lane, v[r]);
    }
}
__device__ __forceinline__ void ph_xattn_naive(const Ctx& c, int l) {
    const f16* QX = wsp<f16>(c, WS_QX); const f16* KM = wsp<f16>(c, WS_KM) + (size_t)l * NMEM * D; const f16* VM = wsp<f16>(c, WS_VM) + (size_t)l * NMEM * D;
    f16* OC = wsp<f16>(c, WS_OC);
    LAS float* pl = (LAS float*)c.lds + c.wid * 256;
    const int gw = c.bid * 8 + c.wid, NGW = c.G * 8;
    for (int it = gw; it < NTOK * 4; it += NGW) {
        const int hh = it & 3; const size_t n = (size_t)(it >> 2); const int b = (int)(n >> 11);
        const f16* qp = QX + n * D + hh * 256; const f16* kb = KM + (size_t)b * 256 * D + hh * 256; const f16* vb = VM + (size_t)b * 256 * D + hh * 256;
        float s[4] = {0.f, 0.f, 0.f, 0.f};
        for (int d8 = 0; d8 < 32; ++d8) { const f16x8 qv = *(const f16x8*)(qp + 8 * d8);
#pragma unroll
            for (int kk = 0; kk < 4; ++kk) { const f16x8 kv = *(const f16x8*)(kb + (size_t)(c.lane + 64 * kk) * D + 8 * d8);
#pragma unroll
                for (int j = 0; j < 8; ++j) s[kk] += (float)qv[j] * (float)kv[j]; } }
        const float mx = wave_max(fmaxf(fmaxf(s[0], s[1]), fmaxf(s[2], s[3])));
        float ps = 0.f;
#pragma unroll
        for (int kk = 0; kk < 4; ++kk) { s[kk] = exp2f(s[kk] - mx); ps += s[kk]; }
        const float rl = 1.0f / wave_sum(ps);
#pragma unroll
        for (int kk = 0; kk < 4; ++kk) pl[c.lane + 64 * kk] = s[kk] * rl;
        asm volatile("s_waitcnt lgkmcnt(0)" ::: "memory");
        float o[4] = {0.f, 0.f, 0.f, 0.f};
        for (int key = 0; key < 256; ++key) { const float p = pl[key]; const f16x4 vv = *(const f16x4*)(vb + (size_t)key * D + 4 * c.lane);
#pragma unroll
            for (int j = 0; j < 4; ++j) o[j] += p * (float)vv[j]; }
        f16x4 ov;
#pragma unroll
        for (int j = 0; j < 4; ++j) ov[j] = (f16)o[j];
        *(f16x4*)(OC + n * D + hh * 256 + 4 * c.lane) = ov;
        asm volatile("s_waitcnt lgkmcnt(0)" ::: "memory");
    }
}
__device__ __forceinline__ void ph_ln2_route(const Ctx& c, int l) {
    typedef _Float16 h8 __attribute__((ext_vector_type(8)));
    f16* H = wsp<f16>(c, WS_H); int* TE = wsp<int>(c, WS_TOKE); float* TW = wsp<float>(c, WS_TOKW); int* HIST = wsp<int>(c, WS_HIST);
    const float* wrg = c.in[32] + (size_t)l * D * 4; const float* brg = c.in[33] + l * 4; const float* wre = c.in[34] + (size_t)l * D * 16; const float* bre = c.in[35] + l * 16;
    constexpr int WS_ = 1032;
    LAS f16* WR = (LAS f16*)c.lds;
    LAS float* LG = (LAS float*)(c.lds + 66560) + c.wid * 512;
    LAS int* hl = (LAS int*)(c.lds + 66560 + 16384);
    int lane = c.lane; asm volatile("" : "+v"(lane));
    const int fr = lane & 15, fq = lane >> 4;
    for (int k = c.tid; k < D; k += 512) { const f32x4 g4 = *(const f32x4*)(wrg + (size_t)k * 4);
        const f32x4 e0 = *(const f32x4*)(wre + (size_t)k * 16), e1 = *(const f32x4*)(wre + (size_t)k * 16 + 4), e2 = *(const f32x4*)(wre + (size_t)k * 16 + 8), e3 = *(const f32x4*)(wre + (size_t)k * 16 + 12);
#pragma unroll
        for (int o = 0; o < 4; ++o) { WR[o * WS_ + k] = (f16)g4[o]; WR[(4 + o) * WS_ + k] = (f16)e0[o]; WR[(8 + o) * WS_ + k] = (f16)e1[o]; WR[(12 + o) * WS_ + k] = (f16)e2[o]; WR[(16 + o) * WS_ + k] = (f16)e3[o]; }
#pragma unroll
        for (int o = 20; o < 32; ++o) WR[o * WS_ + k] = (f16)0.f; }
    if (c.tid < 16) hl[c.tid] = 0;
    float gg[16], bb[16]; vec_load16(c.in[30] + l * D, lane, gg); vec_load16(c.in[31] + l * D, lane, bb);
    __syncthreads();
    for (int blk = c.bid; blk < NTOK / 128; blk += c.G) {
        const int m0 = blk * 128 + c.wid * 16;
#pragma unroll 1
        for (int r = 0; r < 16; r += 4) { float v[4][16];
#pragma unroll
            for (int q = 0; q < 4; ++q) row_load16(H + (size_t)(m0 + r + q) * D, lane, v[q]);
            ln_rows<4>(v, gg, bb);
#pragma unroll
            for (int q = 0; q < 4; ++q) row_store16(H + (size_t)(m0 + r + q) * D, lane, v[q]); }
        asm volatile("s_waitcnt vmcnt(0)" ::: "memory");
        f32x4 acc[2] = {(f32x4){0.f, 0.f, 0.f, 0.f}, (f32x4){0.f, 0.f, 0.f, 0.f}};
        const f16* arow = H + (size_t)(m0 + fr) * D + 8 * fq;
#pragma unroll 8
        for (int ks = 0; ks < 32; ++ks) { const h8 af = *(const h8*)(arow + 32 * ks);
            const h8 b0 = *(const LAS h8*)(WR + fr * WS_ + 32 * ks + 8 * fq), b1 = *(const LAS h8*)(WR + (16 + fr) * WS_ + 32 * ks + 8 * fq);
            acc[0] = __builtin_amdgcn_mfma_f32_16x16x32_f16(af, b0, acc[0], 0, 0, 0); acc[1] = __builtin_amdgcn_mfma_f32_16x16x32_f16(af, b1, acc[1], 0, 0, 0); }
#pragma unroll
        for (int e = 0; e < 4; ++e) { LG[(4 * fq + e) * 32 + fr] = acc[0][e]; LG[(4 * fq + e) * 32 + 16 + fr] = acc[1][e]; }
        asm volatile("s_waitcnt lgkmcnt(0)" ::: "memory");
        if (lane < 16) { const int m = m0 + lane; float lg[20];
#pragma unroll
            for (int q = 0; q < 5; ++q) { const f32x4 t4 = *(const LAS f32x4*)(LG + lane * 32 + 4 * q); lg[4 * q] = t4[0]; lg[4 * q + 1] = t4[1]; lg[4 * q + 2] = t4[2]; lg[4 * q + 3] = t4[3]; }
            float gl[4];
#pragma unroll
            for (int o = 0; o < 4; ++o) gl[o] = lg[o] + brg[o];
            int gi = 0; float gmax = gl[0];
#pragma unroll
            for (int o = 1; o < 4; ++o) if (gl[o] > gmax) { gmax = gl[o]; gi = o; }
            float gs = 0.f;
#pragma unroll
            for (int o = 0; o < 4; ++o) gs += expf(gl[o] - gmax);
            const float gw_ = 1.0f / gs;
            float el[4];
#pragma unroll
            for (int o = 0; o < 4; ++o) { float x = 0.f;
#pragma unroll
                for (int g = 0; g < 4; ++g) if (g == gi) x = lg[4 + 4 * g + o] + bre[4 * g + o];
                el[o] = x; }
            int i1 = 0; float v1 = el[0];
#pragma unroll
            for (int o = 1; o < 4; ++o) if (el[o] > v1) { v1 = el[o]; i1 = o; }
            int i2 = -1; float v2 = 0.f;
#pragma unroll
            for (int o = 0; o < 4; ++o) if (o != i1 && (i2 < 0 || el[o] > v2)) { i2 = o; v2 = el[o]; }
            const float p2 = expf(v2 - v1), w1 = gw_ / (1.0f + p2), w2 = gw_ * p2 / (1.0f + p2);
            const int e1 = gi * 4 + i1, e2 = gi * 4 + i2;
            TE[2 * m] = e1; TE[2 * m + 1] = e2; TW[2 * m] = w1; TW[2 * m + 1] = w2;
            atomicAdd((int*)(hl + e1), 1); atomicAdd((int*)(hl + e2), 1);
        }
        __syncthreads();
        if (c.tid < 16) { HIST[blk * 16 + c.tid] = hl[c.tid]; hl[c.tid] = 0; }
        __syncthreads();
    }
}
__device__ __forceinline__ void ph_lists(const Ctx& c) {
    const int* TE = wsp<int>(c, WS_TOKE); const float* TW = wsp<float>(c, WS_TOKW); const int* HIST = wsp<int>(c, WS_HIST);
    int* RT = wsp<int>(c, WS_ROWTOK); float* RW = wsp<float>(c, WS_ROWW); int* TX = wsp<int>(c, WS_TILEEXP); int* RSRC = wsp<int>(c, WS_ROWSRC);
    LAS int* sh = (LAS int*)c.lds;
    for (int blk = c.bid; blk < NTOK / 128; blk += c.G) {
        { const int e = c.tid & 15, part = c.tid >> 4; int cnt = 0, before = 0;
          for (int i = 0; i < 8; ++i) { const int b2 = part * 8 + i; const int hv = HIST[b2 * 16 + e]; cnt += hv; if (b2 < blk) before += hv; }
          sh[512 + part * 16 + e] = cnt; sh[1024 + part * 16 + e] = before; }
        int my_e = -1, my_rank = 0; float my_w = 0.f;
        if (c.tid < 256) { my_e = TE[blk * 256 + c.tid]; my_w = TW[blk * 256 + c.tid]; }
        if (c.wid < 4) {
            const unsigned long long lt = (c.lane == 0) ? 0ull : (~0ull >> (64 - c.lane));
#pragma unroll
            for (int ee = 0; ee < 16; ++ee) { const unsigned long long m = __ballot(my_e == ee); if (my_e == ee) my_rank = __popcll(m & lt); if (c.lane == 0) sh[64 + c.wid * 16 + ee] = __popcll(m); }
        }
        __syncthreads();
        if (c.tid < 16) { int cnt = 0, before = 0; for (int p = 0; p < 32; ++p) { cnt += sh[512 + p * 16 + c.tid]; before += sh[1024 + p * 16 + c.tid]; } sh[c.tid] = cnt; sh[32 + c.tid] = before; }
        __syncthreads();
        if (c.tid < 16) { int off = 0; for (int e = 0; e < 16; ++e) { if (e == c.tid) break; off += (sh[e] + 255) & ~255; } sh[16 + c.tid] = off; }
        __syncthreads();
        if (c.tid < 256) { int pos = sh[16 + my_e] + sh[32 + my_e] + my_rank;
            for (int w = 0; w < 4; ++w) if (w < c.wid) pos += sh[64 + w * 16 + my_e];
            RT[pos] = blk * 256 + c.tid; RW[pos] = my_w; RSRC[pos] = blk * 128 + (c.tid >> 1); }
        if (blk < 16 && c.tid >= 256) { const int e = blk, cnt = sh[e], pad = ((cnt + 255) & ~255) - cnt, i = c.tid - 256; if (i < pad) { RT[sh[16 + e] + cnt + i] = -1; RW[sh[16 + e] + cnt + i] = 0.f; RSRC[sh[16 + e] + cnt + i] = 0; } }
        if (blk == 0 && c.tid == 0) { int nt = 0; for (int e = 0; e < 16; ++e) { const int k = (sh[e] + 255) >> 8; for (int i = 0; i < k; ++i) TX[1 + nt + i] = e; nt += k; } TX[0] = nt; }
        __syncthreads();
    }
}
__device__ __forceinline__ void ph_final(const Ctx& c, int l) {
    f16* H = wsp<f16>(c, WS_H); const f16* YS = wsp<f16>(c, WS_YS); const int gw = c.wid * c.G + c.bid, NGW = c.G * 8;
    float gg[16], bb[16]; vec_load16(c.in[39] + l * D, c.lane, gg); vec_load16(c.in[40] + l * D, c.lane, bb);
    for (int m = gw * 2; m < NTOK; m += NGW * 2) {
        float v[2][16];
#pragma unroll
        for (int r = 0; r < 2; ++r) { float a[16], b[16]; row_load16_nt(H + (size_t)(m + r) * D, c.lane, v[r]); row_load16_nt(YS + (size_t)(2 * (m + r)) * D, c.lane, a); row_load16_nt(YS + (size_t)(2 * (m + r) + 1) * D, c.lane, b);
#pragma unroll
            for (int i = 0; i < 16; ++i) v[r][i] = ALPHA * v[r][i] + (a[i] + b[i]); }
        ln_rows<2>(v, gg, bb);
#pragma unroll
        for (int r = 0; r < 2; ++r) {
            if (l == DEPTH - 1) { float* o = c.out + (size_t)(m + r) * D;
                __builtin_nontemporal_store((f32x4){v[r][0], v[r][1], v[r][2], v[r][3]}, (f32x4*)(o + 8 * c.lane)); __builtin_nontemporal_store((f32x4){v[r][4], v[r][5], v[r][6], v[r][7]}, (f32x4*)(o + 8 * c.lane + 4));
                __builtin_nontemporal_store((f32x4){v[r][8], v[r][9], v[r][10], v[r][11]}, (f32x4*)(o + 512 + 8 * c.lane)); __builtin_nontemporal_store((f32x4){v[r][12], v[r][13], v[r][14], v[r][15]}, (f32x4*)(o + 512 + 8 * c.lane + 4));
            } else row_store16(H + (size_t)(m + r) * D, c.lane, v[r]); }
    }
}

constexpr int CW_Q = 8192;
__device__ __forceinline__ void b2_queue(const Ctx& c, int l, unsigned* ctr, volatile LAS unsigned* slot) {
    for (;;) {
        if (c.tid == 0) slot[0] = __hip_atomic_fetch_add(ctr, 1u, __ATOMIC_RELAXED, __HIP_MEMORY_SCOPE_AGENT);
        __syncthreads();
        const int idx = (int)slot[0];
        __syncthreads();
        if (idx >= 1536) break;
        if (idx < 16 * att::ATT_NBIG) { const int cb = att::ATT_ORDER[idx >> 4]; att::attn_unit(c, idx & 15, cb >> 3, cb & 7); }
        else if (idx < 16 * att::ATT_NBIG + 512) { const int u = idx - 16 * att::ATT_NBIG; lru::lru_unit<2>(c, l, u >> 5, u & 31); }
        else { const int k = idx - 512; const int cb = att::ATT_ORDER[k >> 4]; att::attn_unit(c, k & 15, cb >> 3, cb & 7); }
    }
}

constexpr int PH_PRO = 0, PH_L0 = 1, PL = 12, NPHASE = PH_L0 + DEPTH * PL;
enum { L_WIN = 0, L_B1, L_B2, L_GLU, L_WOUT, L_WQ, L_WO, L_LN2R, L_LISTS, L_MOE1, L_MOE2, L_FIN };

struct Args { const float* in[41]; float* out; unsigned char* ws; int ph_lo, ph_hi; };

__global__ void __launch_bounds__(512, 2) fwd_kernel(Args args) {
    extern __shared__ __attribute__((aligned(16))) unsigned char lds_raw[];
    Ctx c0;
    c0.in = args.in;
    c0.out = args.out; c0.ws = args.ws; c0.lds = (LAS unsigned char*)lds_raw;
    c0.tid = threadIdx.x; c0.lane = c0.tid & 63; c0.wid = __builtin_amdgcn_readfirstlane(c0.tid >> 6); c0.G = gridDim.x; c0.bid = blockIdx.x;
    volatile LAS unsigned* MISC = (volatile LAS unsigned*)(c0.lds + MISC_OFF);
    if (c0.tid < 32) MISC[c0.tid] = 0u;
    __syncthreads();
    XcdBarrier bar; bar.bar = (unsigned*)(c0.ws + WS_CTL) + CW_BAR; bar.x = 0; bar.st = nullptr;
    const int lo = args.ph_lo, hi = args.ph_hi;
    const bool multi = (hi - lo) > 1;
    if (multi) bar = xcd_barrier_post((unsigned*)(c0.ws + WS_CTL) + CW_BAR, MISC + 8);
#define IN(k) (lo <= (k) && (k) < hi)
#define SEAM(k) do { if (IN(k) && IN((k) + 1)) xcd_barrier(bar); } while (0)
#define GEMM(EPI, SCHED, g, S, E) pg8::gemm_phase<EPI, SCHED, true, true>(c.lds, g, S, E, c.tid)

    if (IN(PH_PRO)) { const Ctx c = fresh(c0); s5::tables1(c); ph_conv(c); ph_ln0(c); } SEAM(PH_PRO);
#define LAYER_BODY(l) do {         const int P0 = PH_L0 + l * PL; \
        if (IN(P0 + L_WIN)) for (int rep_ = 0; rep_ < REPS(L_WIN); ++rep_) { if (rep_) __syncthreads(); const Ctx c = fresh(c0); \
            if (l == 0) { s5::tables2(c); ph_fold_vectors(c); } \
            if (c.bid >= 128) { LAS float* scr = (LAS float*)(c.lds + c.wid * 16384);       \
                for (int it = (c.bid - 128) * 8 + c.wid; it < MOE_CONV_ITEMS; it += 128 * 8) conv_moe_item(c, l, it, scr); } \
            __syncthreads(); \
            pg8::Gemm g{(const f16*)c.ws, (const f16*)c.ws, D, D, D}; pg8::WinKvOrder S; S.so.init(NTOK, DIN, c.G, c.bid); S.lay = l; \
            pg8::EWinKv E{pg8::EStoreWin{wsp<f16>(c, WS_Z), wsp<f16>(c, WS_UG)}, pg8::EStoreKV2{wsp<f16>(c, WS_KM), wsp<f16>(c, WS_VM)}}; GEMM(pg8::EWinKv, pg8::WinKvOrder, g, S, E); } \
        SEAM(P0 + L_WIN); \
        if (IN(P0 + L_B1)) for (int rep_ = 0; rep_ < REPS(L_B1); ++rep_) { if (rep_) __syncthreads(); const Ctx c = fresh(c0); if (l == 0) s5::tables3(c); ph_kmean(c); s5::carry_phase(c, l); } \
        SEAM(P0 + L_B1); \
        if (IN(P0 + L_B2)) for (int rep_ = 0; rep_ < REPS(L_B2); ++rep_) { if (rep_) __syncthreads(); const Ctx c = fresh(c0); \
            { pg8::Gemm g{wsp<f16>(c, WS_UG), wsp<f16>(c, WS_S5T) + (size_t)l * 16 * 512 * 640, 640, 640, 640}; pg8::S5Order S{c.G, c.bid}; \
              pg8::ES5 E{wsp<f16>(c, WS_UG), wsp<f16>(c, WS_YACT), c.in[13] + l * 256, c.in[14] + l * 16}; GEMM(pg8::ES5, pg8::S5Order, g, S, E); } \
            __syncthreads(); \
            b2_queue(c, l, (unsigned*)(c.ws + WS_CTL) + CW_Q + 64 * (l * 4 + rep_), MISC + 16); } \
        SEAM(P0 + L_B2); \
        if (IN(P0 + L_GLU)) for (int rep_ = 0; rep_ < REPS(L_GLU); ++rep_) { if (rep_) __syncthreads(); const Ctx c = fresh(c0); \
            pg8::Gemm g{wsp<f16>(c, WS_YACT), wsp<f16>(c, WS_WGLU_T) + (size_t)l * 256 * 256, 256, 256, 256}; pg8::StaticOrder S; S.init(NTOK, 256, c.G, c.bid); \
            pg8::EGlu E{wsp<f16>(c, WS_YACT), c.in[16] + l * 256, wsp<f16>(c, WS_Y), (LAS float*)(c.lds + 132096)}; GEMM(pg8::EGlu, pg8::StaticOrder, g, S, E); \
            __syncthreads(); \
            { pg8::Gemm g2{(const f16*)c.ws, (const f16*)c.ws, 256, D, D}; pg8::PreOrder S2{c.G, c.bid, l}; pg8::EStorePre E2{wsp<f16>(c, WS_MT)}; GEMM(pg8::EStorePre, pg8::PreOrder, g2, S2, E2); } \
            ph_norm_attn(c); } \
        SEAM(P0 + L_GLU); \
        if (IN(P0 + L_WOUT)) { const Ctx c = fresh(c0); \
            ph_fold_x(c, l); __syncthreads(); \
            pg8::Gemm g{wsp<f16>(c, WS_Y), wsp<f16>(c, WS_WOUT_T) + (size_t)l * D * D, D, D, D}; pg8::StaticOrder S; S.init(NTOK, D, c.G, c.bid); \
            pg8::EResidStats E{wsp<f16>(c, WS_H), wsp<float>(c, WS_STATS1), (LAS float*)(c.lds + 132096)}; GEMM(pg8::EResidStats, pg8::StaticOrder, g, S, E); } \
        SEAM(P0 + L_WOUT); \
        if (IN(P0 + L_WQ)) { const Ctx c = fresh(c0); \
            pg8::Gemm g{wsp<f16>(c, WS_H), (const f16*)c.ws, D, D, D}; pg8::BatchBOrder S; S.so.init(NTOK, D, c.G, c.bid); S.bbase = (unsigned)WS_MT; \
            pg8::ESoftmaxLN E{wsp<f16>(c, WS_P), (LAS float*)(c.lds + 132096), wsp<float>(c, WS_STATS1), wsp<float>(c, WS_S1X), wsp<float>(c, WS_S2X)}; GEMM(pg8::ESoftmaxLN, pg8::BatchBOrder, g, S, E); } \
        SEAM(P0 + L_WQ); \
        if (IN(P0 + L_WO)) { const Ctx c = fresh(c0); \
            pg8::Gemm g{wsp<f16>(c, WS_P), (const f16*)c.ws, D, D, D}; pg8::BatchBOrder S; S.so.init(NTOK, D, c.G, c.bid); S.bbase = (unsigned)WS_NT; \
            pg8::EResidLN E{wsp<f16>(c, WS_H), wsp<float>(c, WS_STATS1), c.in[24] + l * D, c.in[25] + l * D}; GEMM(pg8::EResidLN, pg8::BatchBOrder, g, S, E); } \
        SEAM(P0 + L_WO); \
        if (IN(P0 + L_LN2R)) for (int rep_ = 0; rep_ < REPS(L_LN2R); ++rep_) { if (rep_) __syncthreads(); const Ctx c = fresh(c0); ph_ln2_route(c, l); } \
        SEAM(P0 + L_LN2R); \
        if (IN(P0 + L_LISTS)) for (int rep_ = 0; rep_ < REPS(L_LISTS); ++rep_) { if (rep_) __syncthreads(); const Ctx c = fresh(c0); ph_lists(c); } \
        SEAM(P0 + L_LISTS); \
        if (IN(P0 + L_MOE1)) for (int rep_ = 0; rep_ < REPS(L_MOE1); ++rep_) { if (rep_) __syncthreads(); const Ctx c = fresh(c0); \
            pg8::Gemm g{wsp<f16>(c, WS_H), wsp<f16>(c, WS_WGU_T), D, D, D, wsp<int>(c, WS_ROWSRC)}; pg8::MoeOrder S; S.init(wsp<int>(c, WS_TILEEXP), 2, c.G, c.bid); \
            pg8::ESiluMul E{wsp<f16>(c, WS_HE)}; pg8::gemm_phase<pg8::ESiluMul, pg8::MoeOrder, true, true, true>(c.lds, g, S, E, c.tid); } \
        SEAM(P0 + L_MOE1); \
        if (IN(P0 + L_MOE2)) for (int rep_ = 0; rep_ < REPS(L_MOE2); ++rep_) { if (rep_) __syncthreads(); const Ctx c = fresh(c0); \
            pg8::Gemm g{wsp<f16>(c, WS_HE), wsp<f16>(c, WS_WD_T), DEXP, DEXP, DEXP}; pg8::MoeOrder S; S.init(wsp<int>(c, WS_TILEEXP), 4, c.G, c.bid); \
            pg8::EScatter E{wsp<int>(c, WS_ROWTOK), wsp<float>(c, WS_ROWW), wsp<f16>(c, WS_YS)}; GEMM(pg8::EScatter, pg8::MoeOrder, g, S, E); } \
        SEAM(P0 + L_MOE2); \
        if (IN(P0 + L_FIN)) for (int rep_ = 0; rep_ < REPS(L_FIN); ++rep_) { if (rep_) __syncthreads(); const Ctx c = fresh(c0); ph_final(c, l); } \
        if (l + 1 < DEPTH) SEAM(P0 + L_FIN); \
     } while (0)
    LAYER_BODY(0);
    LAYER_BODY(1);
#undef LAYER_BODY
#undef IN
#undef SEAM
#undef GEMM
}

extern "C" void kernel_launch(void* const* d_in, const int* in_sizes, int n_in, void* d_out, int out_size, void* d_ws, size_t ws_size, hipStream_t stream) {
    static int grid = 0;
    if (grid == 0) {
        if (n_in != 41 || out_size != NTOK * D || ws_size < WS_END) { fprintf(stderr, "kernel_launch: unexpected problem (n_in %d out %d ws %zu)\n", n_in, out_size, ws_size); grid = -1; return; }
        if (hipFuncSetAttribute((const void*)fwd_kernel, hipFuncAttributeMaxDynamicSharedMemorySize, LDS_BYTES) != hipSuccess) { fprintf(stderr, "kernel_launch: hipFuncSetAttribute failed\n"); grid = -1; return; }
        int dev = 0, cus = 0, per_cu = 0;
        hipGetDevice(&dev); hipDeviceGetAttribute(&cus, hipDeviceAttributeMultiprocessorCount, dev);
        hipOccupancyMaxActiveBlocksPerMultiprocessor(&per_cu, (const void*)fwd_kernel, 512, LDS_BYTES);
        (void)hipGetLastError();
        if (per_cu < 1) fprintf(stderr, "kernel_launch: occupancy query says %d\n", per_cu);
        grid = cus > 256 ? 256 : cus;
        if (grid != 256) fprintf(stderr, "kernel_launch: grid %d != 256\n", grid);
    }
    if (grid < 0) return;
    hipMemsetAsync((char*)d_ws + WS_CTL, 0, CTL_ZERO_BYTES, stream);
    Args a{};
    for (int i = 0; i < 41; ++i) a.in[i] = (const float*)d_in[i];
    a.out = (float*)d_out; a.ws = (unsigned char*)d_ws;
#if MK_ONE_LAUNCH
    a.ph_lo = 0; a.ph_hi = NPHASE;
    hipLaunchKernelGGL(fwd_kernel, dim3(grid), dim3(512), LDS_BYTES, stream, a);
#else
    for (int p = 0; p < NPHASE; ++p) { a.ph_lo = p; a.ph_hi = p + 1; hipLaunchKernelGGL(fwd_kernel, dim3(grid), dim3(512), LDS_BYTES, stream, a); }
#endif
}
```
